# Optimizing an MI355X kernel written in HIP

```python
import jax
import jax.numpy as jnp
from jax import lax
import numpy as np

D_MODEL = 1024
BATCH = 16
SEQ = 2048
DEPTH = 2

N_A_LAYERS = DEPTH // 2
N_B_LAYERS = DEPTH - N_A_LAYERS
RMS_EPS = 1e-6

GLA_HEADS = 4
GLA_DK = D_MODEL // 2 // GLA_HEADS
GLA_DV = D_MODEL // GLA_HEADS
GLA_GATE_RANK = 16
GLA_GATE_TAU = 16.0
GLA_CHUNK = 64
GLA_IN_WIDTH = 2 * GLA_HEADS * GLA_DK + 2 * GLA_HEADS * GLA_DV + GLA_GATE_RANK

FOX_HEADS = 16
FOX_HEAD_DIM = D_MODEL // FOX_HEADS
FOX_WIDTH = FOX_HEADS * FOX_HEAD_DIM
FOX_Q_BLOCK = 128

MOE_GROUPS = 4
MOE_EXPERTS_PER_GROUP = 8
MOE_EXPERTS = MOE_GROUPS * MOE_EXPERTS_PER_GROUP
MOE_TOP_K = 2
MOE_D_FF = D_MODEL // 2
MOE_BLOCK = 256

kernel_name = 'hybrid_gla_fox_hmoe'


def rmsnorm(x, g):
    xf = x.astype(jnp.float32)
    y = xf * lax.rsqrt(jnp.mean(xf * xf, axis=-1, keepdims=True) + RMS_EPS)
    return (y * g.astype(jnp.float32)).astype(x.dtype)


def gla_chunked(q, k, v, log_a):
    b_, s_, h_, dk = q.shape
    dv = v.shape[-1]
    nc = s_ // GLA_CHUNK

    def to_chunks(t):
        return t.reshape(b_, nc, GLA_CHUNK, h_, t.shape[-1]).transpose(1, 0, 3, 2, 4)

    causal = jnp.tril(jnp.ones((GLA_CHUNK, GLA_CHUNK), dtype=bool))[None, None, :, :, None]

    def step(state, inp):
        qc, kc, vc, gc = inp
        qf = qc.astype(jnp.float32)
        kf = kc.astype(jnp.float32)
        vf = vc.astype(jnp.float32)
        cum = jnp.cumsum(gc.astype(jnp.float32), axis=2)
        last = cum[:, :, -1:, :]
        o_inter = jnp.einsum('bhid,bhde->bhie', qf * jnp.exp(cum), state)
        rel = jnp.where(causal, cum[:, :, :, None, :] - cum[:, :, None, :, :], -jnp.inf)
        scores = jnp.einsum('bhijd,bhjd->bhij', qf[:, :, :, None, :] * jnp.exp(rel), kf)
        o_intra = jnp.einsum('bhij,bhje->bhie', scores, vf)
        state = state * jnp.exp(last)[:, :, 0, :, None] + jnp.einsum(
            'bhjd,bhje->bhde', kf * jnp.exp(last - cum), vf)
        return state, o_inter + o_intra

    state0 = jnp.zeros((b_, h_, dk, dv), jnp.float32)
    _, o = lax.scan(step, state0, (to_chunks(q), to_chunks(k), to_chunks(v), to_chunks(log_a)))
    return o.transpose(1, 0, 3, 2, 4).reshape(b_, s_, h_, dv).astype(v.dtype)


def gla_mixer(x, w_in, w_a2, b_a, out_norm, w_out):
    b_, s_, _ = x.shape
    qk = GLA_HEADS * GLA_DK
    vw = GLA_HEADS * GLA_DV
    proj = x @ w_in
    q, k, v, r, a = jnp.split(proj, [qk, 2 * qk, 2 * qk + vw, 2 * qk + 2 * vw], axis=-1)
    q = q.reshape(b_, s_, GLA_HEADS, GLA_DK) * (GLA_DK ** -0.5)
    k = k.reshape(b_, s_, GLA_HEADS, GLA_DK)
    v = v.reshape(b_, s_, GLA_HEADS, GLA_DV)
    log_a = jax.nn.log_sigmoid((a @ w_a2 + b_a).astype(jnp.float32)) / GLA_GATE_TAU
    o = gla_chunked(q, k, v, log_a.reshape(b_, s_, GLA_HEADS, GLA_DK))
    o = rmsnorm(o, out_norm)
    o = o.reshape(b_, s_, vw) * jax.nn.silu(r)
    return o @ w_out


def shared_kv(h, kv_norm, kv_w, kv_b_f):
    b_, s_, _ = h.shape
    proj = rmsnorm(h, kv_norm) @ kv_w
    k, v, f = jnp.split(proj, [FOX_WIDTH, 2 * FOX_WIDTH], axis=-1)
    k = k.reshape(b_, s_, FOX_HEADS, FOX_HEAD_DIM)
    v = v.reshape(b_, s_, FOX_HEADS, FOX_HEAD_DIM)
    log_f = jax.nn.log_sigmoid((f + kv_b_f).astype(jnp.float32))
    c = jnp.cumsum(log_f, axis=1).transpose(0, 2, 1)
    return k, v, c


def forgetting_attention(q, k, v, c):
    b_, s_, h_, dh = q.shape
    scale = dh ** -0.5
    outs = []
    for blk in range(s_ // FOX_Q_BLOCK):
        q0 = blk * FOX_Q_BLOCK
        q1 = q0 + FOX_Q_BLOCK
        logits = jnp.einsum('bqhd,bkhd->bhqk', q[:, q0:q1], k[:, :q1]).astype(jnp.float32) * scale
        logits = logits + c[:, :, q0:q1, None] - c[:, :, None, :q1]
        mask = (q0 + jnp.arange(FOX_Q_BLOCK))[:, None] >= jnp.arange(q1)[None, :]
        p = jax.nn.softmax(jnp.where(mask, logits, -jnp.inf), axis=-1)
        outs.append(jnp.einsum('bhqk,bkhd->bqhd', p.astype(v.dtype), v[:, :q1]))
    return jnp.concatenate(outs, axis=1)


def fox_mixer(x, k, v, c, w_in, w_out):
    b_, s_, _ = x.shape
    q, og = jnp.split(x @ w_in, [FOX_WIDTH], axis=-1)
    q = q.reshape(b_, s_, FOX_HEADS, FOX_HEAD_DIM)
    o = forgetting_attention(q, k, v, c).reshape(b_, s_, FOX_WIDTH)
    return (o * jax.nn.sigmoid(og)) @ w_out


def grouped_experts(xt, e_idx, gate, w_gate, w_up, w_down):
    n_tok, d = xt.shape
    n_slot = n_tok * MOE_TOP_K
    flat_e = e_idx.reshape(n_slot)
    order = jnp.argsort(flat_e)
    sorted_e = flat_e[order]
    sorted_tok = order // MOE_TOP_K
    counts = jnp.bincount(flat_e, length=MOE_EXPERTS)
    padded = (counts + MOE_BLOCK - 1) // MOE_BLOCK * MOE_BLOCK
    start = jnp.cumsum(counts) - counts
    pad_end = jnp.cumsum(padded)
    pad_start = pad_end - padded
    dest = pad_start[sorted_e] + jnp.arange(n_slot) - start[sorted_e]
    n_blocks = -(-n_slot // MOE_BLOCK) + MOE_EXPERTS
    xbuf = jnp.zeros((n_blocks * MOE_BLOCK, d), xt.dtype).at[dest].set(xt[sorted_tok])
    block_e = jnp.minimum(
        jnp.searchsorted(pad_end, jnp.arange(n_blocks) * MOE_BLOCK, side='right'), MOE_EXPERTS - 1)

    def expert_block(args):
        xb, e = args
        hb = jax.nn.silu(xb @ w_gate[e]) * (xb @ w_up[e])
        return hb @ w_down[e]

    ybuf = lax.map(expert_block, (xbuf.reshape(n_blocks, MOE_BLOCK, d), block_e))
    y_sorted = ybuf.reshape(n_blocks * MOE_BLOCK, d)[dest]
    w_sorted = gate.reshape(n_slot)[order].astype(y_sorted.dtype)
    return jax.ops.segment_sum(y_sorted * w_sorted[:, None], sorted_tok, num_segments=n_tok)


def hier_moe(x, w_coarse, b_coarse, w_fine, b_fine, w_gate, w_up, w_down):
    b_, s_, d = x.shape
    xt = x.reshape(b_ * s_, d)
    p_coarse = jax.nn.softmax((xt @ w_coarse).astype(jnp.float32) + b_coarse, axis=-1)
    pc_top, g_idx = lax.top_k(p_coarse, 1)
    lf = ((xt @ w_fine).astype(jnp.float32) + b_fine).reshape(-1, MOE_GROUPS, MOE_EXPERTS_PER_GROUP)
    lf_sel = jnp.take_along_axis(lf, g_idx[:, :, None], axis=1)[:, 0]
    pf_top, j_idx = lax.top_k(jax.nn.softmax(lf_sel, axis=-1), MOE_TOP_K)
    gate = pc_top * pf_top / jnp.sum(pf_top, axis=-1, keepdims=True)
    e_idx = g_idx * MOE_EXPERTS_PER_GROUP + j_idx
    y = grouped_experts(xt, e_idx, gate, w_gate, w_up, w_down)
    return y.reshape(b_, s_, d).astype(x.dtype)


def setup_inputs(seed: int = 0) -> dict:
    key = jax.random.key(seed)
    ks = jax.random.split(key, 24)
    d = D_MODEL

    def nrm(k, shape, fan_in):
        return jax.random.normal(k, shape, jnp.float32) * (fan_in ** -0.5)

    def gain(k, shape):
        return 1.0 + 0.02 * jax.random.normal(k, shape, jnp.float32)

    def bias(k, shape):
        return 0.01 * jax.random.normal(k, shape, jnp.float32)

    return {
        'x': jax.random.normal(ks[0], (BATCH, SEQ, d), jnp.float32),
        'gla_norm': gain(ks[1], (N_A_LAYERS, d)),
        'gla_w_in': nrm(ks[2], (N_A_LAYERS, d, GLA_IN_WIDTH), d),
        'gla_w_a2': nrm(ks[3], (N_A_LAYERS, GLA_GATE_RANK, GLA_HEADS * GLA_DK), GLA_GATE_RANK),
        'gla_b_a': bias(ks[4], (N_A_LAYERS, GLA_HEADS * GLA_DK)),
        'gla_out_norm': gain(ks[5], (N_A_LAYERS, GLA_HEADS, GLA_DV)),
        'gla_w_out': nrm(ks[6], (N_A_LAYERS, GLA_HEADS * GLA_DV, d), GLA_HEADS * GLA_DV),
        'kv_norm': gain(ks[7], (d,)),
        'kv_w': nrm(ks[8], (d, 2 * FOX_WIDTH + FOX_HEADS), d),
        'kv_b_f': bias(ks[9], (FOX_HEADS,)),
        'fox_norm': gain(ks[10], (N_B_LAYERS, d)),
        'fox_w_in': nrm(ks[11], (N_B_LAYERS, d, 2 * FOX_WIDTH), d),
        'fox_w_out': nrm(ks[12], (N_B_LAYERS, FOX_WIDTH, d), FOX_WIDTH),
        'ffn_norm': gain(ks[13], (DEPTH, d)),
        'router_coarse_w': nrm(ks[14], (DEPTH, d, MOE_GROUPS), d),
        'router_coarse_b': bias(ks[15], (DEPTH, MOE_GROUPS)),
        'router_fine_w': nrm(ks[16], (DEPTH, d, MOE_EXPERTS), d),
        'router_fine_b': bias(ks[17], (DEPTH, MOE_EXPERTS)),
        'expert_w_gate': nrm(ks[18], (DEPTH, MOE_EXPERTS, d, MOE_D_FF), d),
        'expert_w_up': nrm(ks[19], (DEPTH, MOE_EXPERTS, d, MOE_D_FF), d),
        'expert_w_down': nrm(ks[20], (DEPTH, MOE_EXPERTS, MOE_D_FF, d), MOE_D_FF),
        'final_norm': gain(ks[21], (d,)),
    }


def reference(x, gla_norm, gla_w_in, gla_w_a2, gla_b_a, gla_out_norm, gla_w_out,
              kv_norm, kv_w, kv_b_f, fox_norm, fox_w_in, fox_w_out,
              ffn_norm, router_coarse_w, router_coarse_b, router_fine_w, router_fine_b,
              expert_w_gate, expert_w_up, expert_w_down, final_norm):
    h = x
    k_sh = v_sh = c_sh = None
    for layer in range(DEPTH):
        if layer < N_A_LAYERS:
            i = layer
            h = h + gla_mixer(rmsnorm(h, gla_norm[i]), gla_w_in[i], gla_w_a2[i], gla_b_a[i],
                              gla_out_norm[i], gla_w_out[i])
        else:
            if layer == N_A_LAYERS:
                k_sh, v_sh, c_sh = shared_kv(h, kv_norm, kv_w, kv_b_f)
            i = layer - N_A_LAYERS
            h = h + fox_mixer(rmsnorm(h, fox_norm[i]), k_sh, v_sh, c_sh, fox_w_in[i], fox_w_out[i])
        h = h + hier_moe(rmsnorm(h, ffn_norm[layer]), router_coarse_w[layer], router_coarse_b[layer],
                         router_fine_w[layer], router_fine_b[layer], expert_w_gate[layer],
                         expert_w_up[layer], expert_w_down[layer])
    return rmsnorm(h, final_norm)
```

```cpp
#include <hip/hip_runtime.h>
#include <hip/hip_cooperative_groups.h>
#include <cstdio>
#include <cstdint>
namespace cg = cooperative_groups;

#define LAS __attribute__((address_space(3)))
typedef unsigned short bf16_t;
typedef short bf16x8 __attribute__((ext_vector_type(8)));
typedef float f32x4 __attribute__((ext_vector_type(4)));
typedef float f32x2 __attribute__((ext_vector_type(2)));
typedef unsigned u32x4 __attribute__((ext_vector_type(4)));
typedef unsigned u32x2 __attribute__((ext_vector_type(2)));
typedef int i32x4 __attribute__((ext_vector_type(4)));

constexpr int T = 32768, D = 1024, NBATCH = 16, SEQ = 2048;
constexpr int NWAVES = 8, NTHREADS = 512;
constexpr float RMS_EPS = 1e-6f;
constexpr float LOG2E = 1.4426950408889634f;
constexpr float ATT_C2 = 0.125f * LOG2E;
constexpr float GLA_QSCALE = 0.08838834764831845f;
constexpr int NEXP = 32;
constexpr int MAXTILES = 288;

constexpr size_t MiB = 1u << 20;
constexpr size_t WS_CTL = 0;
constexpr size_t WS_SKINNY = 256 * 1024;
constexpr size_t WS_WIN = 1 * MiB;
constexpr size_t WS_WOUT = WS_WIN + 6 * MiB;
constexpr size_t WS_WKVQ = WS_WOUT + 2 * MiB;
constexpr size_t WS_WFO = WS_WKVQ + 8 * MiB;
constexpr size_t WS_WEUP = WS_WFO + 2 * MiB;
constexpr size_t WS_WEDN = WS_WEUP + 128 * MiB;
constexpr size_t WS_AB = WS_WEDN + 64 * MiB;
constexpr size_t AB_XN = WS_AB;
constexpr size_t AB_Q = WS_AB + 64 * MiB;
constexpr size_t AB_K = WS_AB + 96 * MiB;
constexpr size_t AB_V = WS_AB + 128 * MiB;
constexpr size_t AB_R = WS_AB + 192 * MiB;
constexpr size_t AB_KHT = WS_AB + 256 * MiB;
constexpr size_t AB_PM = WS_AB + 288 * MiB;
constexpr size_t AB_EL = WS_AB + 304 * MiB;
constexpr size_t AB_AA = WS_AB + 305 * MiB;
constexpr size_t AB_SSQ = WS_AB + 307 * MiB;
constexpr size_t AB_ALPHA = AB_XN;
constexpr size_t AB_HB = WS_AB + 64 * MiB;
constexpr size_t AB_YS = WS_AB + 136 * MiB;
constexpr size_t AB_LIST = WS_AB + 280 * MiB;
constexpr size_t AB_TOKI = WS_AB + 284 * MiB;
constexpr size_t AB_TOKG = WS_AB + 285 * MiB;
constexpr size_t AB_FK = WS_AB + 64 * MiB;
constexpr size_t AB_FV = WS_AB + 128 * MiB;
constexpr size_t AB_FQ = WS_AB + 192 * MiB;
constexpr size_t AB_FOG = WS_AB + 256 * MiB;
constexpr size_t AB_LF = WS_AB + 320 * MiB;
constexpr size_t AB_C = WS_AB + 322 * MiB;
constexpr size_t WS_END = WS_AB + 324 * MiB;

constexpr int SK_WA = 0, SK_WR0 = 16 * 1024, SK_WR1 = SK_WR0 + 36 * 1024, SK_WF = SK_WR1 + 36 * 1024;

constexpr int RING_BYTES = 131072;
constexpr int LDS_MISC = RING_BYTES;
constexpr int LDS_BYTES = 147456;

__device__ __forceinline__ unsigned f2bf(float f) { unsigned u = __builtin_bit_cast(unsigned, f); return (u + 0x7fffu + ((u >> 16) & 1u)) >> 16; }
__device__ __forceinline__ unsigned pk2(float lo, float hi) { return f2bf(lo) | (f2bf(hi) << 16); }
__device__ __forceinline__ float bf2f(unsigned h) { return __builtin_bit_cast(float, h << 16); }
__device__ __forceinline__ float bflo(unsigned w) { return __builtin_bit_cast(float, w << 16); }
__device__ __forceinline__ float bfhi(unsigned w) { return __builtin_bit_cast(float, w & 0xffff0000u); }
__device__ __forceinline__ float wave_sum(float v) {
#pragma unroll
    for (int o = 1; o < 64; o <<= 1) v += __shfl_xor(v, o);
    return v;
}
__device__ __forceinline__ float log_sigmoid(float z) { return fminf(z, 0.f) - log1pf(__expf(-fabsf(z))); }
__device__ __forceinline__ float sigmoidf_(float z) { return 1.f / (1.f + __expf(-z)); }
__device__ __forceinline__ int perm32(int rho) { const int n = rho >> 4, i = rho & 15; return 8 * (i >> 2) + 4 * n + (i & 3); }

struct Args { const float* in[22]; float* out; unsigned char* ws; int ph_lo, ph_hi; };

struct Unit { int pm, pn; };
constexpr int BM = 256, HALF = 128, NXCD = 8, WGM = 8;
struct StaticOrder {
    int nM, nN, nwg, G, c;
    __device__ void init(int M, int N, int G_, int c_) { nM = M / BM; nN = N / BM; nwg = nM * nN; G = G_; c = c_; }
    __device__ bool next(int i, Unit& u) const {
        const long L = (long)i * G + c; if (L >= nwg) return false;
        int wgid = (int)L; { const int q = nwg / NXCD, r = nwg % NXCD, xcd = wgid % NXCD, off = wgid / NXCD; wgid = (xcd < r ? xcd * (q + 1) : r * (q + 1) + (xcd - r) * q) + off; }
        const int nig = WGM * nN, gid = wgid / nig, fm = gid * WGM, gsz = (nM - fm) < WGM ? (nM - fm) : WGM;
        u.pm = fm + ((wgid % nig) % gsz); u.pn = (wgid % nig) / gsz; return true;
    }
};
struct IdMap { __device__ __forceinline__ int row(const Unit& u, int r) const { return u.pm * BM + r; } };

struct MoeTab { LAS int* cnt; LAS int* tstart; LAS int* tile_e; };
__device__ __forceinline__ MoeTab moe_tab(LAS unsigned char* lds) { MoeTab t; t.cnt = (LAS int*)(lds + LDS_MISC); t.tstart = t.cnt + 32; t.tile_e = t.tstart + 64; return t; }
__device__ __forceinline__ void moe_tab_build(const MoeTab& t, const int* gcnt) {
    if (threadIdx.x == 0) { int s = 0; for (int e = 0; e < NEXP; ++e) { const int c = gcnt[e]; t.cnt[e] = c; t.tstart[e] = s; s += (c + 255) >> 8; } t.tstart[32] = s; }
    __syncthreads();
    const int nt = t.tstart[32];
    for (int p = threadIdx.x; p < nt; p += NTHREADS) { int e = 0; for (int j = 1; j < NEXP; ++j) if (t.tstart[j] <= p) e = j; t.tile_e[p] = e; }
    __syncthreads();
}
struct MoeOrder {
    StaticOrder so; MoeTab tab;
    __device__ bool next(int i, Unit& u) const { if (!so.next(i, u)) return false; u.pn += 4 * tab.tile_e[u.pm]; return true; }
};
struct MoeGather {
    MoeTab tab; const int* list;
    __device__ __forceinline__ int row(const Unit& u, int r) const {
        const int e = u.pn >> 2; int idx = (u.pm - tab.tstart[e]) * BM + r; const int c = tab.cnt[e]; idx = idx < c ? idx : c - 1; return list[e * T + idx];
    }
};

template <int WHICH> struct EpiSplitBf16 {
    static constexpr bool PERM = true;
    unsigned char* ws;
    __device__ __forceinline__ void operator()(const f32x4 (&acc)[2][2][4][2], const Unit& u, int wr, int wc, int fr, int fq) const {
        size_t off; int ldc, f0;
        if (WHICH == 0) { if (u.pn < 2) { off = AB_Q; ldc = 512; f0 = 0; } else if (u.pn < 4) { off = AB_K; ldc = 512; f0 = 2; } else if (u.pn < 8) { off = AB_V; ldc = 1024; f0 = 4; } else { off = AB_R; ldc = 1024; f0 = 8; } }
        else { off = AB_FK + (size_t)(u.pn >> 2) * (64 * MiB); ldc = 1024; f0 = u.pn & ~3; }
        bf16_t* base = (bf16_t*)(ws + off);
        const int row0 = u.pm * BM + wr * 64 + fr, col0 = (u.pn - f0) * BM + wc * 32 + 8 * fq;
#pragma unroll
        for (int ai = 0; ai < 2; ++ai)
#pragma unroll
            for (int m = 0; m < 4; ++m) { bf16_t* rowp = base + (size_t)(row0 + ai * HALF + m * 16) * ldc + col0;
#pragma unroll
                for (int bj = 0; bj < 2; ++bj) { const f32x4 v0 = acc[ai][bj][m][0], v1 = acc[ai][bj][m][1];
                    u32x4 w; w.x = pk2(v0[0], v0[1]); w.y = pk2(v0[2], v0[3]); w.z = pk2(v1[0], v1[1]); w.w = pk2(v1[2], v1[3]);
                    *(u32x4*)(rowp + bj * HALF) = w; } }
    }
};
struct EpiResF32 {
    static constexpr bool PERM = false;
    const float* base; float* out;
    __device__ __forceinline__ void operator()(const f32x4 (&acc)[2][2][4][2], const Unit& u, int wr, int wc, int fr, int fq) const {
        const int row0 = u.pm * BM + wr * 64 + fr, col0 = u.pn * BM + wc * 32 + 4 * fq;
#pragma unroll
        for (int ai = 0; ai < 2; ++ai)
#pragma unroll
            for (int m = 0; m < 4; ++m) { const size_t off = (size_t)(row0 + ai * HALF + m * 16) * D + col0;
#pragma unroll
                for (int bj = 0; bj < 2; ++bj)
#pragma unroll
                    for (int n = 0; n < 2; ++n) { const f32x4 b = *(const f32x4*)(base + off + bj * HALF + n * 16); *(f32x4*)(out + off + bj * HALF + n * 16) = b + acc[ai][bj][m][n]; } }
    }
};
struct EpiSwiGLU {
    static constexpr bool PERM = true;
    bf16_t* hb;
    __device__ __forceinline__ void operator()(const f32x4 (&acc)[2][2][4][2], const Unit& u, int wr, int wc, int fr, int fq) const {
        const int row0 = u.pm * BM + wr * 64 + fr, col0 = (u.pn & 3) * 128 + wc * 32 + 8 * fq;
#pragma unroll
        for (int ai = 0; ai < 2; ++ai)
#pragma unroll
            for (int m = 0; m < 4; ++m) { float h[8];
#pragma unroll
                for (int n = 0; n < 2; ++n)
#pragma unroll
                    for (int j = 0; j < 4; ++j) { const float g = acc[ai][0][m][n][j], up = acc[ai][1][m][n][j]; h[n * 4 + j] = g * sigmoidf_(g) * up; }
                u32x4 w; w.x = pk2(h[0], h[1]); w.y = pk2(h[2], h[3]); w.z = pk2(h[4], h[5]); w.w = pk2(h[6], h[7]);
                *(u32x4*)(hb + (size_t)(row0 + ai * HALF + m * 16) * 512 + col0) = w; }
    }
};
struct EpiMoeDown {
    static constexpr bool PERM = true;
    bf16_t* ys;
    __device__ __forceinline__ void operator()(const f32x4 (&acc)[2][2][4][2], const Unit& u, int wr, int wc, int fr, int fq) const {
        const int row0 = u.pm * BM + wr * 64 + fr, col0 = (u.pn & 3) * BM + wc * 32 + 8 * fq;
#pragma unroll
        for (int ai = 0; ai < 2; ++ai)
#pragma unroll
            for (int m = 0; m < 4; ++m) { bf16_t* rowp = ys + (size_t)(row0 + ai * HALF + m * 16) * D + col0;
#pragma unroll
                for (int bj = 0; bj < 2; ++bj) { const f32x4 v0 = acc[ai][bj][m][0], v1 = acc[ai][bj][m][1];
                    u32x4 w; w.x = pk2(v0[0], v0[1]); w.y = pk2(v0[2], v0[3]); w.z = pk2(v1[0], v1[1]); w.w = pk2(v1[2], v1[3]);
                    *(u32x4*)(rowp + bj * HALF) = w; } }
    }
};

template <class Epi, class Sched, class AMap>
__device__ __forceinline__ void gemm_direct(const bf16_t* __restrict__ A, const bf16_t* __restrict__ Bt, int K, const Sched& S, const Epi& E, const AMap& AM) {
    const int tid = threadIdx.x, wid = __builtin_amdgcn_readfirstlane(tid >> 6), lane = tid & 63, wr = wid >> 2, wc = wid & 3, fr = lane & 15, fq = lane >> 4;
    Unit u;
    for (int i = 0; S.next(i, u); ++i) {
        f32x4 acc[2][2][4][2];
#pragma unroll
        for (int a = 0; a < 2; ++a)
#pragma unroll
            for (int b = 0; b < 2; ++b)
#pragma unroll
                for (int m = 0; m < 4; ++m)
#pragma unroll
                    for (int n = 0; n < 2; ++n) acc[a][b][m][n] = (f32x4){0.f, 0.f, 0.f, 0.f};
        const bf16_t* ap[2][4]; const bf16_t* bp[2][2];
#pragma unroll
        for (int ai = 0; ai < 2; ++ai)
#pragma unroll
            for (int m = 0; m < 4; ++m) ap[ai][m] = A + (size_t)AM.row(u, ai * HALF + wr * 64 + m * 16 + fr) * K + 8 * fq;
#pragma unroll
        for (int bj = 0; bj < 2; ++bj)
#pragma unroll
            for (int n = 0; n < 2; ++n) { const int rho = 16 * n + fr, rr = Epi::PERM ? perm32(rho) : rho; bp[bj][n] = Bt + (size_t)(u.pn * BM + bj * HALF + wc * 32 + rr) * K + 8 * fq; }
        for (int k0 = 0; k0 < K; k0 += 32) {
            bf16x8 af[2][4], bfr[2][2];
#pragma unroll
            for (int ai = 0; ai < 2; ++ai)
#pragma unroll
                for (int m = 0; m < 4; ++m) af[ai][m] = *(const bf16x8*)(ap[ai][m] + k0);
#pragma unroll
            for (int bj = 0; bj < 2; ++bj)
#pragma unroll
                for (int n = 0; n < 2; ++n) bfr[bj][n] = *(const bf16x8*)(bp[bj][n] + k0);
#pragma unroll
            for (int ai = 0; ai < 2; ++ai)
#pragma unroll
                for (int bj = 0; bj < 2; ++bj)
#pragma unroll
                    for (int m = 0; m < 4; ++m)
#pragma unroll
                        for (int n = 0; n < 2; ++n) acc[ai][bj][m][n] = __builtin_amdgcn_mfma_f32_16x16x32_bf16(bfr[bj][n], af[ai][m], acc[ai][bj][m][n], 0, 0, 0);
        }
        E(acc, u, wr, wc, fr, fq);
    }
}

__device__ __forceinline__ void tr_item(const float* __restrict__ W, int ldw, int k0, const float* __restrict__ gain, float scale, bf16_t* dst  , int Kd, LAS float* scr, int lane) {
#pragma unroll 8
    for (int i = 0; i < 32; ++i) { const int kk = 2 * i + (lane >> 5); float v = W[(size_t)(k0 + kk) * ldw + (lane & 31)]; const float g = gain ? gain[k0 + kk] : 1.f; scr[kk * 33 + (lane & 31)] = v * g * scale; }
    asm volatile("s_waitcnt lgkmcnt(0)" ::: "memory");
    const int c = lane & 7;
#pragma unroll
    for (int j = 0; j < 4; ++j) { const int n = (lane >> 3) + 8 * j; const LAS float* s = scr + (8 * c) * 33 + n;
        u32x4 o; o.x = pk2(s[0 * 33], s[1 * 33]); o.y = pk2(s[2 * 33], s[3 * 33]); o.z = pk2(s[4 * 33], s[5 * 33]); o.w = pk2(s[6 * 33], s[7 * 33]);
        *(u32x4*)(dst + (size_t)n * Kd + k0 + 8 * c) = o; }
    asm volatile("s_waitcnt lgkmcnt(0)" ::: "memory");
}
__device__ __forceinline__ void p0_weights(const Args& a, LAS unsigned char* lds, int gw, int NGW, int lane, int wave) {
    LAS float* scr = (LAS float*)(lds + wave * 16384);
    unsigned char* ws = a.ws;
    bf16_t* WIN = (bf16_t*)(ws + WS_WIN); bf16_t* WOUT = (bf16_t*)(ws + WS_WOUT); bf16_t* WKVQ = (bf16_t*)(ws + WS_WKVQ); bf16_t* WFO = (bf16_t*)(ws + WS_WFO);
    bf16_t* WEUP = (bf16_t*)(ws + WS_WEUP); bf16_t* WEDN = (bf16_t*)(ws + WS_WEDN);
    constexpr int I_IN = 16 * 96, I_OUT = 16 * 32, I_KV = 16 * 64, I_FQ = 16 * 32, I_FOG = 16 * 32, I_FO = 16 * 32;
    constexpr int I_SMALL = I_IN + I_OUT + I_KV + I_FQ + I_FOG + I_FO;
    constexpr int I_EG = 16 * 16, I_ED = 8 * 32;
    constexpr int I_EXP = 2 * I_EG + I_ED;
    constexpr int NITEMS = I_SMALL + 2 * NEXP * I_EXP;
    for (int it = gw; it < NITEMS; it += NGW) {
        int r = it;
        if (r < I_IN) { const int kb = r / 96, nb = r % 96; const int n0 = nb * 32; tr_item(a.in[2] + n0, 3088, kb * 64, a.in[1], n0 < 512 ? GLA_QSCALE : 1.f, WIN + (size_t)n0 * 1024, 1024, scr, lane); continue; } r -= I_IN;
        if (r < I_OUT) { const int kb = r / 32, n0 = (r % 32) * 32; tr_item(a.in[6] + n0, 1024, kb * 64, a.in[5], 1.f, WOUT + (size_t)n0 * 1024, 1024, scr, lane); continue; } r -= I_OUT;
        if (r < I_KV) { const int kb = r / 64, n0 = (r % 64) * 32; tr_item(a.in[8] + n0, 2064, kb * 64, a.in[7], 1.f, WKVQ + (size_t)n0 * 1024, 1024, scr, lane); continue; } r -= I_KV;
        if (r < I_FQ) { const int kb = r / 32, n0 = (r % 32) * 32; tr_item(a.in[11] + n0, 2048, kb * 64, a.in[10], ATT_C2, WKVQ + (size_t)(2048 + n0) * 1024, 1024, scr, lane); continue; } r -= I_FQ;
        if (r < I_FOG) { const int kb = r / 32, n0 = (r % 32) * 32; tr_item(a.in[11] + 1024 + n0, 2048, kb * 64, a.in[10], 1.f, WKVQ + (size_t)(3072 + n0) * 1024, 1024, scr, lane); continue; } r -= I_FOG;
        if (r < I_FO) { const int kb = r / 32, n0 = (r % 32) * 32; tr_item(a.in[12] + n0, 1024, kb * 64, nullptr, 1.f, WFO + (size_t)n0 * 1024, 1024, scr, lane); continue; } r -= I_FO;
        const int le = r / I_EXP, l = le / NEXP; int q = r % I_EXP;
        const float* gain = a.in[13] + l * 1024;
        if (q < 2 * I_EG) { const int up = q >= I_EG; if (up) q -= I_EG; const int kb = q / 16, n0 = (q % 16) * 32;
            const float* W = (up ? a.in[19] : a.in[18]) + (size_t)le * 1024 * 512 + n0;
            bf16_t* dst = WEUP + ((size_t)le * 1024 + (n0 >> 7) * 256 + up * 128 + (n0 & 127)) * 1024;
            tr_item(W, 512, kb * 64, gain, 1.f, dst, 1024, scr, lane); continue; }
        q -= 2 * I_EG;
        { const int kb = q / 32, n0 = (q % 32) * 32; tr_item(a.in[20] + (size_t)le * 512 * 1024 + n0, 1024, kb * 64, nullptr, 1.f, WEDN + ((size_t)le * 1024 + n0) * 512, 512, scr, lane); }
    }
    float* SK = (float*)(ws + WS_SKINNY);
    const int gt = gw * 64 + lane, NGT = NGW * 64;
    for (int i = gt; i < (16 + 36 + 36 + 16) * 1024; i += NGT) {
        const int n = i >> 10, k = i & 1023; float v;
        if (n < 16) v = a.in[1][k] * a.in[2][(size_t)k * 3088 + 3072 + n];
        else if (n < 52) { const int m = n - 16; v = a.in[13][k] * (m < 4 ? a.in[14][k * 4 + m] : a.in[16][k * 32 + (m - 4)]); }
        else if (n < 88) { const int m = n - 52; v = a.in[13][1024 + k] * (m < 4 ? a.in[14][4096 + k * 4 + m] : a.in[16][32768 + k * 32 + (m - 4)]); }
        else { const int m = n - 88; v = a.in[7][k] * a.in[8][(size_t)k * 2064 + 2048 + m]; }
        SK[i] = v;
    }
    if (blockIdx.x == 0 && threadIdx.x < 64) ((int*)(ws + WS_CTL))[threadIdx.x] = 0;
}

struct RowRegs { f32x4 v[4]; };
__device__ __forceinline__ RowRegs row_load(const float* p, int lane) { RowRegs r; const f32x4* q = (const f32x4*)p + lane;
#pragma unroll
    for (int j = 0; j < 4; ++j) r.v[j] = q[64 * j];
    return r; }
__device__ __forceinline__ float row_rs(const RowRegs& r) { float s = 0.f;
#pragma unroll
    for (int j = 0; j < 4; ++j) s += (r.v[j][0] * r.v[j][0] + r.v[j][1] * r.v[j][1]) + (r.v[j][2] * r.v[j][2] + r.v[j][3] * r.v[j][3]);
    return 1.0f / sqrtf(wave_sum(s) * (1.0f / 1024.0f) + RMS_EPS); }
__device__ __forceinline__ void row_store_bf16(bf16_t* p, const RowRegs& r, float rs, int lane) { u32x2* o = (u32x2*)p + lane;
#pragma unroll
    for (int j = 0; j < 4; ++j) { u32x2 w; w.x = pk2(r.v[j][0] * rs, r.v[j][1] * rs); w.y = pk2(r.v[j][2] * rs, r.v[j][3] * rs); o[64 * j] = w; } }
__device__ __forceinline__ float row_dot(const RowRegs& r, const float* w, int lane) { const f32x4* q = (const f32x4*)w + lane; float s = 0.f;
#pragma unroll
    for (int j = 0; j < 4; ++j) { const f32x4 x = q[64 * j]; s += (r.v[j][0] * x[0] + r.v[j][1] * x[1]) + (r.v[j][2] * x[2] + r.v[j][3] * x[3]); }
    return wave_sum(s); }
__device__ __forceinline__ void row_add_bf16(RowRegs& r, const bf16_t* p, float g, int lane) { const u32x2* q = (const u32x2*)p + lane;
#pragma unroll
    for (int j = 0; j < 4; ++j) { const u32x2 w = q[64 * j]; r.v[j][0] += g * bflo(w.x); r.v[j][1] += g * bfhi(w.x); r.v[j][2] += g * bflo(w.y); r.v[j][3] += g * bfhi(w.y); } }

__device__ __forceinline__ void p1_rows(const Args& a, int gw, int NGW, int lane) {
    bf16_t* XN = (bf16_t*)(a.ws + AB_XN); float* AA = (float*)(a.ws + AB_AA); const float* WA = (const float*)(a.ws + WS_SKINNY) + SK_WA;
    for (int t = gw; t < T; t += NGW) {
        const RowRegs r = row_load(a.in[0] + (size_t)t * D, lane); const float rs = row_rs(r);
        row_store_bf16(XN + (size_t)t * D, r, rs, lane);
        float mine = 0.f;
#pragma unroll
        for (int n = 0; n < 16; ++n) { const float d = row_dot(r, WA + n * 1024, lane) * rs; if (lane == n) mine = d; }
        if (lane < 16) AA[(size_t)t * 16 + lane] = mine;
    }
}

__device__ __forceinline__ void combine_row(RowRegs& r, const unsigned char* ws, const MoeTab& tab, int t, int lane) {
    const i32x4 ti = ((const i32x4*)(ws + AB_TOKI))[t]; const f32x2 tg = ((const f32x2*)(ws + AB_TOKG))[t];
    const bf16_t* YS = (const bf16_t*)(ws + AB_YS);
    const int p0 = tab.tstart[ti.x] * BM + ti.z, p1 = tab.tstart[ti.y] * BM + ti.w;
    row_add_bf16(r, YS + (size_t)p0 * D, tg.x, lane); row_add_bf16(r, YS + (size_t)p1 * D, tg.y, lane);
}
__device__ __forceinline__ void p10_rows(const Args& a, LAS unsigned char* lds, int layer, int gw, int NGW, int lane) {
    const MoeTab tab = moe_tab(lds); moe_tab_build(tab, (const int*)(a.ws + WS_CTL) + layer * 32);
    bf16_t* XN = (bf16_t*)(a.ws + AB_XN); float* LF = (float*)(a.ws + AB_LF); const float* WF = (const float*)(a.ws + WS_SKINNY) + SK_WF;
    for (int t = gw; t < T; t += NGW) {
        RowRegs r = row_load(a.out + (size_t)t * D, lane); combine_row(r, a.ws, tab, t, lane);
        f32x4* o = (f32x4*)(a.out + (size_t)t * D) + lane;
#pragma unroll
        for (int j = 0; j < 4; ++j) o[64 * j] = r.v[j];
        const float rs = row_rs(r); row_store_bf16(XN + (size_t)t * D, r, rs, lane);
        float mine = 0.f;
#pragma unroll
        for (int n = 0; n < 16; ++n) { const float d = row_dot(r, WF + n * 1024, lane) * rs; if (lane == n) mine = d; }
        if (lane < 16) LF[(size_t)t * 16 + lane] = log_sigmoid(mine + a.in[9][lane]);
    }
}
__device__ __forceinline__ void p17_rows(const Args& a, LAS unsigned char* lds, int layer, int gw, int NGW, int lane) {
    const MoeTab tab = moe_tab(lds); moe_tab_build(tab, (const int*)(a.ws + WS_CTL) + layer * 32);
    const f32x4* fn = (const f32x4*)a.in[21] + lane;
    for (int t = gw; t < T; t += NGW) {
        RowRegs r = row_load(a.out + (size_t)t * D, lane); combine_row(r, a.ws, tab, t, lane);
        const float rs = row_rs(r);
        f32x4* o = (f32x4*)(a.out + (size_t)t * D) + lane;
#pragma unroll
        for (int j = 0; j < 4; ++j) o[64 * j] = r.v[j] * rs * fn[64 * j];
    }
}

__device__ __forceinline__ void route_phase(const Args& a, LAS unsigned char* lds, int layer, int lane, int wave) {
    bf16_t* XN = (bf16_t*)(a.ws + AB_XN); const float* WR = (const float*)(a.ws + WS_SKINNY) + (layer ? SK_WR1 : SK_WR0);
    int* gcnt = (int*)(a.ws + WS_CTL) + layer * 32; int* LIST = (int*)(a.ws + AB_LIST); i32x4* TOKI = (i32x4*)(a.ws + AB_TOKI); f32x2* TOKG = (f32x2*)(a.ws + AB_TOKG);
    const float* bc = a.in[15] + layer * 4; const float* bfine = a.in[17] + layer * 32;
    LAS int* be = (LAS int*)(lds);
    LAS int* rk = be + 256;
    LAS int* lcnt = rk + 256;
    LAS int* lbase = lcnt + 32;
    LAS float* bg = (LAS float*)(lbase + 32);
    for (int batch = blockIdx.x; batch < T / 128; batch += gridDim.x) {
        if (threadIdx.x < 32) lcnt[threadIdx.x] = 0;
        for (int i = 0; i < 16; ++i) {
            const int lr = wave * 16 + i, t = batch * 128 + lr;
            const RowRegs r = row_load(a.out + (size_t)t * D, lane); const float rs = row_rs(r);
            row_store_bf16(XN + (size_t)t * D, r, rs, lane);
            float mine = 0.f;
#pragma unroll 2
            for (int n = 0; n < 36; ++n) { const float d = row_dot(r, WR + n * 1024, lane) * rs; if (lane == n) mine = d; }
            const float c0 = __shfl(mine, 0) + bc[0], c1 = __shfl(mine, 1) + bc[1], c2 = __shfl(mine, 2) + bc[2], c3 = __shfl(mine, 3) + bc[3];
            int gi = 0; float cm = c0; if (c1 > cm) { cm = c1; gi = 1; } if (c2 > cm) { cm = c2; gi = 2; } if (c3 > cm) { cm = c3; gi = 3; }
            const float pc = 1.f / (__expf(c0 - cm) + __expf(c1 - cm) + __expf(c2 - cm) + __expf(c3 - cm));
            float f[8];
#pragma unroll
            for (int j = 0; j < 8; ++j) f[j] = __shfl(mine, 4 + gi * 8 + j) + bfine[gi * 8 + j];
            int j0 = 0; float m0 = f[0];
#pragma unroll
            for (int j = 1; j < 8; ++j) if (f[j] > m0) { m0 = f[j]; j0 = j; }
            int j1 = -1; float m1 = -INFINITY;
#pragma unroll
            for (int j = 0; j < 8; ++j) if (j != j0 && f[j] > m1) { m1 = f[j]; j1 = j; }
            const float e1 = __expf(m1 - m0), inv = 1.f / (1.f + e1);
            if (lane == 0) { be[lr * 2] = gi * 8 + j0; be[lr * 2 + 1] = gi * 8 + j1; bg[lr * 2] = pc * inv; bg[lr * 2 + 1] = pc * e1 * inv; }
        }
        __syncthreads();
        if (threadIdx.x < 256) rk[threadIdx.x] = atomicAdd((int*)&lcnt[be[threadIdx.x]], 1);
        __syncthreads();
        if (threadIdx.x < 32) lbase[threadIdx.x] = lcnt[threadIdx.x] ? atomicAdd(&gcnt[threadIdx.x], lcnt[threadIdx.x]) : 0;
        __syncthreads();
        if (threadIdx.x < 256) { const int e = be[threadIdx.x], idx = lbase[e] + rk[threadIdx.x]; LIST[e * T + idx] = batch * 128 + (threadIdx.x >> 1); rk[threadIdx.x] = idx; }
        __syncthreads();
        if (threadIdx.x < 128) { const int lr = threadIdx.x; TOKI[batch * 128 + lr] = (i32x4){be[lr * 2], be[lr * 2 + 1], rk[lr * 2], rk[lr * 2 + 1]}; TOKG[batch * 128 + lr] = (f32x2){bg[lr * 2], bg[lr * 2 + 1]}; }
        __syncthreads();
    }
}

__device__ __forceinline__ void gla_alpha_naive(const Args& a) {
    const float* AA = (const float*)(a.ws + AB_AA); float* AL = (float*)(a.ws + AB_ALPHA); const float* w2 = a.in[3]; const float* ba = a.in[4];
    for (size_t i = (size_t)blockIdx.x * NTHREADS + threadIdx.x; i < (size_t)T * 512; i += (size_t)gridDim.x * NTHREADS) {
        const int t = (int)(i >> 9), hd = (int)(i & 511); float z = ba[hd];
#pragma unroll
        for (int r = 0; r < 16; ++r) z += AA[(size_t)t * 16 + r] * w2[r * 512 + hd];
        AL[i] = __expf(log_sigmoid(z) * (1.f / 16.f));
    }
}
__device__ __forceinline__ void gla_scan_naive(const Args& a, int gw, int NGW, int lane) {
    const bf16_t* __restrict__ Q = (const bf16_t*)(a.ws + AB_Q); const bf16_t* __restrict__ K = (const bf16_t*)(a.ws + AB_K); bf16_t* V = (bf16_t*)(a.ws + AB_V);
    const float* __restrict__ AL = (const float*)(a.ws + AB_ALPHA); float* SSQ = (float*)(a.ws + AB_SSQ);
    for (int item = gw; item < 256; item += NGW) {
        const int b = item >> 4, h = (item >> 2) & 3, sl = item & 3, e = h * 256 + sl * 64 + lane;
        float St[128];
#pragma unroll
        for (int d = 0; d < 128; ++d) St[d] = 0.f;
        for (int t = 0; t < SEQ; ++t) {
            const size_t row = (size_t)b * SEQ + t;
            const float v = bf2f(V[row * D + e]);
            const u32x4* qp = (const u32x4*)(Q + row * 512 + h * 128); const u32x4* kp = (const u32x4*)(K + row * 512 + h * 128); const f32x4* ap = (const f32x4*)(AL + row * 512 + h * 128);
            float o = 0.f;
#pragma unroll
            for (int c = 0; c < 16; ++c) { const u32x4 qw = qp[c], kw = kp[c]; const f32x4 a0 = ap[2 * c], a1 = ap[2 * c + 1];
                const float qf[8] = {bflo(qw.x), bfhi(qw.x), bflo(qw.y), bfhi(qw.y), bflo(qw.z), bfhi(qw.z), bflo(qw.w), bfhi(qw.w)};
                const float kf[8] = {bflo(kw.x), bfhi(kw.x), bflo(kw.y), bfhi(kw.y), bflo(kw.z), bfhi(kw.z), bflo(kw.w), bfhi(kw.w)};
                const float af[8] = {a0[0], a0[1], a0[2], a0[3], a1[0], a1[1], a1[2], a1[3]};
#pragma unroll
                for (int j = 0; j < 8; ++j) { const int d = c * 8 + j; St[d] = af[j] * St[d] + kf[j] * v; o += qf[j] * St[d]; } }
            V[row * D + e] = (bf16_t)f2bf(o);
            const float ss = wave_sum(o * o);
            if (lane == 0) SSQ[row * 16 + h * 4 + sl] = ss;
        }
    }
}
__device__ __forceinline__ void gla_post(const Args& a) {
    bf16_t* V = (bf16_t*)(a.ws + AB_V); const bf16_t* R = (const bf16_t*)(a.ws + AB_R); const float* SSQ = (const float*)(a.ws + AB_SSQ);
    for (size_t i = (size_t)blockIdx.x * NTHREADS + threadIdx.x; i < (size_t)T * 128; i += (size_t)gridDim.x * NTHREADS) {
        const size_t t = i >> 7; const int c8 = (int)(i & 127) * 8, h = c8 >> 8;
        const f32x4 sq = *(const f32x4*)(SSQ + t * 16 + h * 4);
        const float rstd = 1.0f / sqrtf(((sq[0] + sq[1]) + (sq[2] + sq[3])) * (1.f / 256.f) + RMS_EPS);
        const u32x4 ow = *(const u32x4*)(V + t * D + c8), rw = *(const u32x4*)(R + t * D + c8);
        const unsigned oo[4] = {ow.x, ow.y, ow.z, ow.w}, rr[4] = {rw.x, rw.y, rw.z, rw.w}; unsigned res[4];
#pragma unroll
        for (int j = 0; j < 4; ++j) { const float r0 = bflo(rr[j]), r1 = bfhi(rr[j]); res[j] = pk2(bflo(oo[j]) * rstd * r0 * sigmoidf_(r0), bfhi(oo[j]) * rstd * r1 * sigmoidf_(r1)); }
        *(u32x4*)(V + t * D + c8) = (u32x4){res[0], res[1], res[2], res[3]};
    }
}

__device__ __forceinline__ void fox_cumsum(const Args& a, int gw, int NGW, int lane) {
    const float* LF = (const float*)(a.ws + AB_LF); float* C = (float*)(a.ws + AB_C);
    for (int item = gw; item < 256; item += NGW) {
        const int b = item >> 4, h = item & 15; float loc[32]; float s = 0.f;
#pragma unroll
        for (int i = 0; i < 32; ++i) { s += LF[((size_t)b * SEQ + lane * 32 + i) * 16 + h]; loc[i] = s; }
        float incl = s;
#pragma unroll
        for (int o = 1; o < 64; o <<= 1) { const float n = __shfl_up(incl, o); if (lane >= o) incl += n; }
        const float excl = incl - s;
#pragma unroll
        for (int i = 0; i < 32; ++i) C[(size_t)item * SEQ + lane * 32 + i] = loc[i] + excl;
    }
}
__device__ __forceinline__ void fox_attn_naive(const Args& a, int gw, int NGW, int lane) {
    bf16_t* Q = (bf16_t*)(a.ws + AB_FQ); const bf16_t* __restrict__ K = (const bf16_t*)(a.ws + AB_FK); const bf16_t* __restrict__ V = (const bf16_t*)(a.ws + AB_FV);
    const bf16_t* __restrict__ OG = (const bf16_t*)(a.ws + AB_FOG); const float* __restrict__ C = (const float*)(a.ws + AB_C);
    for (int item = gw; item < 8192; item += NGW) {
        const int bh = item >> 5, tb = item & 31, b = bh >> 4, h = bh & 15, t = tb * 64 + lane;
        const size_t row = (size_t)b * SEQ + t;
        float q[64], o[64];
#pragma unroll
        for (int c = 0; c < 8; ++c) { const u32x4 w = *(const u32x4*)(Q + row * D + h * 64 + c * 8); q[c * 8 + 0] = bflo(w.x); q[c * 8 + 1] = bfhi(w.x); q[c * 8 + 2] = bflo(w.y); q[c * 8 + 3] = bfhi(w.y); q[c * 8 + 4] = bflo(w.z); q[c * 8 + 5] = bfhi(w.z); q[c * 8 + 6] = bflo(w.w); q[c * 8 + 7] = bfhi(w.w); }
#pragma unroll
        for (int d = 0; d < 64; ++d) o[d] = 0.f;
        float m = -INFINITY, l = 0.f; const float cref = C[(size_t)bh * SEQ + tb * 64 + 63];
        const int smax = tb * 64 + 63;
        for (int s = 0; s <= smax; ++s) {
            const size_t krow = (size_t)b * SEQ + s; float x = 0.f;
#pragma unroll
            for (int c = 0; c < 8; ++c) { const u32x4 w = *(const u32x4*)(K + krow * D + h * 64 + c * 8);
                x += q[c * 8 + 0] * bflo(w.x) + q[c * 8 + 1] * bfhi(w.x) + q[c * 8 + 2] * bflo(w.y) + q[c * 8 + 3] * bfhi(w.y) + q[c * 8 + 4] * bflo(w.z) + q[c * 8 + 5] * bfhi(w.z) + q[c * 8 + 6] * bflo(w.w) + q[c * 8 + 7] * bfhi(w.w); }
            x += (cref - C[(size_t)bh * SEQ + s]) * LOG2E;
            if (s > t) x = -INFINITY;
            const float mn = fmaxf(m, x); const float sc = (mn == -INFINITY) ? 1.f : exp2f(m - mn), p = (mn == -INFINITY) ? 0.f : exp2f(x - mn);
            m = mn; l = l * sc + p;
#pragma unroll
            for (int c = 0; c < 8; ++c) { const u32x4 w = *(const u32x4*)(V + krow * D + h * 64 + c * 8);
                const float vv[8] = {bflo(w.x), bfhi(w.x), bflo(w.y), bfhi(w.y), bflo(w.z), bfhi(w.z), bflo(w.w), bfhi(w.w)};
#pragma unroll
                for (int j = 0; j < 8; ++j) o[c * 8 + j] = o[c * 8 + j] * sc + p * vv[j]; }
        }
        const float il = 1.f / l;
#pragma unroll
        for (int c = 0; c < 8; ++c) { const u32x4 g = *(const u32x4*)(OG + row * D + h * 64 + c * 8); const unsigned gg[4] = {g.x, g.y, g.z, g.w}; unsigned res[4];
#pragma unroll
            for (int j = 0; j < 4; ++j) res[j] = pk2(o[c * 8 + 2 * j] * il * sigmoidf_(bflo(gg[j])), o[c * 8 + 2 * j + 1] * il * sigmoidf_(bfhi(gg[j])));
            *(u32x4*)(Q + row * D + h * 64 + c * 8) = (u32x4){res[0], res[1], res[2], res[3]}; }
    }
}

constexpr int NPHASES = 18;
__global__ void __launch_bounds__(NTHREADS, 2) fwd(Args a) {
    extern __shared__ __attribute__((aligned(16))) unsigned char lds_raw[];
    LAS unsigned char* lds = (LAS unsigned char*)lds_raw;
    cg::grid_group grid = cg::this_grid();
    const int tid = threadIdx.x, lane = tid & 63, wave = __builtin_amdgcn_readfirstlane(tid >> 6);
    const int G = gridDim.x, gw = blockIdx.x * NWAVES + wave, NGW = G * NWAVES;
    unsigned char* ws = a.ws;
    const int lo = a.ph_lo, hi = a.ph_hi;
#ifdef ONLY_PHASE
#define IN(k) ((k) == ONLY_PHASE && lo <= (k) && (k) < hi)
#else
#define IN(k) (lo <= (k) && (k) < hi)
#endif
#define SEAM(k) do { if (IN(k) && IN((k) + 1)) grid.sync(); } while (0)
    if (IN(0)) { p0_weights(a, lds, gw, NGW, lane, wave); } SEAM(0);
    if (IN(1)) { p1_rows(a, gw, NGW, lane); } SEAM(1);
    if (IN(2)) {
        StaticOrder S; S.init(T, 3072, G, blockIdx.x);
        EpiSplitBf16<0> E{ws};
        gemm_direct((const bf16_t*)(ws + AB_XN), (const bf16_t*)(ws + WS_WIN), 1024, S, E, IdMap{});
    } SEAM(2);
    if (IN(3)) { gla_alpha_naive(a); } SEAM(3);
    if (IN(4)) { gla_scan_naive(a, gw, NGW, lane); } SEAM(4);
    if (IN(5)) { gla_post(a); } SEAM(5);
    if (IN(6)) {
        StaticOrder S; S.init(T, 1024, G, blockIdx.x); EpiResF32 E{a.in[0], a.out};
        gemm_direct((const bf16_t*)(ws + AB_V), (const bf16_t*)(ws + WS_WOUT), 1024, S, E, IdMap{});
    } SEAM(6);
#define MOE_PHASES(layer, pb) \
    if (IN(pb)) { route_phase(a, lds, layer, lane, wave); } SEAM(pb); \
    if (IN(pb + 1)) { \
        const MoeTab tab = moe_tab(lds); moe_tab_build(tab, (const int*)(ws + WS_CTL) + layer * 32); \
        MoeOrder S; S.so.init(tab.tstart[32] * BM, 1024, G, blockIdx.x); S.tab = tab; \
        MoeGather AM{tab, (const int*)(ws + AB_LIST)}; EpiSwiGLU E{(bf16_t*)(ws + AB_HB)}; \
        gemm_direct((const bf16_t*)(ws + AB_XN), (const bf16_t*)(ws + WS_WEUP) + (size_t)layer * 32 * 1024 * 1024, 1024, S, E, AM); \
        __syncthreads(); \
    } SEAM(pb + 1); \
    if (IN(pb + 2)) { \
        const MoeTab tab = moe_tab(lds); moe_tab_build(tab, (const int*)(ws + WS_CTL) + layer * 32); \
        MoeOrder S; S.so.init(tab.tstart[32] * BM, 1024, G, blockIdx.x); S.tab = tab; \
        EpiMoeDown E{(bf16_t*)(ws + AB_YS)}; \
        gemm_direct((const bf16_t*)(ws + AB_HB), (const bf16_t*)(ws + WS_WEDN) + (size_t)layer * 32 * 1024 * 512, 512, S, E, IdMap{}); \
        __syncthreads(); \
    } SEAM(pb + 2);
    MOE_PHASES(0, 7)
    if (IN(10)) { p10_rows(a, lds, 0, gw, NGW, lane); __syncthreads(); } SEAM(10);
    if (IN(11)) {
        fox_cumsum(a, gw, NGW, lane);
        StaticOrder S; S.init(T, 4096, G, blockIdx.x);
        EpiSplitBf16<1> E{ws};
        gemm_direct((const bf16_t*)(ws + AB_XN), (const bf16_t*)(ws + WS_WKVQ), 1024, S, E, IdMap{});
    } SEAM(11);
    if (IN(12)) { fox_attn_naive(a, gw, NGW, lane); } SEAM(12);
    if (IN(13)) {
        StaticOrder S; S.init(T, 1024, G, blockIdx.x); EpiResF32 E{a.out, a.out};
        gemm_direct((const bf16_t*)(ws + AB_FQ), (const bf16_t*)(ws + WS_WFO), 1024, S, E, IdMap{});
    } SEAM(13);
    MOE_PHASES(1, 14)
    if (IN(17)) { p17_rows(a, lds, 1, gw, NGW, lane); }
#undef IN
#undef SEAM
}

#ifndef ONE_LAUNCH
#define ONE_LAUNCH 0
#endif
extern "C" void kernel_launch(void* const* d_in, const int* in_sizes, int n_in, void* d_out, int out_size, void* d_ws, size_t ws_size, hipStream_t stream) {
    static int grid = 0;
    if (grid == 0) {
        if (n_in != 22 || out_size != T * D || ws_size < WS_END) { fprintf(stderr, "kernel_launch: unexpected shapes (n_in %d, out %d, ws %zu < %zu)\n", n_in, out_size, ws_size, (size_t)WS_END); grid = -1; return; }
        int dev = 0, cus = 0, per_cu = 0;
        hipGetDevice(&dev); hipDeviceGetAttribute(&cus, hipDeviceAttributeMultiprocessorCount, dev);
        hipFuncSetAttribute((const void*)fwd, hipFuncAttributeMaxDynamicSharedMemorySize, LDS_BYTES);
        hipOccupancyMaxActiveBlocksPerMultiprocessor(&per_cu, (const void*)fwd, NTHREADS, LDS_BYTES);
        if (per_cu < 1) { fprintf(stderr, "kernel_launch: occupancy query says %d blocks per CU\n", per_cu); grid = -1; return; }
        grid = cus;
        fprintf(stderr, "kernel_launch: grid %d (per_cu %d), ws %zu\n", grid, per_cu, ws_size);
    }
    if (grid < 0) return;
    Args a{};
    for (int i = 0; i < 22; ++i) a.in[i] = (const float*)d_in[i];
    a.out = (float*)d_out; a.ws = (unsigned char*)d_ws;
#if ONE_LAUNCH
    a.ph_lo = 0; a.ph_hi = NPHASES;
    void* args[] = {&a};
    hipError_t e = hipLaunchCooperativeKernel((const void*)fwd, dim3(grid), dim3(NTHREADS), args, LDS_BYTES, stream);
    if (e != hipSuccess) fprintf(stderr, "cooperative launch failed: %s\n", hipGetErrorString(e));
#else
    for (int p = 0; p < NPHASES; ++p) {
        a.ph_lo = p; a.ph_hi = p + 1;
        hipLaunchKernelGGL(fwd, dim3(grid), dim3(NTHREADS), LDS_BYTES, stream, a);
    }
#endif
}
```

```cpp
#include <hip/hip_runtime.h>
#include <hip/hip_cooperative_groups.h>
#include <cstdio>
#include <cstdint>
namespace cg = cooperative_groups;

#define LAS __attribute__((address_space(3)))
typedef unsigned short bf16_t;
typedef short bf16x8 __attribute__((ext_vector_type(8)));
typedef float f32x4 __attribute__((ext_vector_type(4)));
typedef float f32x2 __attribute__((ext_vector_type(2)));
typedef unsigned u32x4 __attribute__((ext_vector_type(4)));
typedef unsigned u32x2 __attribute__((ext_vector_type(2)));
typedef int i32x4 __attribute__((ext_vector_type(4)));

constexpr int T = 32768, D = 1024, NBATCH = 16, SEQ = 2048;
constexpr int NWAVES = 8, NTHREADS = 512;
constexpr float RMS_EPS = 1e-6f;
constexpr float LOG2E = 1.4426950408889634f;
constexpr float ATT_C2 = 0.125f * LOG2E;
constexpr float GLA_QSCALE = 0.08838834764831845f;
constexpr int NEXP = 32;
constexpr int MAXTILES = 288;

constexpr size_t MiB = 1u << 20;
constexpr size_t WS_CTL = 0;
constexpr size_t WS_SKINNY = 256 * 1024;
constexpr size_t WS_WIN = 1 * MiB;
constexpr size_t WS_WOUT = WS_WIN + 6 * MiB;
constexpr size_t WS_WKVQ = WS_WOUT + 2 * MiB;
constexpr size_t WS_WFO = WS_WKVQ + 8 * MiB;
constexpr size_t WS_WEUP = WS_WFO + 2 * MiB;
constexpr size_t WS_WEDN = WS_WEUP + 128 * MiB;
constexpr size_t WS_AB = WS_WEDN + 64 * MiB;
constexpr size_t AB_XN = WS_AB;
constexpr size_t AB_Q = WS_AB + 64 * MiB;
constexpr size_t AB_K = WS_AB + 96 * MiB;
constexpr size_t AB_V = WS_AB + 128 * MiB;
constexpr size_t AB_R = WS_AB + 192 * MiB;
constexpr size_t AB_KHT = WS_AB + 256 * MiB;
constexpr size_t AB_PM = WS_AB + 288 * MiB;
constexpr size_t AB_EL = WS_AB + 304 * MiB;
constexpr size_t AB_AA = WS_AB + 305 * MiB;
constexpr size_t AB_SSQ = WS_AB + 307 * MiB;
constexpr size_t AB_ALPHA = AB_XN;
constexpr size_t AB_HB = WS_AB + 64 * MiB;
constexpr size_t AB_YS = WS_AB + 136 * MiB;
constexpr size_t AB_LIST = WS_AB + 280 * MiB;
constexpr size_t AB_TOKI = WS_AB + 284 * MiB;
constexpr size_t AB_TOKG = WS_AB + 285 * MiB;
constexpr size_t AB_FK = WS_AB + 64 * MiB;
constexpr size_t AB_FV = WS_AB + 128 * MiB;
constexpr size_t AB_FQ = WS_AB + 192 * MiB;
constexpr size_t AB_FOG = WS_AB + 256 * MiB;
constexpr size_t AB_LF = WS_AB + 320 * MiB;
constexpr size_t AB_C = WS_AB + 322 * MiB;
constexpr size_t WS_END = WS_AB + 324 * MiB;

constexpr int SK_WA = 0, SK_WR0 = 16 * 1024, SK_WR1 = SK_WR0 + 36 * 1024, SK_WF = SK_WR1 + 36 * 1024;

constexpr int RING_BYTES = 131072;
constexpr int LDS_MISC = RING_BYTES;
constexpr int LDS_BYTES = 147456;

__device__ __forceinline__ unsigned f2bf(float f) { unsigned u = __builtin_bit_cast(unsigned, f); return (u + 0x7fffu + ((u >> 16) & 1u)) >> 16; }
__device__ __forceinline__ unsigned pk2(float lo, float hi) { return f2bf(lo) | (f2bf(hi) << 16); }
__device__ __forceinline__ float bf2f(unsigned h) { return __builtin_bit_cast(float, h << 16); }
__device__ __forceinline__ float bflo(unsigned w) { return __builtin_bit_cast(float, w << 16); }
__device__ __forceinline__ float bfhi(unsigned w) { return __builtin_bit_cast(float, w & 0xffff0000u); }
__device__ __forceinline__ float wave_sum(float v) {
#pragma unroll
    for (int o = 1; o < 64; o <<= 1) v += __shfl_xor(v, o);
    return v;
}
__device__ __forceinline__ float log_sigmoid(float z) { return fminf(z, 0.f) - log1pf(__expf(-fabsf(z))); }
__device__ __forceinline__ float sigmoidf_(float z) { return 1.f / (1.f + __expf(-z)); }
__device__ __forceinline__ int perm32(int rho) { const int n = rho >> 4, i = rho & 15; return 8 * (i >> 2) + 4 * n + (i & 3); }

struct Args { const float* in[22]; float* out; unsigned char* ws; int ph_lo, ph_hi; };

struct Unit { int pm, pn; };
constexpr int BM = 256, HALF = 128, NXCD = 8, WGM = 8;
struct StaticOrder {
    int nM, nN, nwg, G, c;
    __device__ void init(int M, int N, int G_, int c_) { nM = M / BM; nN = N / BM; nwg = nM * nN; G = G_; c = c_; }
    __device__ bool next(int i, Unit& u) const {
        const long L = (long)i * G + c; if (L >= nwg) return false;
        int wgid = (int)L; { const int q = nwg / NXCD, r = nwg % NXCD, xcd = wgid % NXCD, off = wgid / NXCD; wgid = (xcd < r ? xcd * (q + 1) : r * (q + 1) + (xcd - r) * q) + off; }
        const int nig = WGM * nN, gid = wgid / nig, fm = gid * WGM, gsz = (nM - fm) < WGM ? (nM - fm) : WGM;
        u.pm = fm + ((wgid % nig) % gsz); u.pn = (wgid % nig) / gsz; return true;
    }
};
struct IdMap { __device__ __forceinline__ int row(const Unit& u, int r) const { return u.pm * BM + r; } };

struct MoeTab { LAS int* cnt; LAS int* tstart; LAS int* tile_e; };
__device__ __forceinline__ MoeTab moe_tab(LAS unsigned char* lds) { MoeTab t; t.cnt = (LAS int*)(lds + LDS_MISC); t.tstart = t.cnt + 32; t.tile_e = t.tstart + 64; return t; }
__device__ __forceinline__ void moe_tab_build(const MoeTab& t, const int* gcnt) {
    if (threadIdx.x == 0) { int s = 0; for (int e = 0; e < NEXP; ++e) { const int c = gcnt[e]; t.cnt[e] = c; t.tstart[e] = s; s += (c + 255) >> 8; } t.tstart[32] = s; }
    __syncthreads();
    const int nt = t.tstart[32];
    for (int p = threadIdx.x; p < nt; p += NTHREADS) { int e = 0; for (int j = 1; j < NEXP; ++j) if (t.tstart[j] <= p) e = j; t.tile_e[p] = e; }
    __syncthreads();
}
struct MoeOrder {
    StaticOrder so; MoeTab tab;
    __device__ bool next(int i, Unit& u) const { if (!so.next(i, u)) return false; u.pn += 4 * tab.tile_e[u.pm]; return true; }
};
struct MoeGather {
    MoeTab tab; const int* list;
    __device__ __forceinline__ int row(const Unit& u, int r) const {
        const int e = u.pn >> 2; int idx = (u.pm - tab.tstart[e]) * BM + r; const int c = tab.cnt[e]; idx = idx < c ? idx : c - 1; return list[e * T + idx];
    }
};

template <int WHICH> struct EpiSplitBf16 {
    static constexpr bool PERM = true;
    unsigned char* ws;
    __device__ __forceinline__ void operator()(const f32x4 (&acc)[2][2][4][2], const Unit& u, int wr, int wc, int fr, int fq) const {
        size_t off; int ldc, f0;
        if (WHICH == 0) { if (u.pn < 2) { off = AB_Q; ldc = 512; f0 = 0; } else if (u.pn < 4) { off = AB_K; ldc = 512; f0 = 2; } else if (u.pn < 8) { off = AB_V; ldc = 1024; f0 = 4; } else { off = AB_R; ldc = 1024; f0 = 8; } }
        else { off = AB_FK + (size_t)(u.pn >> 2) * (64 * MiB); ldc = 1024; f0 = u.pn & ~3; }
        bf16_t* base = (bf16_t*)(ws + off);
        const int row0 = u.pm * BM + wr * 64 + fr, col0 = (u.pn - f0) * BM + wc * 32 + 8 * fq;
#pragma unroll
        for (int ai = 0; ai < 2; ++ai)
#pragma unroll
            for (int m = 0; m < 4; ++m) { bf16_t* rowp = base + (size_t)(row0 + ai * HALF + m * 16) * ldc + col0;
#pragma unroll
                for (int bj = 0; bj < 2; ++bj) { const f32x4 v0 = acc[ai][bj][m][0], v1 = acc[ai][bj][m][1];
                    u32x4 w; w.x = pk2(v0[0], v0[1]); w.y = pk2(v0[2], v0[3]); w.z = pk2(v1[0], v1[1]); w.w = pk2(v1[2], v1[3]);
                    *(u32x4*)(rowp + bj * HALF) = w; } }
    }
};
struct EpiResF32 {
    static constexpr bool PERM = false;
    const float* base; float* out;
    __device__ __forceinline__ void operator()(const f32x4 (&acc)[2][2][4][2], const Unit& u, int wr, int wc, int fr, int fq) const {
        const int row0 = u.pm * BM + wr * 64 + fr, col0 = u.pn * BM + wc * 32 + 4 * fq;
#pragma unroll
        for (int ai = 0; ai < 2; ++ai)
#pragma unroll
            for (int m = 0; m < 4; ++m) { const size_t off = (size_t)(row0 + ai * HALF + m * 16) * D + col0;
#pragma unroll
                for (int bj = 0; bj < 2; ++bj)
#pragma unroll
                    for (int n = 0; n < 2; ++n) { const f32x4 b = *(const f32x4*)(base + off + bj * HALF + n * 16); *(f32x4*)(out + off + bj * HALF + n * 16) = b + acc[ai][bj][m][n]; } }
    }
};
struct EpiSwiGLU {
    static constexpr bool PERM = true;
    bf16_t* hb;
    __device__ __forceinline__ void operator()(const f32x4 (&acc)[2][2][4][2], const Unit& u, int wr, int wc, int fr, int fq) const {
        const int row0 = u.pm * BM + wr * 64 + fr, col0 = (u.pn & 3) * 128 + wc * 32 + 8 * fq;
#pragma unroll
        for (int ai = 0; ai < 2; ++ai)
#pragma unroll
            for (int m = 0; m < 4; ++m) { float h[8];
#pragma unroll
                for (int n = 0; n < 2; ++n)
#pragma unroll
                    for (int j = 0; j < 4; ++j) { const float g = acc[ai][0][m][n][j], up = acc[ai][1][m][n][j]; h[n * 4 + j] = g * sigmoidf_(g) * up; }
                u32x4 w; w.x = pk2(h[0], h[1]); w.y = pk2(h[2], h[3]); w.z = pk2(h[4], h[5]); w.w = pk2(h[6], h[7]);
                *(u32x4*)(hb + (size_t)(row0 + ai * HALF + m * 16) * 512 + col0) = w; }
    }
};
struct EpiMoeDown {
    static constexpr bool PERM = true;
    bf16_t* ys;
    __device__ __forceinline__ void operator()(const f32x4 (&acc)[2][2][4][2], const Unit& u, int wr, int wc, int fr, int fq) const {
        const int row0 = u.pm * BM + wr * 64 + fr, col0 = (u.pn & 3) * BM + wc * 32 + 8 * fq;
#pragma unroll
        for (int ai = 0; ai < 2; ++ai)
#pragma unroll
            for (int m = 0; m < 4; ++m) { bf16_t* rowp = ys + (size_t)(row0 + ai * HALF + m * 16) * D + col0;
#pragma unroll
                for (int bj = 0; bj < 2; ++bj) { const f32x4 v0 = acc[ai][bj][m][0], v1 = acc[ai][bj][m][1];
                    u32x4 w; w.x = pk2(v0[0], v0[1]); w.y = pk2(v0[2], v0[3]); w.z = pk2(v1[0], v1[1]); w.w = pk2(v1[2], v1[3]);
                    *(u32x4*)(rowp + bj * HALF) = w; } }
    }
};

template <class Epi, class Sched, class AMap>
__device__ __forceinline__ void gemm_direct(const bf16_t* __restrict__ A, const bf16_t* __restrict__ Bt, int K, const Sched& S, const Epi& E, const AMap& AM) {
    const int tid = threadIdx.x, wid = __builtin_amdgcn_readfirstlane(tid >> 6), lane = tid & 63, wr = wid >> 2, wc = wid & 3, fr = lane & 15, fq = lane >> 4;
    Unit u;
    for (int i = 0; S.next(i, u); ++i) {
        f32x4 acc[2][2][4][2];
#pragma unroll
        for (int a = 0; a < 2; ++a)
#pragma unroll
            for (int b = 0; b < 2; ++b)
#pragma unroll
                for (int m = 0; m < 4; ++m)
#pragma unroll
                    for (int n = 0; n < 2; ++n) acc[a][b][m][n] = (f32x4){0.f, 0.f, 0.f, 0.f};
        const bf16_t* ap[2][4]; const bf16_t* bp[2][2];
#pragma unroll
        for (int ai = 0; ai < 2; ++ai)
#pragma unroll
            for (int m = 0; m < 4; ++m) ap[ai][m] = A + (size_t)AM.row(u, ai * HALF + wr * 64 + m * 16 + fr) * K + 8 * fq;
#pragma unroll
        for (int bj = 0; bj < 2; ++bj)
#pragma unroll
            for (int n = 0; n < 2; ++n) { const int rho = 16 * n + fr, rr = Epi::PERM ? perm32(rho) : rho; bp[bj][n] = Bt + (size_t)(u.pn * BM + bj * HALF + wc * 32 + rr) * K + 8 * fq; }
        for (int k0 = 0; k0 < K; k0 += 32) {
            bf16x8 af[2][4], bfr[2][2];
#pragma unroll
            for (int ai = 0; ai < 2; ++ai)
#pragma unroll
                for (int m = 0; m < 4; ++m) af[ai][m] = *(const bf16x8*)(ap[ai][m] + k0);
#pragma unroll
            for (int bj = 0; bj < 2; ++bj)
#pragma unroll
                for (int n = 0; n < 2; ++n) bfr[bj][n] = *(const bf16x8*)(bp[bj][n] + k0);
#pragma unroll
            for (int ai = 0; ai < 2; ++ai)
#pragma unroll
                for (int bj = 0; bj < 2; ++bj)
#pragma unroll
                    for (int m = 0; m < 4; ++m)
#pragma unroll
                        for (int n = 0; n < 2; ++n) acc[ai][bj][m][n] = __builtin_amdgcn_mfma_f32_16x16x32_bf16(bfr[bj][n], af[ai][m], acc[ai][bj][m][n], 0, 0, 0);
        }
        E(acc, u, wr, wc, fr, fq);
    }
}

__device__ __forceinline__ void tr_item(const float* __restrict__ W, int ldw, int k0, const float* __restrict__ gain, float scale, bf16_t* dst  , int Kd, LAS float* scr, int lane) {
#pragma unroll 8
    for (int i = 0; i < 32; ++i) { const int kk = 2 * i + (lane >> 5); float v = W[(size_t)(k0 + kk) * ldw + (lane & 31)]; const float g = gain ? gain[k0 + kk] : 1.f; scr[kk * 33 + (lane & 31)] = v * g * scale; }
    asm volatile("s_waitcnt lgkmcnt(0)" ::: "memory");
    const int c = lane & 7;
#pragma unroll
    for (int j = 0; j < 4; ++j) { const int n = (lane >> 3) + 8 * j; const LAS float* s = scr + (8 * c) * 33 + n;
        u32x4 o; o.x = pk2(s[0 * 33], s[1 * 33]); o.y = pk2(s[2 * 33], s[3 * 33]); o.z = pk2(s[4 * 33], s[5 * 33]); o.w = pk2(s[6 * 33], s[7 * 33]);
        *(u32x4*)(dst + (size_t)n * Kd + k0 + 8 * c) = o; }
    asm volatile("s_waitcnt lgkmcnt(0)" ::: "memory");
}
__device__ __forceinline__ void p0_weights(const Args& a, LAS unsigned char* lds, int gw, int NGW, int lane, int wave) {
    LAS float* scr = (LAS float*)(lds + wave * 16384);
    unsigned char* ws = a.ws;
    bf16_t* WIN = (bf16_t*)(ws + WS_WIN); bf16_t* WOUT = (bf16_t*)(ws + WS_WOUT); bf16_t* WKVQ = (bf16_t*)(ws + WS_WKVQ); bf16_t* WFO = (bf16_t*)(ws + WS_WFO);
    bf16_t* WEUP = (bf16_t*)(ws + WS_WEUP); bf16_t* WEDN = (bf16_t*)(ws + WS_WEDN);
    constexpr int I_IN = 16 * 96, I_OUT = 16 * 32, I_KV = 16 * 64, I_FQ = 16 * 32, I_FOG = 16 * 32, I_FO = 16 * 32;
    constexpr int I_SMALL = I_IN + I_OUT + I_KV + I_FQ + I_FOG + I_FO;
    constexpr int I_EG = 16 * 16, I_ED = 8 * 32;
    constexpr int I_EXP = 2 * I_EG + I_ED;
    constexpr int NITEMS = I_SMALL + 2 * NEXP * I_EXP;
    for (int it = gw; it < NITEMS; it += NGW) {
        int r = it;
        if (r < I_IN) { const int kb = r / 96, nb = r % 96; const int n0 = nb * 32; tr_item(a.in[2] + n0, 3088, kb * 64, a.in[1], n0 < 512 ? GLA_QSCALE : 1.f, WIN + (size_t)n0 * 1024, 1024, scr, lane); continue; } r -= I_IN;
        if (r < I_OUT) { const int kb = r / 32, n0 = (r % 32) * 32; tr_item(a.in[6] + n0, 1024, kb * 64, a.in[5], 1.f, WOUT + (size_t)n0 * 1024, 1024, scr, lane); continue; } r -= I_OUT;
        if (r < I_KV) { const int kb = r / 64, n0 = (r % 64) * 32; tr_item(a.in[8] + n0, 2064, kb * 64, a.in[7], 1.f, WKVQ + (size_t)n0 * 1024, 1024, scr, lane); continue; } r -= I_KV;
        if (r < I_FQ) { const int kb = r / 32, n0 = (r % 32) * 32; tr_item(a.in[11] + n0, 2048, kb * 64, a.in[10], ATT_C2, WKVQ + (size_t)(2048 + n0) * 1024, 1024, scr, lane); continue; } r -= I_FQ;
        if (r < I_FOG) { const int kb = r / 32, n0 = (r % 32) * 32; tr_item(a.in[11] + 1024 + n0, 2048, kb * 64, a.in[10], 1.f, WKVQ + (size_t)(3072 + n0) * 1024, 1024, scr, lane); continue; } r -= I_FOG;
        if (r < I_FO) { const int kb = r / 32, n0 = (r % 32) * 32; tr_item(a.in[12] + n0, 1024, kb * 64, nullptr, 1.f, WFO + (size_t)n0 * 1024, 1024, scr, lane); continue; } r -= I_FO;
        const int le = r / I_EXP, l = le / NEXP; int q = r % I_EXP;
        const float* gain = a.in[13] + l * 1024;
        if (q < 2 * I_EG) { const int up = q >= I_EG; if (up) q -= I_EG; const int kb = q / 16, n0 = (q % 16) * 32;
            const float* W = (up ? a.in[19] : a.in[18]) + (size_t)le * 1024 * 512 + n0;
            bf16_t* dst = WEUP + ((size_t)le * 1024 + (n0 >> 7) * 256 + up * 128 + (n0 & 127)) * 1024;
            tr_item(W, 512, kb * 64, gain, 1.f, dst, 1024, scr, lane); continue; }
        q -= 2 * I_EG;
        { const int kb = q / 32, n0 = (q % 32) * 32; tr_item(a.in[20] + (size_t)le * 512 * 1024 + n0, 1024, kb * 64, nullptr, 1.f, WEDN + ((size_t)le * 1024 + n0) * 512, 512, scr, lane); }
    }
    float* SK = (float*)(ws + WS_SKINNY);
    const int gt = gw * 64 + lane, NGT = NGW * 64;
    for (int i = gt; i < (16 + 36 + 36 + 16) * 1024; i += NGT) {
        const int n = i >> 10, k = i & 1023; float v;
        if (n < 16) v = a.in[1][k] * a.in[2][(size_t)k * 3088 + 3072 + n];
        else if (n < 52) { const int m = n - 16; v = a.in[13][k] * (m < 4 ? a.in[14][k * 4 + m] : a.in[16][k * 32 + (m - 4)]); }
        else if (n < 88) { const int m = n - 52; v = a.in[13][1024 + k] * (m < 4 ? a.in[14][4096 + k * 4 + m] : a.in[16][32768 + k * 32 + (m - 4)]); }
        else { const int m = n - 88; v = a.in[7][k] * a.in[8][(size_t)k * 2064 + 2048 + m]; }
        SK[i] = v;
    }
    if (blockIdx.x == 0 && threadIdx.x < 64) ((int*)(ws + WS_CTL))[threadIdx.x] = 0;
}

struct RowRegs { f32x4 v[4]; };
__device__ __forceinline__ RowRegs row_load(const float* p, int lane) { RowRegs r; const f32x4* q = (const f32x4*)p + lane;
#pragma unroll
    for (int j = 0; j < 4; ++j) r.v[j] = q[64 * j];
    return r; }
__device__ __forceinline__ float row_rs(const RowRegs& r) { float s = 0.f;
#pragma unroll
    for (int j = 0; j < 4; ++j) s += (r.v[j][0] * r.v[j][0] + r.v[j][1] * r.v[j][1]) + (r.v[j][2] * r.v[j][2] + r.v[j][3] * r.v[j][3]);
    return 1.0f / sqrtf(wave_sum(s) * (1.0f / 1024.0f) + RMS_EPS); }
__device__ __forceinline__ void row_store_bf16(bf16_t* p, const RowRegs& r, float rs, int lane) { u32x2* o = (u32x2*)p + lane;
#pragma unroll
    for (int j = 0; j < 4; ++j) { u32x2 w; w.x = pk2(r.v[j][0] * rs, r.v[j][1] * rs); w.y = pk2(r.v[j][2] * rs, r.v[j][3] * rs); o[64 * j] = w; } }
__device__ __forceinline__ float row_dot(const RowRegs& r, const float* w, int lane) { const f32x4* q = (const f32x4*)w + lane; float s = 0.f;
#pragma unroll
    for (int j = 0; j < 4; ++j) { const f32x4 x = q[64 * j]; s += (r.v[j][0] * x[0] + r.v[j][1] * x[1]) + (r.v[j][2] * x[2] + r.v[j][3] * x[3]); }
    return wave_sum(s); }
__device__ __forceinline__ void row_add_bf16(RowRegs& r, const bf16_t* p, float g, int lane) { const u32x2* q = (const u32x2*)p + lane;
#pragma unroll
    for (int j = 0; j < 4; ++j) { const u32x2 w = q[64 * j]; r.v[j][0] += g * bflo(w.x); r.v[j][1] += g * bfhi(w.x); r.v[j][2] += g * bflo(w.y); r.v[j][3] += g * bfhi(w.y); } }

__device__ __forceinline__ void p1_rows(const Args& a, int gw, int NGW, int lane) {
    bf16_t* XN = (bf16_t*)(a.ws + AB_XN); float* AA = (float*)(a.ws + AB_AA); const float* WA = (const float*)(a.ws + WS_SKINNY) + SK_WA;
    for (int t = gw; t < T; t += NGW) {
        const RowRegs r = row_load(a.in[0] + (size_t)t * D, lane); const float rs = row_rs(r);
        row_store_bf16(XN + (size_t)t * D, r, rs, lane);
        float mine = 0.f;
#pragma unroll
        for (int n = 0; n < 16; ++n) { const float d = row_dot(r, WA + n * 1024, lane) * rs; if (lane == n) mine = d; }
        if (lane < 16) AA[(size_t)t * 16 + lane] = mine;
    }
}

__device__ __forceinline__ void combine_row(RowRegs& r, const unsigned char* ws, const MoeTab& tab, int t, int lane) {
    const i32x4 ti = ((const i32x4*)(ws + AB_TOKI))[t]; const f32x2 tg = ((const f32x2*)(ws + AB_TOKG))[t];
    const bf16_t* YS = (const bf16_t*)(ws + AB_YS);
    const int p0 = tab.tstart[ti.x] * BM + ti.z, p1 = tab.tstart[ti.y] * BM + ti.w;
    row_add_bf16(r, YS + (size_t)p0 * D, tg.x, lane); row_add_bf16(r, YS + (size_t)p1 * D, tg.y, lane);
}
__device__ __forceinline__ void p10_rows(const Args& a, LAS unsigned char* lds, int layer, int gw, int NGW, int lane) {
    const MoeTab tab = moe_tab(lds); moe_tab_build(tab, (const int*)(a.ws + WS_CTL) + layer * 32);
    bf16_t* XN = (bf16_t*)(a.ws + AB_XN); float* LF = (float*)(a.ws + AB_LF); const float* WF = (const float*)(a.ws + WS_SKINNY) + SK_WF;
    for (int t = gw; t < T; t += NGW) {
        RowRegs r = row_load(a.out + (size_t)t * D, lane); combine_row(r, a.ws, tab, t, lane);
        f32x4* o = (f32x4*)(a.out + (size_t)t * D) + lane;
#pragma unroll
        for (int j = 0; j < 4; ++j) o[64 * j] = r.v[j];
        const float rs = row_rs(r); row_store_bf16(XN + (size_t)t * D, r, rs, lane);
        float mine = 0.f;
#pragma unroll
        for (int n = 0; n < 16; ++n) { const float d = row_dot(r, WF + n * 1024, lane) * rs; if (lane == n) mine = d; }
        if (lane < 16) LF[(size_t)t * 16 + lane] = log_sigmoid(mine + a.in[9][lane]);
    }
}
__device__ __forceinline__ void p17_rows(const Args& a, LAS unsigned char* lds, int layer, int gw, int NGW, int lane) {
    const MoeTab tab = moe_tab(lds); moe_tab_build(tab, (const int*)(a.ws + WS_CTL) + layer * 32);
    const f32x4* fn = (const f32x4*)a.in[21] + lane;
    for (int t = gw; t < T; t += NGW) {
        RowRegs r = row_load(a.out + (size_t)t * D, lane); combine_row(r, a.ws, tab, t, lane);
        const float rs = row_rs(r);
        f32x4* o = (f32x4*)(a.out + (size_t)t * D) + lane;
#pragma unroll
        for (int j = 0; j < 4; ++j) o[64 * j] = r.v[j] * rs * fn[64 * j];
    }
}

__device__ __forceinline__ void route_phase(const Args& a, LAS unsigned char* lds, int layer, int lane, int wave) {
    bf16_t* XN = (bf16_t*)(a.ws + AB_XN); const float* WR = (const float*)(a.ws + WS_SKINNY) + (layer ? SK_WR1 : SK_WR0);
    int* gcnt = (int*)(a.ws + WS_CTL) + layer * 32; int* LIST = (int*)(a.ws + AB_LIST); i32x4* TOKI = (i32x4*)(a.ws + AB_TOKI); f32x2* TOKG = (f32x2*)(a.ws + AB_TOKG);
    const float* bc = a.in[15] + layer * 4; const float* bfine = a.in[17] + layer * 32;
    LAS int* be = (LAS int*)(lds);
    LAS int* rk = be + 256;
    LAS int* lcnt = rk + 256;
    LAS int* lbase = lcnt + 32;
    LAS float* bg = (LAS float*)(lbase + 32);
    for (int batch = blockIdx.x; batch < T / 128; batch += gridDim.x) {
        if (threadIdx.x < 32) lcnt[threadIdx.x] = 0;
        for (int i = 0; i < 16; ++i) {
            const int lr = wave * 16 + i, t = batch * 128 + lr;
            const RowRegs r = row_load(a.out + (size_t)t * D, lane); const float rs = row_rs(r);
            row_store_bf16(XN + (size_t)t * D, r, rs, lane);
            float mine = 0.f;
#pragma unroll 2
            for (int n = 0; n < 36; ++n) { const float d = row_dot(r, WR + n * 1024, lane) * rs; if (lane == n) mine = d; }
            const float c0 = __shfl(mine, 0) + bc[0], c1 = __shfl(mine, 1) + bc[1], c2 = __shfl(mine, 2) + bc[2], c3 = __shfl(mine, 3) + bc[3];
            int gi = 0; float cm = c0; if (c1 > cm) { cm = c1; gi = 1; } if (c2 > cm) { cm = c2; gi = 2; } if (c3 > cm) { cm = c3; gi = 3; }
            const float pc = 1.f / (__expf(c0 - cm) + __expf(c1 - cm) + __expf(c2 - cm) + __expf(c3 - cm));
            float f[8];
#pragma unroll
            for (int j = 0; j < 8; ++j) f[j] = __shfl(mine, 4 + gi * 8 + j) + bfine[gi * 8 + j];
            int j0 = 0; float m0 = f[0];
#pragma unroll
            for (int j = 1; j < 8; ++j) if (f[j] > m0) { m0 = f[j]; j0 = j; }
            int j1 = -1; float m1 = -INFINITY;
#pragma unroll
            for (int j = 0; j < 8; ++j) if (j != j0 && f[j] > m1) { m1 = f[j]; j1 = j; }
            const float e1 = __expf(m1 - m0), inv = 1.f / (1.f + e1);
            if (lane == 0) { be[lr * 2] = gi * 8 + j0; be[lr * 2 + 1] = gi * 8 + j1; bg[lr * 2] = pc * inv; bg[lr * 2 + 1] = pc * e1 * inv; }
        }
        __syncthreads();
        if (threadIdx.x < 256) rk[threadIdx.x] = atomicAdd((int*)&lcnt[be[threadIdx.x]], 1);
        __syncthreads();
        if (threadIdx.x < 32) lbase[threadIdx.x] = lcnt[threadIdx.x] ? atomicAdd(&gcnt[threadIdx.x], lcnt[threadIdx.x]) : 0;
        __syncthreads();
        if (threadIdx.x < 256) { const int e = be[threadIdx.x], idx = lbase[e] + rk[threadIdx.x]; LIST[e * T + idx] = batch * 128 + (threadIdx.x >> 1); rk[threadIdx.x] = idx; }
        __syncthreads();
        if (threadIdx.x < 128) { const int lr = threadIdx.x; TOKI[batch * 128 + lr] = (i32x4){be[lr * 2], be[lr * 2 + 1], rk[lr * 2], rk[lr * 2 + 1]}; TOKG[batch * 128 + lr] = (f32x2){bg[lr * 2], bg[lr * 2 + 1]}; }
        __syncthreads();
    }
}

__device__ __forceinline__ void gla_alpha_naive(const Args& a) {
    const float* AA = (const float*)(a.ws + AB_AA); float* AL = (float*)(a.ws + AB_ALPHA); const float* w2 = a.in[3]; const float* ba = a.in[4];
    for (size_t i = (size_t)blockIdx.x * NTHREADS + threadIdx.x; i < (size_t)T * 512; i += (size_t)gridDim.x * NTHREADS) {
        const int t = (int)(i >> 9), hd = (int)(i & 511); float z = ba[hd];
#pragma unroll
        for (int r = 0; r < 16; ++r) z += AA[(size_t)t * 16 + r] * w2[r * 512 + hd];
        AL[i] = __expf(log_sigmoid(z) * (1.f / 16.f));
    }
}
__device__ __forceinline__ void gla_scan_naive(const Args& a, int gw, int NGW, int lane) {
    const bf16_t* __restrict__ Q = (const bf16_t*)(a.ws + AB_Q); const bf16_t* __restrict__ K = (const bf16_t*)(a.ws + AB_K); bf16_t* V = (bf16_t*)(a.ws + AB_V);
    const float* __restrict__ AL = (const float*)(a.ws + AB_ALPHA); float* SSQ = (float*)(a.ws + AB_SSQ);
    for (int item = gw; item < 256; item += NGW) {
        const int b = item >> 4, h = (item >> 2) & 3, sl = item & 3, e = h * 256 + sl * 64 + lane;
        float St[128];
#pragma unroll
        for (int d = 0; d < 128; ++d) St[d] = 0.f;
        for (int t = 0; t < SEQ; ++t) {
            const size_t row = (size_t)b * SEQ + t;
            const float v = bf2f(V[row * D + e]);
            const u32x4* qp = (const u32x4*)(Q + row * 512 + h * 128); const u32x4* kp = (const u32x4*)(K + row * 512 + h * 128); const f32x4* ap = (const f32x4*)(AL + row * 512 + h * 128);
            float o = 0.f;
#pragma unroll
            for (int c = 0; c < 16; ++c) { const u32x4 qw = qp[c], kw = kp[c]; const f32x4 a0 = ap[2 * c], a1 = ap[2 * c + 1];
                const float qf[8] = {bflo(qw.x), bfhi(qw.x), bflo(qw.y), bfhi(qw.y), bflo(qw.z), bfhi(qw.z), bflo(qw.w), bfhi(qw.w)};
                const float kf[8] = {bflo(kw.x), bfhi(kw.x), bflo(kw.y), bfhi(kw.y), bflo(kw.z), bfhi(kw.z), bflo(kw.w), bfhi(kw.w)};
                const float af[8] = {a0[0], a0[1], a0[2], a0[3], a1[0], a1[1], a1[2], a1[3]};
#pragma unroll
                for (int j = 0; j < 8; ++j) { const int d = c * 8 + j; St[d] = af[j] * St[d] + kf[j] * v; o += qf[j] * St[d]; } }
            V[row * D + e] = (bf16_t)f2bf(o);
            const float ss = wave_sum(o * o);
            if (lane == 0) SSQ[row * 16 + h * 4 + sl] = ss;
        }
    }
}
__device__ __forceinline__ void gla_post(const Args& a) {
    bf16_t* V = (bf16_t*)(a.ws + AB_V); const bf16_t* R = (const bf16_t*)(a.ws + AB_R); const float* SSQ = (const float*)(a.ws + AB_SSQ);
    for (size_t i = (size_t)blockIdx.x * NTHREADS + threadIdx.x; i < (size_t)T * 128; i += (size_t)gridDim.x * NTHREADS) {
        const size_t t = i >> 7; const int c8 = (int)(i & 127) * 8, h = c8 >> 8;
        const f32x4 sq = *(const f32x4*)(SSQ + t * 16 + h * 4);
        const float rstd = 1.0f / sqrtf(((sq[0] + sq[1]) + (sq[2] + sq[3])) * (1.f / 256.f) + RMS_EPS);
        const u32x4 ow = *(const u32x4*)(V + t * D + c8), rw = *(const u32x4*)(R + t * D + c8);
        const unsigned oo[4] = {ow.x, ow.y, ow.z, ow.w}, rr[4] = {rw.x, rw.y, rw.z, rw.w}; unsigned res[4];
#pragma unroll
        for (int j = 0; j < 4; ++j) { const float r0 = bflo(rr[j]), r1 = bfhi(rr[j]); res[j] = pk2(bflo(oo[j]) * rstd * r0 * sigmoidf_(r0), bfhi(oo[j]) * rstd * r1 * sigmoidf_(r1)); }
        *(u32x4*)(V + t * D + c8) = (u32x4){res[0], res[1], res[2], res[3]};
    }
}

__device__ __forceinline__ void fox_cumsum(const Args& a, int gw, int NGW, int lane) {
    const float* LF = (const float*)(a.ws + AB_LF); float* C = (float*)(a.ws + AB_C);
    for (int item = gw; item < 256; item += NGW) {
        const int b = item >> 4, h = item & 15; float loc[32]; float s = 0.f;
#pragma unroll
        for (int i = 0; i < 32; ++i) { s += LF[((size_t)b * SEQ + lane * 32 + i) * 16 + h]; loc[i] = s; }
        float incl = s;
#pragma unroll
        for (int o = 1; o < 64; o <<= 1) { const float n = __shfl_up(incl, o); if (lane >= o) incl += n; }
        const float excl = incl - s;
#pragma unroll
        for (int i = 0; i < 32; ++i) C[(size_t)item * SEQ + lane * 32 + i] = loc[i] + excl;
    }
}
__device__ __forceinline__ void fox_attn_naive(const Args& a, int gw, int NGW, int lane) {
    bf16_t* Q = (bf16_t*)(a.ws + AB_FQ); const bf16_t* __restrict__ K = (const bf16_t*)(a.ws + AB_FK); const bf16_t* __restrict__ V = (const bf16_t*)(a.ws + AB_FV);
    const bf16_t* __restrict__ OG = (const bf16_t*)(a.ws + AB_FOG); const float* __restrict__ C = (const float*)(a.ws + AB_C);
    for (int item = gw; item < 8192; item += NGW) {
        const int bh = item >> 5, tb = item & 31, b = bh >> 4, h = bh & 15, t = tb * 64 + lane;
        const size_t row = (size_t)b * SEQ + t;
        float q[64], o[64];
#pragma unroll
        for (int c = 0; c < 8; ++c) { const u32x4 w = *(const u32x4*)(Q + row * D + h * 64 + c * 8); q[c * 8 + 0] = bflo(w.x); q[c * 8 + 1] = bfhi(w.x); q[c * 8 + 2] = bflo(w.y); q[c * 8 + 3] = bfhi(w.y); q[c * 8 + 4] = bflo(w.z); q[c * 8 + 5] = bfhi(w.z); q[c * 8 + 6] = bflo(w.w); q[c * 8 + 7] = bfhi(w.w); }
#pragma unroll
        for (int d = 0; d < 64; ++d) o[d] = 0.f;
        float m = -INFINITY, l = 0.f; const float cref = C[(size_t)bh * SEQ + tb * 64 + 63];
        const int smax = tb * 64 + 63;
        for (int s = 0; s <= smax; ++s) {
            const size_t krow = (size_t)b * SEQ + s; float x = 0.f;
#pragma unroll
            for (int c = 0; c < 8; ++c) { const u32x4 w = *(const u32x4*)(K + krow * D + h * 64 + c * 8);
                x += q[c * 8 + 0] * bflo(w.x) + q[c * 8 + 1] * bfhi(w.x) + q[c * 8 + 2] * bflo(w.y) + q[c * 8 + 3] * bfhi(w.y) + q[c * 8 + 4] * bflo(w.z) + q[c * 8 + 5] * bfhi(w.z) + q[c * 8 + 6] * bflo(w.w) + q[c * 8 + 7] * bfhi(w.w); }
            x += (cref - C[(size_t)bh * SEQ + s]) * LOG2E;
            if (s > t) x = -INFINITY;
            const float mn = fmaxf(m, x); const float sc = (mn == -INFINITY) ? 1.f : exp2f(m - mn), p = (mn == -INFINITY) ? 0.f : exp2f(x - mn);
            m = mn; l = l * sc + p;
#pragma unroll
            for (int c = 0; c < 8; ++c) { const u32x4 w = *(const u32x4*)(V + krow * D + h * 64 + c * 8);
                const float vv[8] = {bflo(w.x), bfhi(w.x), bflo(w.y), bfhi(w.y), bflo(w.z), bfhi(w.z), bflo(w.w), bfhi(w.w)};
#pragma unroll
                for (int j = 0; j < 8; ++j) o[c * 8 + j] = o[c * 8 + j] * sc + p * vv[j]; }
        }
        const float il = 1.f / l;
#pragma unroll
        for (int c = 0; c < 8; ++c) { const u32x4 g = *(const u32x4*)(OG + row * D + h * 64 + c * 8); const unsigned gg[4] = {g.x, g.y, g.z, g.w}; unsigned res[4];
#pragma unroll
            for (int j = 0; j < 4; ++j) res[j] = pk2(o[c * 8 + 2 * j] * il * sigmoidf_(bflo(gg[j])), o[c * 8 + 2 * j + 1] * il * sigmoidf_(bfhi(gg[j])));
            *(u32x4*)(Q + row * D + h * 64 + c * 8) = (u32x4){res[0], res[1], res[2], res[3]}; }
    }
}

constexpr int NPHASES = 18;
__global__ void __launch_bounds__(NTHREADS, 2) fwd(Args a) {
    extern __shared__ __attribute__((aligned(16))) unsigned char lds_raw[];
    LAS unsigned char* lds = (LAS unsigned char*)lds_raw;
    cg::grid_group grid = cg::this_grid();
    const int tid = threadIdx.x, lane = tid & 63, wave = __builtin_amdgcn_readfirstlane(tid >> 6);
    const int G = gridDim.x, gw = blockIdx.x * NWAVES + wave, NGW = G * NWAVES;
    unsigned char* ws = a.ws;
    const int lo = a.ph_lo, hi = a.ph_hi;
#ifdef ONLY_PHASE
#define IN(k) ((k) == ONLY_PHASE && lo <= (k) && (k) < hi)
#else
#define IN(k) (lo <= (k) && (k) < hi)
#endif
#define SEAM(k) do { if (IN(k) && IN((k) + 1)) grid.sync(); } while (0)
    if (IN(0)) { p0_weights(a, lds, gw, NGW, lane, wave); } SEAM(0);
    if (IN(1)) { p1_rows(a, gw, NGW, lane); } SEAM(1);
    if (IN(2)) {
        StaticOrder S; S.init(T, 3072, G, blockIdx.x);
        EpiSplitBf16<0> E{ws};
        gemm_direct((const bf16_t*)(ws + AB_XN), (const bf16_t*)(ws + WS_WIN), 1024, S, E, IdMap{});
    } SEAM(2);
    if (IN(3)) { gla_alpha_naive(a); } SEAM(3);
    if (IN(4)) { gla_scan_naive(a, gw, NGW, lane); } SEAM(4);
    if (IN(5)) { gla_post(a); } SEAM(5);
    if (IN(6)) {
        StaticOrder S; S.init(T, 1024, G, blockIdx.x); EpiResF32 E{a.in[0], a.out};
        gemm_direct((const bf16_t*)(ws + AB_V), (const bf16_t*)(ws + WS_WOUT), 1024, S, E, IdMap{});
    } SEAM(6);
#define MOE_PHASES(layer, pb) \
    if (IN(pb)) { route_phase(a, lds, layer, lane, wave); } SEAM(pb); \
    if (IN(pb + 1)) { \
        const MoeTab tab = moe_tab(lds); moe_tab_build(tab, (const int*)(ws + WS_CTL) + layer * 32); \
        MoeOrder S; S.so.init(tab.tstart[32] * BM, 1024, G, blockIdx.x); S.tab = tab; \
        MoeGather AM{tab, (const int*)(ws + AB_LIST)}; EpiSwiGLU E{(bf16_t*)(ws + AB_HB)}; \
        gemm_direct((const bf16_t*)(ws + AB_XN), (const bf16_t*)(ws + WS_WEUP) + (size_t)layer * 32 * 1024 * 1024, 1024, S, E, AM); \
        __syncthreads(); \
    } SEAM(pb + 1); \
    if (IN(pb + 2)) { \
        const MoeTab tab = moe_tab(lds); moe_tab_build(tab, (const int*)(ws + WS_CTL) + layer * 32); \
        MoeOrder S; S.so.init(tab.tstart[32] * BM, 1024, G, blockIdx.x); S.tab = tab; \
        EpiMoeDown E{(bf16_t*)(ws + AB_YS)}; \
        gemm_direct((const bf16_t*)(ws + AB_HB), (const bf16_t*)(ws + WS_WEDN) + (size_t)layer * 32 * 1024 * 512, 512, S, E, IdMap{}); \
        __syncthreads(); \
    } SEAM(pb + 2);
    MOE_PHASES(0, 7)
    if (IN(10)) { p10_rows(a, lds, 0, gw, NGW, lane); __syncthreads(); } SEAM(10);
    if (IN(11)) {
        fox_cumsum(a, gw, NGW, lane);
        StaticOrder S; S.init(T, 4096, G, blockIdx.x);
        EpiSplitBf16<1> E{ws};
        gemm_direct((const bf16_t*)(ws + AB_XN), (const bf16_t*)(ws + WS_WKVQ), 1024, S, E, IdMap{});
    } SEAM(11);
    if (IN(12)) { fox_attn_naive(a, gw, NGW, lane); } SEAM(12);
    if (IN(13)) {
        StaticOrder S; S.init(T, 1024, G, blockIdx.x); EpiResF32 E{a.out, a.out};
        gemm_direct((const bf16_t*)(ws + AB_FQ), (const bf16_t*)(ws + WS_WFO), 1024, S, E, IdMap{});
    } SEAM(13);
    MOE_PHASES(1, 14)
    if (IN(17)) { p17_rows(a, lds, 1, gw, NGW, lane); }
#undef IN
#undef SEAM
}

#ifndef ONE_LAUNCH
#define ONE_LAUNCH 1
#endif
extern "C" void kernel_launch(void* const* d_in, const int* in_sizes, int n_in, void* d_out, int out_size, void* d_ws, size_t ws_size, hipStream_t stream) {
    static int grid = 0;
    if (grid == 0) {
        if (n_in != 22 || out_size != T * D || ws_size < WS_END) { fprintf(stderr, "kernel_launch: unexpected shapes (n_in %d, out %d, ws %zu < %zu)\n", n_in, out_size, ws_size, (size_t)WS_END); grid = -1; return; }
        int dev = 0, cus = 0, per_cu = 0;
        hipGetDevice(&dev); hipDeviceGetAttribute(&cus, hipDeviceAttributeMultiprocessorCount, dev);
        hipFuncSetAttribute((const void*)fwd, hipFuncAttributeMaxDynamicSharedMemorySize, LDS_BYTES);
        hipOccupancyMaxActiveBlocksPerMultiprocessor(&per_cu, (const void*)fwd, NTHREADS, LDS_BYTES);
        if (per_cu < 1) { fprintf(stderr, "kernel_launch: occupancy query says %d blocks per CU\n", per_cu); grid = -1; return; }
        grid = cus;
        fprintf(stderr, "kernel_launch: grid %d (per_cu %d), ws %zu\n", grid, per_cu, ws_size);
    }
    if (grid < 0) return;
    Args a{};
    for (int i = 0; i < 22; ++i) a.in[i] = (const float*)d_in[i];
    a.out = (float*)d_out; a.ws = (unsigned char*)d_ws;
#if ONE_LAUNCH
    a.ph_lo = 0; a.ph_hi = NPHASES;
    void* args[] = {&a};
    hipError_t e = hipLaunchCooperativeKernel((const void*)fwd, dim3(grid), dim3(NTHREADS), args, LDS_BYTES, stream);
    if (e != hipSuccess) fprintf(stderr, "cooperative launch failed: %s\n", hipGetErrorString(e));
#else
    for (int p = 0; p < NPHASES; ++p) {
        a.ph_lo = p; a.ph_hi = p + 1;
        hipLaunchKernelGGL(fwd, dim3(grid), dim3(NTHREADS), LDS_BYTES, stream, a);
    }
#endif
}
```

```cpp
#include <hip/hip_runtime.h>
#include <hip/hip_cooperative_groups.h>
#include <cstdio>
#include <cstdint>
namespace cg = cooperative_groups;

#define LAS __attribute__((address_space(3)))
typedef unsigned short bf16_t;
typedef short bf16x8 __attribute__((ext_vector_type(8)));
typedef float f32x4 __attribute__((ext_vector_type(4)));
typedef float f32x2 __attribute__((ext_vector_type(2)));
typedef unsigned u32x4 __attribute__((ext_vector_type(4)));
typedef unsigned u32x2 __attribute__((ext_vector_type(2)));
typedef int i32x4 __attribute__((ext_vector_type(4)));

constexpr int T = 32768, D = 1024, NBATCH = 16, SEQ = 2048;
constexpr int NWAVES = 8, NTHREADS = 512;
constexpr float RMS_EPS = 1e-6f;
constexpr float LOG2E = 1.4426950408889634f;
constexpr float ATT_C2 = 0.125f * LOG2E;
constexpr float GLA_QSCALE = 0.08838834764831845f;
constexpr int NEXP = 32;
constexpr int MAXTILES = 288;

constexpr size_t MiB = 1u << 20;
constexpr size_t WS_CTL = 0;
constexpr size_t WS_SKINNY = 256 * 1024;
constexpr size_t WS_WIN = 1 * MiB;
constexpr size_t WS_WOUT = WS_WIN + 6 * MiB;
constexpr size_t WS_WKVQ = WS_WOUT + 2 * MiB;
constexpr size_t WS_WFO = WS_WKVQ + 8 * MiB;
constexpr size_t WS_WEUP = WS_WFO + 2 * MiB;
constexpr size_t WS_WEDN = WS_WEUP + 128 * MiB;
constexpr size_t WS_AB = WS_WEDN + 64 * MiB;
constexpr size_t AB_XN = WS_AB;
constexpr size_t AB_Q = WS_AB + 64 * MiB;
constexpr size_t AB_K = WS_AB + 96 * MiB;
constexpr size_t AB_V = WS_AB + 128 * MiB;
constexpr size_t AB_R = WS_AB + 192 * MiB;
constexpr size_t AB_KHT = WS_AB + 256 * MiB;
constexpr size_t AB_PM = WS_AB + 288 * MiB;
constexpr size_t AB_EL = WS_AB + 304 * MiB;
constexpr size_t AB_AA = WS_AB + 305 * MiB;
constexpr size_t AB_SSQ = WS_AB + 307 * MiB;
constexpr size_t AB_ALPHA = AB_XN;
constexpr size_t AB_HB = WS_AB + 64 * MiB;
constexpr size_t AB_YS = WS_AB + 136 * MiB;
constexpr size_t AB_LIST = WS_AB + 280 * MiB;
constexpr size_t AB_TOKI = WS_AB + 284 * MiB;
constexpr size_t AB_TOKG = WS_AB + 285 * MiB;
constexpr size_t AB_FK = WS_AB + 64 * MiB;
constexpr size_t AB_FV = WS_AB + 128 * MiB;
constexpr size_t AB_FQ = WS_AB + 192 * MiB;
constexpr size_t AB_FOG = WS_AB + 256 * MiB;
constexpr size_t AB_LF = WS_AB + 320 * MiB;
constexpr size_t AB_C = WS_AB + 322 * MiB;
constexpr size_t WS_END = WS_AB + 324 * MiB;

constexpr int SK_WA = 0, SK_WR0 = 16 * 1024, SK_WR1 = SK_WR0 + 36 * 1024, SK_WF = SK_WR1 + 36 * 1024;

constexpr int RING_BYTES = 131072;
constexpr int LDS_MISC = RING_BYTES;
constexpr int LDS_BYTES = 147456;

__device__ __forceinline__ unsigned f2bf(float f) { unsigned u = __builtin_bit_cast(unsigned, f); return (u + 0x7fffu + ((u >> 16) & 1u)) >> 16; }
__device__ __forceinline__ unsigned pk2(float lo, float hi) { return f2bf(lo) | (f2bf(hi) << 16); }
__device__ __forceinline__ float bf2f(unsigned h) { return __builtin_bit_cast(float, h << 16); }
__device__ __forceinline__ float bflo(unsigned w) { return __builtin_bit_cast(float, w << 16); }
__device__ __forceinline__ float bfhi(unsigned w) { return __builtin_bit_cast(float, w & 0xffff0000u); }
__device__ __forceinline__ float wave_sum(float v) {
#pragma unroll
    for (int o = 1; o < 64; o <<= 1) v += __shfl_xor(v, o);
    return v;
}
__device__ __forceinline__ float log_sigmoid(float z) { return fminf(z, 0.f) - log1pf(__expf(-fabsf(z))); }
__device__ __forceinline__ float sigmoidf_(float z) { return 1.f / (1.f + __expf(-z)); }
__device__ __forceinline__ int perm32(int rho) { const int n = rho >> 4, i = rho & 15; return 8 * (i >> 2) + 4 * n + (i & 3); }

struct Args { const float* in[22]; float* out; unsigned char* ws; int ph_lo, ph_hi; };

struct Unit { int pm, pn; };
constexpr int BM = 256, HALF = 128, NXCD = 8, WGM = 8;
struct StaticOrder {
    int nM, nN, nwg, G, c;
    __device__ void init(int M, int N, int G_, int c_) { nM = M / BM; nN = N / BM; nwg = nM * nN; G = G_; c = c_; }
    __device__ bool next(int i, Unit& u) const {
        const long L = (long)i * G + c; if (L >= nwg) return false;
        int wgid = (int)L; { const int q = nwg / NXCD, r = nwg % NXCD, xcd = wgid % NXCD, off = wgid / NXCD; wgid = (xcd < r ? xcd * (q + 1) : r * (q + 1) + (xcd - r) * q) + off; }
        const int nig = WGM * nN, gid = wgid / nig, fm = gid * WGM, gsz = (nM - fm) < WGM ? (nM - fm) : WGM;
        u.pm = fm + ((wgid % nig) % gsz); u.pn = (wgid % nig) / gsz; return true;
    }
};
struct IdMap { __device__ __forceinline__ int row(const Unit& u, int r) const { return u.pm * BM + r; } };

struct MoeTab { LAS int* cnt; LAS int* tstart; LAS int* tile_e; };
__device__ __forceinline__ MoeTab moe_tab(LAS unsigned char* lds) { MoeTab t; t.cnt = (LAS int*)(lds + LDS_MISC); t.tstart = t.cnt + 32; t.tile_e = t.tstart + 64; return t; }
__device__ __forceinline__ void moe_tab_build(const MoeTab& t, const int* gcnt) {
    if (threadIdx.x == 0) { int s = 0; for (int e = 0; e < NEXP; ++e) { const int c = gcnt[e]; t.cnt[e] = c; t.tstart[e] = s; s += (c + 255) >> 8; } t.tstart[32] = s; }
    __syncthreads();
    const int nt = t.tstart[32];
    for (int p = threadIdx.x; p < nt; p += NTHREADS) { int e = 0; for (int j = 1; j < NEXP; ++j) if (t.tstart[j] <= p) e = j; t.tile_e[p] = e; }
    __syncthreads();
}
struct MoeOrder {
    StaticOrder so; MoeTab tab;
    __device__ bool next(int i, Unit& u) const { if (!so.next(i, u)) return false; u.pn += 4 * tab.tile_e[u.pm]; return true; }
};
struct MoeGather {
    MoeTab tab; const int* list;
    __device__ __forceinline__ int row(const Unit& u, int r) const {
        const int e = u.pn >> 2; int idx = (u.pm - tab.tstart[e]) * BM + r; const int c = tab.cnt[e]; idx = idx < c ? idx : c - 1; return list[e * T + idx];
    }
};

template <int WHICH> struct EpiSplitBf16 {
    static constexpr bool PERM = true;
    unsigned char* ws;
    __device__ __forceinline__ void operator()(const f32x4 (&acc)[2][2][4][2], const Unit& u, int wr, int wc, int fr, int fq) const {
        size_t off; int ldc, f0;
        if (WHICH == 0) { if (u.pn < 2) { off = AB_Q; ldc = 512; f0 = 0; } else if (u.pn < 4) { off = AB_K; ldc = 512; f0 = 2; } else if (u.pn < 8) { off = AB_V; ldc = 1024; f0 = 4; } else { off = AB_R; ldc = 1024; f0 = 8; } }
        else { off = AB_FK + (size_t)(u.pn >> 2) * (64 * MiB); ldc = 1024; f0 = u.pn & ~3; }
        bf16_t* base = (bf16_t*)(ws + off);
        const int row0 = u.pm * BM + wr * 64 + fr, col0 = (u.pn - f0) * BM + wc * 32 + 8 * fq;
#pragma unroll
        for (int ai = 0; ai < 2; ++ai)
#pragma unroll
            for (int m = 0; m < 4; ++m) { bf16_t* rowp = base + (size_t)(row0 + ai * HALF + m * 16) * ldc + col0;
#pragma unroll
                for (int bj = 0; bj < 2; ++bj) { const f32x4 v0 = acc[ai][bj][m][0], v1 = acc[ai][bj][m][1];
                    u32x4 w; w.x = pk2(v0[0], v0[1]); w.y = pk2(v0[2], v0[3]); w.z = pk2(v1[0], v1[1]); w.w = pk2(v1[2], v1[3]);
                    *(u32x4*)(rowp + bj * HALF) = w; } }
    }
};
struct EpiResF32 {
    static constexpr bool PERM = false;
    const float* base; float* out;
    __device__ __forceinline__ void operator()(const f32x4 (&acc)[2][2][4][2], const Unit& u, int wr, int wc, int fr, int fq) const {
        const int row0 = u.pm * BM + wr * 64 + fr, col0 = u.pn * BM + wc * 32 + 4 * fq;
#pragma unroll
        for (int ai = 0; ai < 2; ++ai)
#pragma unroll
            for (int m = 0; m < 4; ++m) { const size_t off = (size_t)(row0 + ai * HALF + m * 16) * D + col0;
#pragma unroll
                for (int bj = 0; bj < 2; ++bj)
#pragma unroll
                    for (int n = 0; n < 2; ++n) { const f32x4 b = *(const f32x4*)(base + off + bj * HALF + n * 16); *(f32x4*)(out + off + bj * HALF + n * 16) = b + acc[ai][bj][m][n]; } }
    }
};
struct EpiSwiGLU {
    static constexpr bool PERM = true;
    bf16_t* hb;
    __device__ __forceinline__ void operator()(const f32x4 (&acc)[2][2][4][2], const Unit& u, int wr, int wc, int fr, int fq) const {
        const int row0 = u.pm * BM + wr * 64 + fr, col0 = (u.pn & 3) * 128 + wc * 32 + 8 * fq;
#pragma unroll
        for (int ai = 0; ai < 2; ++ai)
#pragma unroll
            for (int m = 0; m < 4; ++m) { float h[8];
#pragma unroll
                for (int n = 0; n < 2; ++n)
#pragma unroll
                    for (int j = 0; j < 4; ++j) { const float g = acc[ai][0][m][n][j], up = acc[ai][1][m][n][j]; h[n * 4 + j] = g * sigmoidf_(g) * up; }
                u32x4 w; w.x = pk2(h[0], h[1]); w.y = pk2(h[2], h[3]); w.z = pk2(h[4], h[5]); w.w = pk2(h[6], h[7]);
                *(u32x4*)(hb + (size_t)(row0 + ai * HALF + m * 16) * 512 + col0) = w; }
    }
};
struct EpiMoeDown {
    static constexpr bool PERM = true;
    bf16_t* ys;
    __device__ __forceinline__ void operator()(const f32x4 (&acc)[2][2][4][2], const Unit& u, int wr, int wc, int fr, int fq) const {
        const int row0 = u.pm * BM + wr * 64 + fr, col0 = (u.pn & 3) * BM + wc * 32 + 8 * fq;
#pragma unroll
        for (int ai = 0; ai < 2; ++ai)
#pragma unroll
            for (int m = 0; m < 4; ++m) { bf16_t* rowp = ys + (size_t)(row0 + ai * HALF + m * 16) * D + col0;
#pragma unroll
                for (int bj = 0; bj < 2; ++bj) { const f32x4 v0 = acc[ai][bj][m][0], v1 = acc[ai][bj][m][1];
                    u32x4 w; w.x = pk2(v0[0], v0[1]); w.y = pk2(v0[2], v0[3]); w.z = pk2(v1[0], v1[1]); w.w = pk2(v1[2], v1[3]);
                    *(u32x4*)(rowp + bj * HALF) = w; } }
    }
};

template <class Epi, class Sched, class AMap>
__device__ __forceinline__ void gemm_direct(const bf16_t* __restrict__ A, const bf16_t* __restrict__ Bt, int K, const Sched& S, const Epi& E, const AMap& AM) {
    const int tid = threadIdx.x, wid = __builtin_amdgcn_readfirstlane(tid >> 6), lane = tid & 63, wr = wid >> 2, wc = wid & 3, fr = lane & 15, fq = lane >> 4;
    Unit u;
    for (int i = 0; S.next(i, u); ++i) {
        f32x4 acc[2][2][4][2];
#pragma unroll
        for (int a = 0; a < 2; ++a)
#pragma unroll
            for (int b = 0; b < 2; ++b)
#pragma unroll
                for (int m = 0; m < 4; ++m)
#pragma unroll
                    for (int n = 0; n < 2; ++n) acc[a][b][m][n] = (f32x4){0.f, 0.f, 0.f, 0.f};
        const bf16_t* ap[2][4]; const bf16_t* bp[2][2];
#pragma unroll
        for (int ai = 0; ai < 2; ++ai)
#pragma unroll
            for (int m = 0; m < 4; ++m) ap[ai][m] = A + (size_t)AM.row(u, ai * HALF + wr * 64 + m * 16 + fr) * K + 8 * fq;
#pragma unroll
        for (int bj = 0; bj < 2; ++bj)
#pragma unroll
            for (int n = 0; n < 2; ++n) { const int rho = 16 * n + fr, rr = Epi::PERM ? perm32(rho) : rho; bp[bj][n] = Bt + (size_t)(u.pn * BM + bj * HALF + wc * 32 + rr) * K + 8 * fq; }
        for (int k0 = 0; k0 < K; k0 += 32) {
            bf16x8 af[2][4], bfr[2][2];
#pragma unroll
            for (int ai = 0; ai < 2; ++ai)
#pragma unroll
                for (int m = 0; m < 4; ++m) af[ai][m] = *(const bf16x8*)(ap[ai][m] + k0);
#pragma unroll
            for (int bj = 0; bj < 2; ++bj)
#pragma unroll
                for (int n = 0; n < 2; ++n) bfr[bj][n] = *(const bf16x8*)(bp[bj][n] + k0);
#pragma unroll
            for (int ai = 0; ai < 2; ++ai)
#pragma unroll
                for (int bj = 0; bj < 2; ++bj)
#pragma unroll
                    for (int m = 0; m < 4; ++m)
#pragma unroll
                        for (int n = 0; n < 2; ++n) acc[ai][bj][m][n] = __builtin_amdgcn_mfma_f32_16x16x32_bf16(bfr[bj][n], af[ai][m], acc[ai][bj][m][n], 0, 0, 0);
        }
        E(acc, u, wr, wc, fr, fq);
    }
}

constexpr int BK = 64, HTB = HALF * BK * 2;
__device__ __forceinline__ int lds_byte(int r, int c) { const int st = (r >> 4) * 2 + (c >> 5), rr = r & 15, cc = c & 31, ob = rr * 64 + cc * 2; return st * 1024 + (ob ^ (((ob >> 9) & 1) << 5)); }
__device__ __forceinline__ void stage_rc(int b, int& R, int& C) { const int st = b / 1024, sb = b % 1024, swz = sb ^ (((sb >> 9) & 1) << 5); R = (st >> 1) * 16 + swz / 64; C = (st & 1) * 32 + (swz % 64) / 2; }
template <class Epi, class Sched, class AMap, bool ALIGN_EPI>
__device__ __forceinline__ void gemm_phase(LAS unsigned char* lds, const bf16_t* A, const bf16_t* Bt, const int K, const Sched& S, const Epi& E, const AMap& AM) {
    const int tid = threadIdx.x, wid = __builtin_amdgcn_readfirstlane(tid >> 6), lane = tid & 63, wr = wid >> 2, wc = wid & 3, fr = lane & 15, fq = lane >> 4;
    const int nt = K / BK;
    int RA[2], CA[2]; unsigned voffB[2];
#pragma unroll
    for (int i = 0; i < 2; ++i) { int R, C; stage_rc(tid * 16 + i * 8192, R, C); const int Rb = Epi::PERM ? ((R & ~31) + perm32(R & 31)) : R; RA[i] = R; CA[i] = C; voffB[i] = (unsigned)(Rb * K + C) * 2u; }
    const size_t kstep = (size_t)(BK * 2);
    const size_t hstep = (size_t)HALF * K * 2;
    const size_t tstep = 2 * hstep;
    const unsigned ldsw = (unsigned)wid * 1024u;
    const int aoff = lds_byte(wr * 64 + fr, fq * 8), boff = lds_byte(wc * 32 + fr, fq * 8);
#define PG8_SA(b, h) (((b) * 2 + (h)) * HTB)
#define PG8_SB(b, h) ((4 + (b) * 2 + (h)) * HTB)
#define PG8_STAGE(bufoff, gbase, voff) do { _Pragma("unroll") for (int _i = 0; _i < 2; ++_i) \
        __builtin_amdgcn_global_load_lds((const unsigned*)((const char*)(gbase) + (voff)[_i]), (LAS unsigned*)(lds + (bufoff) + ldsw + _i * 8192), 16, 0, 0); } while (0)
#define PG8_LDA(dst, b, h) do { _Pragma("unroll") for (int m = 0; m < 4; ++m) _Pragma("unroll") for (int k = 0; k < 2; ++k) dst[m][k] = *(const LAS bf16x8*)(lds + PG8_SA(b, h) + aoff + m * 2048 + k * 1024); } while (0)
#define PG8_LDB(dst, b, h) do { _Pragma("unroll") for (int n = 0; n < 2; ++n) _Pragma("unroll") for (int k = 0; k < 2; ++k) dst[n][k] = *(const LAS bf16x8*)(lds + PG8_SB(b, h) + boff + n * 2048 + k * 1024); } while (0)
#define PG8_MMA(ai, bj, At, Bt_) do { __builtin_amdgcn_s_setprio(1); _Pragma("unroll") for (int m = 0; m < 4; ++m) _Pragma("unroll") for (int n = 0; n < 2; ++n) _Pragma("unroll") for (int k = 0; k < 2; ++k) \
        acc[ai][bj][m][n] = __builtin_amdgcn_mfma_f32_16x16x32_bf16(Bt_[n][k], At[m][k], acc[ai][bj][m][n], 0, 0, 0); __builtin_amdgcn_s_setprio(0); } while (0)
#define PG8_WAIT_V(n) asm volatile("s_waitcnt vmcnt(" #n ")" ::: "memory")
#define PG8_WAIT_L(n) asm volatile("s_waitcnt lgkmcnt(" #n ")" ::: "memory")
#define PG8_BAR __builtin_amdgcn_s_barrier()
#define PG8_SCHED __builtin_amdgcn_sched_barrier(0)
#define PG8_OFFS(dst, u) do { _Pragma("unroll") for (int h = 0; h < 2; ++h) _Pragma("unroll") for (int i = 0; i < 2; ++i) dst[h][i] = (unsigned)(((size_t)AM.row(u, h * HALF + RA[i]) * K + CA[i]) * 2); } while (0)
    Unit cur, nxt; int ui = 0;
    if (!S.next(0, cur)) return;
    f32x4 acc[2][2][4][2];
#pragma unroll
    for (int a = 0; a < 2; ++a)
#pragma unroll
        for (int b = 0; b < 2; ++b)
#pragma unroll
            for (int m = 0; m < 4; ++m)
#pragma unroll
                for (int n = 0; n < 2; ++n) acc[a][b][m][n] = (f32x4){0.f, 0.f, 0.f, 0.f};
    bf16x8 At[4][2], B0[2][2], B1[2][2];
    unsigned oc[2][2], on[2][2];
    PG8_OFFS(oc, cur);
    const char* const Ab = (const char*)A;
    const char* cB = (const char*)Bt + (size_t)cur.pn * tstep;
    PG8_STAGE(PG8_SB(0, 0), cB, voffB); PG8_STAGE(PG8_SB(0, 1), cB + hstep, voffB); PG8_STAGE(PG8_SA(0, 0), Ab, oc[0]); PG8_STAGE(PG8_SA(0, 1), Ab, oc[1]);
    if (wr == 1) PG8_BAR;
    PG8_WAIT_V(2); PG8_BAR;
    PG8_STAGE(PG8_SB(1, 0), cB + kstep, voffB); PG8_STAGE(PG8_SA(1, 0), Ab + kstep, oc[0]); PG8_STAGE(PG8_SB(1, 1), cB + hstep + kstep, voffB);
    PG8_WAIT_V(6); PG8_BAR;
    for (;;) {
        const bool has_next = S.next(ui + 1, nxt);
        const char* nB = cB;
        if (has_next) { PG8_OFFS(on, nxt); nB = (const char*)Bt + (size_t)nxt.pn * tstep; }
        else {
#pragma unroll
            for (int h = 0; h < 2; ++h)
#pragma unroll
                for (int i = 0; i < 2; ++i) on[h][i] = oc[h][i]; }
        for (int t = 0; t < nt; t += 2) {
            const bool last = (t == nt - 2);
            const char* a1 = Ab + (size_t)(t + 1) * kstep;
            const char* a2 = last ? Ab : Ab + (size_t)(t + 2) * kstep; const char* b2 = last ? nB : cB + (size_t)(t + 2) * kstep;
            const char* a3 = a2 + kstep; const char* b3 = b2 + kstep;
            unsigned o2[2][2];
#pragma unroll
            for (int h = 0; h < 2; ++h)
#pragma unroll
                for (int i = 0; i < 2; ++i) o2[h][i] = last ? on[h][i] : oc[h][i];
            PG8_LDB(B0, 0, 0); PG8_LDB(B1, 0, 1); PG8_SCHED; PG8_LDA(At, 0, 0); PG8_STAGE(PG8_SA(1, 1), a1, oc[1]);
            PG8_WAIT_V(8); PG8_WAIT_L(0); PG8_BAR; PG8_MMA(0, 0, At, B0); PG8_MMA(0, 1, At, B1); PG8_BAR; PG8_SCHED;
            PG8_LDA(At, 0, 1); PG8_STAGE(PG8_SB(0, 0), b2, voffB); PG8_STAGE(PG8_SB(0, 1), b2 + hstep, voffB); PG8_STAGE(PG8_SA(0, 0), a2, o2[0]);
            PG8_WAIT_V(8); PG8_WAIT_L(0); PG8_BAR; PG8_MMA(1, 0, At, B0); PG8_MMA(1, 1, At, B1); PG8_BAR; PG8_SCHED;
            PG8_LDB(B0, 1, 0); PG8_LDB(B1, 1, 1); PG8_SCHED; PG8_LDA(At, 1, 0); PG8_STAGE(PG8_SA(0, 1), a2, o2[1]);
            PG8_WAIT_V(8); PG8_WAIT_L(0); PG8_BAR; PG8_MMA(0, 0, At, B0); PG8_MMA(0, 1, At, B1); PG8_BAR; PG8_SCHED;
            PG8_LDA(At, 1, 1); PG8_STAGE(PG8_SB(1, 0), b3, voffB); PG8_STAGE(PG8_SB(1, 1), b3 + hstep, voffB); PG8_STAGE(PG8_SA(1, 0), a3, o2[0]);
            PG8_WAIT_V(8); PG8_WAIT_L(0); PG8_BAR; PG8_MMA(1, 0, At, B0); PG8_MMA(1, 1, At, B1); PG8_BAR; PG8_SCHED;
        }
        if constexpr (ALIGN_EPI) { if (wr == 0) PG8_BAR; }
        E(acc, cur, wr, wc, fr, fq);
        if (!has_next) break;
#pragma unroll
        for (int a = 0; a < 2; ++a)
#pragma unroll
            for (int b = 0; b < 2; ++b)
#pragma unroll
                for (int m = 0; m < 4; ++m)
#pragma unroll
                    for (int n = 0; n < 2; ++n) acc[a][b][m][n] = (f32x4){0.f, 0.f, 0.f, 0.f};
        cur = nxt; cB = nB; ++ui;
#pragma unroll
        for (int h = 0; h < 2; ++h)
#pragma unroll
            for (int i = 0; i < 2; ++i) oc[h][i] = on[h][i];
        if constexpr (ALIGN_EPI) { if (wr == 1) PG8_BAR; }
    }
    PG8_WAIT_V(0);
    if constexpr (!ALIGN_EPI) { if (wr == 0) PG8_BAR; }
    PG8_BAR;
#undef PG8_SA
#undef PG8_SB
#undef PG8_STAGE
#undef PG8_LDA
#undef PG8_LDB
#undef PG8_MMA
#undef PG8_WAIT_V
#undef PG8_WAIT_L
#undef PG8_BAR
#undef PG8_SCHED
#undef PG8_OFFS
}

__device__ __forceinline__ void tr_item(const float* __restrict__ W, int ldw, int k0, const float* __restrict__ gain, float scale, bf16_t* dst  , int Kd, LAS float* scr, int lane) {
#pragma unroll 8
    for (int i = 0; i < 32; ++i) { const int kk = 2 * i + (lane >> 5); float v = W[(size_t)(k0 + kk) * ldw + (lane & 31)]; const float g = gain ? gain[k0 + kk] : 1.f; scr[kk * 33 + (lane & 31)] = v * g * scale; }
    asm volatile("s_waitcnt lgkmcnt(0)" ::: "memory");
    const int c = lane & 7;
#pragma unroll
    for (int j = 0; j < 4; ++j) { const int n = (lane >> 3) + 8 * j; const LAS float* s = scr + (8 * c) * 33 + n;
        u32x4 o; o.x = pk2(s[0 * 33], s[1 * 33]); o.y = pk2(s[2 * 33], s[3 * 33]); o.z = pk2(s[4 * 33], s[5 * 33]); o.w = pk2(s[6 * 33], s[7 * 33]);
        *(u32x4*)(dst + (size_t)n * Kd + k0 + 8 * c) = o; }
    asm volatile("s_waitcnt lgkmcnt(0)" ::: "memory");
}
__device__ __forceinline__ void p0_weights(const Args& a, LAS unsigned char* lds, int gw, int NGW, int lane, int wave) {
    LAS float* scr = (LAS float*)(lds + wave * 16384);
    unsigned char* ws = a.ws;
    bf16_t* WIN = (bf16_t*)(ws + WS_WIN); bf16_t* WOUT = (bf16_t*)(ws + WS_WOUT); bf16_t* WKVQ = (bf16_t*)(ws + WS_WKVQ); bf16_t* WFO = (bf16_t*)(ws + WS_WFO);
    bf16_t* WEUP = (bf16_t*)(ws + WS_WEUP); bf16_t* WEDN = (bf16_t*)(ws + WS_WEDN);
    constexpr int I_IN = 16 * 96, I_OUT = 16 * 32, I_KV = 16 * 64, I_FQ = 16 * 32, I_FOG = 16 * 32, I_FO = 16 * 32;
    constexpr int I_SMALL = I_IN + I_OUT + I_KV + I_FQ + I_FOG + I_FO;
    constexpr int I_EG = 16 * 16, I_ED = 8 * 32;
    constexpr int I_EXP = 2 * I_EG + I_ED;
    constexpr int NITEMS = I_SMALL + 2 * NEXP * I_EXP;
    for (int it = gw; it < NITEMS; it += NGW) {
        int r = it;
        if (r < I_IN) { const int kb = r / 96, nb = r % 96; const int n0 = nb * 32; tr_item(a.in[2] + n0, 3088, kb * 64, a.in[1], n0 < 512 ? GLA_QSCALE : 1.f, WIN + (size_t)n0 * 1024, 1024, scr, lane); continue; } r -= I_IN;
        if (r < I_OUT) { const int kb = r / 32, n0 = (r % 32) * 32; tr_item(a.in[6] + n0, 1024, kb * 64, a.in[5], 1.f, WOUT + (size_t)n0 * 1024, 1024, scr, lane); continue; } r -= I_OUT;
        if (r < I_KV) { const int kb = r / 64, n0 = (r % 64) * 32; tr_item(a.in[8] + n0, 2064, kb * 64, a.in[7], 1.f, WKVQ + (size_t)n0 * 1024, 1024, scr, lane); continue; } r -= I_KV;
        if (r < I_FQ) { const int kb = r / 32, n0 = (r % 32) * 32; tr_item(a.in[11] + n0, 2048, kb * 64, a.in[10], ATT_C2, WKVQ + (size_t)(2048 + n0) * 1024, 1024, scr, lane); continue; } r -= I_FQ;
        if (r < I_FOG) { const int kb = r / 32, n0 = (r % 32) * 32; tr_item(a.in[11] + 1024 + n0, 2048, kb * 64, a.in[10], 1.f, WKVQ + (size_t)(3072 + n0) * 1024, 1024, scr, lane); continue; } r -= I_FOG;
        if (r < I_FO) { const int kb = r / 32, n0 = (r % 32) * 32; tr_item(a.in[12] + n0, 1024, kb * 64, nullptr, 1.f, WFO + (size_t)n0 * 1024, 1024, scr, lane); continue; } r -= I_FO;
        const int le = r / I_EXP, l = le / NEXP; int q = r % I_EXP;
        const float* gain = a.in[13] + l * 1024;
        if (q < 2 * I_EG) { const int up = q >= I_EG; if (up) q -= I_EG; const int kb = q / 16, n0 = (q % 16) * 32;
            const float* W = (up ? a.in[19] : a.in[18]) + (size_t)le * 1024 * 512 + n0;
            bf16_t* dst = WEUP + ((size_t)le * 1024 + (n0 >> 7) * 256 + up * 128 + (n0 & 127)) * 1024;
            tr_item(W, 512, kb * 64, gain, 1.f, dst, 1024, scr, lane); continue; }
        q -= 2 * I_EG;
        { const int kb = q / 32, n0 = (q % 32) * 32; tr_item(a.in[20] + (size_t)le * 512 * 1024 + n0, 1024, kb * 64, nullptr, 1.f, WEDN + ((size_t)le * 1024 + n0) * 512, 512, scr, lane); }
    }
    float* SK = (float*)(ws + WS_SKINNY);
    const int gt = gw * 64 + lane, NGT = NGW * 64;
    for (int i = gt; i < (16 + 36 + 36 + 16) * 1024; i += NGT) {
        const int n = i >> 10, k = i & 1023; float v;
        if (n < 16) v = a.in[1][k] * a.in[2][(size_t)k * 3088 + 3072 + n];
        else if (n < 52) { const int m = n - 16; v = a.in[13][k] * (m < 4 ? a.in[14][k * 4 + m] : a.in[16][k * 32 + (m - 4)]); }
        else if (n < 88) { const int m = n - 52; v = a.in[13][1024 + k] * (m < 4 ? a.in[14][4096 + k * 4 + m] : a.in[16][32768 + k * 32 + (m - 4)]); }
        else { const int m = n - 88; v = a.in[7][k] * a.in[8][(size_t)k * 2064 + 2048 + m]; }
        SK[i] = v;
    }
    if (blockIdx.x == 0 && threadIdx.x < 64) ((int*)(ws + WS_CTL))[threadIdx.x] = 0;
}

struct RowRegs { f32x4 v[4]; };
__device__ __forceinline__ RowRegs row_load(const float* p, int lane) { RowRegs r; const f32x4* q = (const f32x4*)p + lane;
#pragma unroll
    for (int j = 0; j < 4; ++j) r.v[j] = q[64 * j];
    return r; }
__device__ __forceinline__ float row_rs(const RowRegs& r) { float s = 0.f;
#pragma unroll
    for (int j = 0; j < 4; ++j) s += (r.v[j][0] * r.v[j][0] + r.v[j][1] * r.v[j][1]) + (r.v[j][2] * r.v[j][2] + r.v[j][3] * r.v[j][3]);
    return 1.0f / sqrtf(wave_sum(s) * (1.0f / 1024.0f) + RMS_EPS); }
__device__ __forceinline__ void row_store_bf16(bf16_t* p, const RowRegs& r, float rs, int lane) { u32x2* o = (u32x2*)p + lane;
#pragma unroll
    for (int j = 0; j < 4; ++j) { u32x2 w; w.x = pk2(r.v[j][0] * rs, r.v[j][1] * rs); w.y = pk2(r.v[j][2] * rs, r.v[j][3] * rs); o[64 * j] = w; } }
__device__ __forceinline__ float row_dot(const RowRegs& r, const float* w, int lane) { const f32x4* q = (const f32x4*)w + lane; float s = 0.f;
#pragma unroll
    for (int j = 0; j < 4; ++j) { const f32x4 x = q[64 * j]; s += (r.v[j][0] * x[0] + r.v[j][1] * x[1]) + (r.v[j][2] * x[2] + r.v[j][3] * x[3]); }
    return wave_sum(s); }
__device__ __forceinline__ void row_add_bf16(RowRegs& r, const bf16_t* p, float g, int lane) { const u32x2* q = (const u32x2*)p + lane;
#pragma unroll
    for (int j = 0; j < 4; ++j) { const u32x2 w = q[64 * j]; r.v[j][0] += g * bflo(w.x); r.v[j][1] += g * bfhi(w.x); r.v[j][2] += g * bflo(w.y); r.v[j][3] += g * bfhi(w.y); } }

__device__ __forceinline__ void p1_rows(const Args& a, int gw, int NGW, int lane) {
    bf16_t* XN = (bf16_t*)(a.ws + AB_XN); float* AA = (float*)(a.ws + AB_AA); const float* WA = (const float*)(a.ws + WS_SKINNY) + SK_WA;
    for (int t = gw; t < T; t += NGW) {
        const RowRegs r = row_load(a.in[0] + (size_t)t * D, lane); const float rs = row_rs(r);
        row_store_bf16(XN + (size_t)t * D, r, rs, lane);
        float mine = 0.f;
#pragma unroll
        for (int n = 0; n < 16; ++n) { const float d = row_dot(r, WA + n * 1024, lane) * rs; if (lane == n) mine = d; }
        if (lane < 16) AA[(size_t)t * 16 + lane] = mine;
    }
}

__device__ __forceinline__ void combine_row(RowRegs& r, const unsigned char* ws, const MoeTab& tab, int t, int lane) {
    const i32x4 ti = ((const i32x4*)(ws + AB_TOKI))[t]; const f32x2 tg = ((const f32x2*)(ws + AB_TOKG))[t];
    const bf16_t* YS = (const bf16_t*)(ws + AB_YS);
    const int p0 = tab.tstart[ti.x] * BM + ti.z, p1 = tab.tstart[ti.y] * BM + ti.w;
    row_add_bf16(r, YS + (size_t)p0 * D, tg.x, lane); row_add_bf16(r, YS + (size_t)p1 * D, tg.y, lane);
}
__device__ __forceinline__ void p10_rows(const Args& a, LAS unsigned char* lds, int layer, int gw, int NGW, int lane) {
    const MoeTab tab = moe_tab(lds); moe_tab_build(tab, (const int*)(a.ws + WS_CTL) + layer * 32);
    bf16_t* XN = (bf16_t*)(a.ws + AB_XN); float* LF = (float*)(a.ws + AB_LF); const float* WF = (const float*)(a.ws + WS_SKINNY) + SK_WF;
    for (int t = gw; t < T; t += NGW) {
        RowRegs r = row_load(a.out + (size_t)t * D, lane); combine_row(r, a.ws, tab, t, lane);
        f32x4* o = (f32x4*)(a.out + (size_t)t * D) + lane;
#pragma unroll
        for (int j = 0; j < 4; ++j) o[64 * j] = r.v[j];
        const float rs = row_rs(r); row_store_bf16(XN + (size_t)t * D, r, rs, lane);
        float mine = 0.f;
#pragma unroll
        for (int n = 0; n < 16; ++n) { const float d = row_dot(r, WF + n * 1024, lane) * rs; if (lane == n) mine = d; }
        if (lane < 16) LF[(size_t)t * 16 + lane] = log_sigmoid(mine + a.in[9][lane]);
    }
}
__device__ __forceinline__ void p17_rows(const Args& a, LAS unsigned char* lds, int layer, int gw, int NGW, int lane) {
    const MoeTab tab = moe_tab(lds); moe_tab_build(tab, (const int*)(a.ws + WS_CTL) + layer * 32);
    const f32x4* fn = (const f32x4*)a.in[21] + lane;
    for (int t = gw; t < T; t += NGW) {
        RowRegs r = row_load(a.out + (size_t)t * D, lane); combine_row(r, a.ws, tab, t, lane);
        const float rs = row_rs(r);
        f32x4* o = (f32x4*)(a.out + (size_t)t * D) + lane;
#pragma unroll
        for (int j = 0; j < 4; ++j) o[64 * j] = r.v[j] * rs * fn[64 * j];
    }
}

__device__ __forceinline__ void route_phase(const Args& a, LAS unsigned char* lds, int layer, int lane, int wave) {
    bf16_t* XN = (bf16_t*)(a.ws + AB_XN); const float* WR = (const float*)(a.ws + WS_SKINNY) + (layer ? SK_WR1 : SK_WR0);
    int* gcnt = (int*)(a.ws + WS_CTL) + layer * 32; int* LIST = (int*)(a.ws + AB_LIST); i32x4* TOKI = (i32x4*)(a.ws + AB_TOKI); f32x2* TOKG = (f32x2*)(a.ws + AB_TOKG);
    const float* bc = a.in[15] + layer * 4; const float* bfine = a.in[17] + layer * 32;
    LAS int* be = (LAS int*)(lds);
    LAS int* rk = be + 256;
    LAS int* lcnt = rk + 256;
    LAS int* lbase = lcnt + 32;
    LAS float* bg = (LAS float*)(lbase + 32);
    for (int batch = blockIdx.x; batch < T / 128; batch += gridDim.x) {
        if (threadIdx.x < 32) lcnt[threadIdx.x] = 0;
        for (int i = 0; i < 16; ++i) {
            const int lr = wave * 16 + i, t = batch * 128 + lr;
            const RowRegs r = row_load(a.out + (size_t)t * D, lane); const float rs = row_rs(r);
            row_store_bf16(XN + (size_t)t * D, r, rs, lane);
            float mine = 0.f;
#pragma unroll 2
            for (int n = 0; n < 36; ++n) { const float d = row_dot(r, WR + n * 1024, lane) * rs; if (lane == n) mine = d; }
            const float c0 = __shfl(mine, 0) + bc[0], c1 = __shfl(mine, 1) + bc[1], c2 = __shfl(mine, 2) + bc[2], c3 = __shfl(mine, 3) + bc[3];
            int gi = 0; float cm = c0; if (c1 > cm) { cm = c1; gi = 1; } if (c2 > cm) { cm = c2; gi = 2; } if (c3 > cm) { cm = c3; gi = 3; }
            const float pc = 1.f / (__expf(c0 - cm) + __expf(c1 - cm) + __expf(c2 - cm) + __expf(c3 - cm));
            float f[8];
#pragma unroll
            for (int j = 0; j < 8; ++j) f[j] = __shfl(mine, 4 + gi * 8 + j) + bfine[gi * 8 + j];
            int j0 = 0; float m0 = f[0];
#pragma unroll
            for (int j = 1; j < 8; ++j) if (f[j] > m0) { m0 = f[j]; j0 = j; }
            int j1 = -1; float m1 = -INFINITY;
#pragma unroll
            for (int j = 0; j < 8; ++j) if (j != j0 && f[j] > m1) { m1 = f[j]; j1 = j; }
            const float e1 = __expf(m1 - m0), inv = 1.f / (1.f + e1);
            if (lane == 0) { be[lr * 2] = gi * 8 + j0; be[lr * 2 + 1] = gi * 8 + j1; bg[lr * 2] = pc * inv; bg[lr * 2 + 1] = pc * e1 * inv; }
        }
        __syncthreads();
        if (threadIdx.x < 256) rk[threadIdx.x] = atomicAdd((int*)&lcnt[be[threadIdx.x]], 1);
        __syncthreads();
        if (threadIdx.x < 32) lbase[threadIdx.x] = lcnt[threadIdx.x] ? atomicAdd(&gcnt[threadIdx.x], lcnt[threadIdx.x]) : 0;
        __syncthreads();
        if (threadIdx.x < 256) { const int e = be[threadIdx.x], idx = lbase[e] + rk[threadIdx.x]; LIST[e * T + idx] = batch * 128 + (threadIdx.x >> 1); rk[threadIdx.x] = idx; }
        __syncthreads();
        if (threadIdx.x < 128) { const int lr = threadIdx.x; TOKI[batch * 128 + lr] = (i32x4){be[lr * 2], be[lr * 2 + 1], rk[lr * 2], rk[lr * 2 + 1]}; TOKG[batch * 128 + lr] = (f32x2){bg[lr * 2], bg[lr * 2 + 1]}; }
        __syncthreads();
    }
}

__device__ __forceinline__ void gla_alpha_naive(const Args& a) {
    const float* AA = (const float*)(a.ws + AB_AA); float* AL = (float*)(a.ws + AB_ALPHA); const float* w2 = a.in[3]; const float* ba = a.in[4];
    for (size_t i = (size_t)blockIdx.x * NTHREADS + threadIdx.x; i < (size_t)T * 512; i += (size_t)gridDim.x * NTHREADS) {
        const int t = (int)(i >> 9), hd = (int)(i & 511); float z = ba[hd];
#pragma unroll
        for (int r = 0; r < 16; ++r) z += AA[(size_t)t * 16 + r] * w2[r * 512 + hd];
        AL[i] = __expf(log_sigmoid(z) * (1.f / 16.f));
    }
}
__device__ __forceinline__ void gla_scan_naive(const Args& a, int gw, int NGW, int lane) {
    const bf16_t* __restrict__ Q = (const bf16_t*)(a.ws + AB_Q); const bf16_t* __restrict__ K = (const bf16_t*)(a.ws + AB_K); bf16_t* V = (bf16_t*)(a.ws + AB_V);
    const float* __restrict__ AL = (const float*)(a.ws + AB_ALPHA); float* SSQ = (float*)(a.ws + AB_SSQ);
    for (int item = gw; item < 256; item += NGW) {
        const int b = item >> 4, h = (item >> 2) & 3, sl = item & 3, e = h * 256 + sl * 64 + lane;
        float St[128];
#pragma unroll
        for (int d = 0; d < 128; ++d) St[d] = 0.f;
        for (int t = 0; t < SEQ; ++t) {
            const size_t row = (size_t)b * SEQ + t;
            const float v = bf2f(V[row * D + e]);
            const u32x4* qp = (const u32x4*)(Q + row * 512 + h * 128); const u32x4* kp = (const u32x4*)(K + row * 512 + h * 128); const f32x4* ap = (const f32x4*)(AL + row * 512 + h * 128);
            float o = 0.f;
#pragma unroll
            for (int c = 0; c < 16; ++c) { const u32x4 qw = qp[c], kw = kp[c]; const f32x4 a0 = ap[2 * c], a1 = ap[2 * c + 1];
                const float qf[8] = {bflo(qw.x), bfhi(qw.x), bflo(qw.y), bfhi(qw.y), bflo(qw.z), bfhi(qw.z), bflo(qw.w), bfhi(qw.w)};
                const float kf[8] = {bflo(kw.x), bfhi(kw.x), bflo(kw.y), bfhi(kw.y), bflo(kw.z), bfhi(kw.z), bflo(kw.w), bfhi(kw.w)};
                const float af[8] = {a0[0], a0[1], a0[2], a0[3], a1[0], a1[1], a1[2], a1[3]};
#pragma unroll
                for (int j = 0; j < 8; ++j) { const int d = c * 8 + j; St[d] = af[j] * St[d] + kf[j] * v; o += qf[j] * St[d]; } }
            V[row * D + e] = (bf16_t)f2bf(o);
            const float ss = wave_sum(o * o);
            if (lane == 0) SSQ[row * 16 + h * 4 + sl] = ss;
        }
    }
}
__device__ __forceinline__ void gla_post(const Args& a) {
    bf16_t* V = (bf16_t*)(a.ws + AB_V); const bf16_t* R = (const bf16_t*)(a.ws + AB_R); const float* SSQ = (const float*)(a.ws + AB_SSQ);
    for (size_t i = (size_t)blockIdx.x * NTHREADS + threadIdx.x; i < (size_t)T * 128; i += (size_t)gridDim.x * NTHREADS) {
        const size_t t = i >> 7; const int c8 = (int)(i & 127) * 8, h = c8 >> 8;
        const f32x4 sq = *(const f32x4*)(SSQ + t * 16 + h * 4);
        const float rstd = 1.0f / sqrtf(((sq[0] + sq[1]) + (sq[2] + sq[3])) * (1.f / 256.f) + RMS_EPS);
        const u32x4 ow = *(const u32x4*)(V + t * D + c8), rw = *(const u32x4*)(R + t * D + c8);
        const unsigned oo[4] = {ow.x, ow.y, ow.z, ow.w}, rr[4] = {rw.x, rw.y, rw.z, rw.w}; unsigned res[4];
#pragma unroll
        for (int j = 0; j < 4; ++j) { const float r0 = bflo(rr[j]), r1 = bfhi(rr[j]); res[j] = pk2(bflo(oo[j]) * rstd * r0 * sigmoidf_(r0), bfhi(oo[j]) * rstd * r1 * sigmoidf_(r1)); }
        *(u32x4*)(V + t * D + c8) = (u32x4){res[0], res[1], res[2], res[3]};
    }
}

__device__ __forceinline__ void fox_cumsum(const Args& a, int gw, int NGW, int lane) {
    const float* LF = (const float*)(a.ws + AB_LF); float* C = (float*)(a.ws + AB_C);
    for (int item = gw; item < 256; item += NGW) {
        const int b = item >> 4, h = item & 15; float loc[32]; float s = 0.f;
#pragma unroll
        for (int i = 0; i < 32; ++i) { s += LF[((size_t)b * SEQ + lane * 32 + i) * 16 + h]; loc[i] = s; }
        float incl = s;
#pragma unroll
        for (int o = 1; o < 64; o <<= 1) { const float n = __shfl_up(incl, o); if (lane >= o) incl += n; }
        const float excl = incl - s;
#pragma unroll
        for (int i = 0; i < 32; ++i) C[(size_t)item * SEQ + lane * 32 + i] = loc[i] + excl;
    }
}
__device__ __forceinline__ void fox_attn_naive(const Args& a, int gw, int NGW, int lane) {
    bf16_t* Q = (bf16_t*)(a.ws + AB_FQ); const bf16_t* __restrict__ K = (const bf16_t*)(a.ws + AB_FK); const bf16_t* __restrict__ V = (const bf16_t*)(a.ws + AB_FV);
    const bf16_t* __restrict__ OG = (const bf16_t*)(a.ws + AB_FOG); const float* __restrict__ C = (const float*)(a.ws + AB_C);
    for (int item = gw; item < 8192; item += NGW) {
        const int bh = item >> 5, tb = item & 31, b = bh >> 4, h = bh & 15, t = tb * 64 + lane;
        const size_t row = (size_t)b * SEQ + t;
        float q[64], o[64];
#pragma unroll
        for (int c = 0; c < 8; ++c) { const u32x4 w = *(const u32x4*)(Q + row * D + h * 64 + c * 8); q[c * 8 + 0] = bflo(w.x); q[c * 8 + 1] = bfhi(w.x); q[c * 8 + 2] = bflo(w.y); q[c * 8 + 3] = bfhi(w.y); q[c * 8 + 4] = bflo(w.z); q[c * 8 + 5] = bfhi(w.z); q[c * 8 + 6] = bflo(w.w); q[c * 8 + 7] = bfhi(w.w); }
#pragma unroll
        for (int d = 0; d < 64; ++d) o[d] = 0.f;
        float m = -INFINITY, l = 0.f; const float cref = C[(size_t)bh * SEQ + tb * 64 + 63];
        const int smax = tb * 64 + 63;
        for (int s = 0; s <= smax; ++s) {
            const size_t krow = (size_t)b * SEQ + s; float x = 0.f;
#pragma unroll
            for (int c = 0; c < 8; ++c) { const u32x4 w = *(const u32x4*)(K + krow * D + h * 64 + c * 8);
                x += q[c * 8 + 0] * bflo(w.x) + q[c * 8 + 1] * bfhi(w.x) + q[c * 8 + 2] * bflo(w.y) + q[c * 8 + 3] * bfhi(w.y) + q[c * 8 + 4] * bflo(w.z) + q[c * 8 + 5] * bfhi(w.z) + q[c * 8 + 6] * bflo(w.w) + q[c * 8 + 7] * bfhi(w.w); }
            x += (cref - C[(size_t)bh * SEQ + s]) * LOG2E;
            if (s > t) x = -INFINITY;
            const float mn = fmaxf(m, x); const float sc = (mn == -INFINITY) ? 1.f : exp2f(m - mn), p = (mn == -INFINITY) ? 0.f : exp2f(x - mn);
            m = mn; l = l * sc + p;
#pragma unroll
            for (int c = 0; c < 8; ++c) { const u32x4 w = *(const u32x4*)(V + krow * D + h * 64 + c * 8);
                const float vv[8] = {bflo(w.x), bfhi(w.x), bflo(w.y), bfhi(w.y), bflo(w.z), bfhi(w.z), bflo(w.w), bfhi(w.w)};
#pragma unroll
                for (int j = 0; j < 8; ++j) o[c * 8 + j] = o[c * 8 + j] * sc + p * vv[j]; }
        }
        const float il = 1.f / l;
#pragma unroll
        for (int c = 0; c < 8; ++c) { const u32x4 g = *(const u32x4*)(OG + row * D + h * 64 + c * 8); const unsigned gg[4] = {g.x, g.y, g.z, g.w}; unsigned res[4];
#pragma unroll
            for (int j = 0; j < 4; ++j) res[j] = pk2(o[c * 8 + 2 * j] * il * sigmoidf_(bflo(gg[j])), o[c * 8 + 2 * j + 1] * il * sigmoidf_(bfhi(gg[j])));
            *(u32x4*)(Q + row * D + h * 64 + c * 8) = (u32x4){res[0], res[1], res[2], res[3]}; }
    }
}

constexpr int NPHASES = 18;
__global__ void __launch_bounds__(NTHREADS, 2) fwd(Args a) {
    extern __shared__ __attribute__((aligned(16))) unsigned char lds_raw[];
    LAS unsigned char* lds = (LAS unsigned char*)lds_raw;
    cg::grid_group grid = cg::this_grid();
    const int tid = threadIdx.x, lane = tid & 63, wave = __builtin_amdgcn_readfirstlane(tid >> 6);
    const int G = gridDim.x, gw = blockIdx.x * NWAVES + wave, NGW = G * NWAVES;
    unsigned char* ws = a.ws;
    const int lo = a.ph_lo, hi = a.ph_hi;
#ifdef ONLY_PHASE
#define IN(k) ((k) == ONLY_PHASE && lo <= (k) && (k) < hi)
#else
#define IN(k) (lo <= (k) && (k) < hi)
#endif
#define SEAM(k) do { if (IN(k) && IN((k) + 1)) grid.sync(); } while (0)
    if (IN(0)) { p0_weights(a, lds, gw, NGW, lane, wave); } SEAM(0);
    if (IN(1)) { p1_rows(a, gw, NGW, lane); } SEAM(1);
    if (IN(2)) {
        StaticOrder S; S.init(T, 3072, G, blockIdx.x);
        EpiSplitBf16<0> E{ws};
        gemm_phase<EpiSplitBf16<0>, StaticOrder, IdMap, true>(lds, (const bf16_t*)(ws + AB_XN), (const bf16_t*)(ws + WS_WIN), 1024, S, E, IdMap{});
    } SEAM(2);
    if (IN(3)) { gla_alpha_naive(a); } SEAM(3);
    if (IN(4)) { gla_scan_naive(a, gw, NGW, lane); } SEAM(4);
    if (IN(5)) { gla_post(a); } SEAM(5);
    if (IN(6)) {
        StaticOrder S; S.init(T, 1024, G, blockIdx.x); EpiResF32 E{a.in[0], a.out};
        gemm_phase<EpiResF32, StaticOrder, IdMap, true>(lds, (const bf16_t*)(ws + AB_V), (const bf16_t*)(ws + WS_WOUT), 1024, S, E, IdMap{});
    } SEAM(6);
#define MOE_PHASES(layer, pb) \
    if (IN(pb)) { route_phase(a, lds, layer, lane, wave); } SEAM(pb); \
    if (IN(pb + 1)) { \
        const MoeTab tab = moe_tab(lds); moe_tab_build(tab, (const int*)(ws + WS_CTL) + layer * 32); \
        MoeOrder S; S.so.init(tab.tstart[32] * BM, 1024, G, blockIdx.x); S.tab = tab; \
        MoeGather AM{tab, (const int*)(ws + AB_LIST)}; EpiSwiGLU E{(bf16_t*)(ws + AB_HB)}; \
        gemm_phase<EpiSwiGLU, MoeOrder, MoeGather, true>(lds, (const bf16_t*)(ws + AB_XN), (const bf16_t*)(ws + WS_WEUP) + (size_t)layer * 32 * 1024 * 1024, 1024, S, E, AM); \
        __syncthreads(); \
    } SEAM(pb + 1); \
    if (IN(pb + 2)) { \
        const MoeTab tab = moe_tab(lds); moe_tab_build(tab, (const int*)(ws + WS_CTL) + layer * 32); \
        MoeOrder S; S.so.init(tab.tstart[32] * BM, 1024, G, blockIdx.x); S.tab = tab; \
        EpiMoeDown E{(bf16_t*)(ws + AB_YS)}; \
        gemm_phase<EpiMoeDown, MoeOrder, IdMap, true>(lds, (const bf16_t*)(ws + AB_HB), (const bf16_t*)(ws + WS_WEDN) + (size_t)layer * 32 * 1024 * 512, 512, S, E, IdMap{}); \
        __syncthreads(); \
    } SEAM(pb + 2);
    MOE_PHASES(0, 7)
    if (IN(10)) { p10_rows(a, lds, 0, gw, NGW, lane); __syncthreads(); } SEAM(10);
    if (IN(11)) {
        fox_cumsum(a, gw, NGW, lane);
        StaticOrder S; S.init(T, 4096, G, blockIdx.x);
        EpiSplitBf16<1> E{ws};
        gemm_phase<EpiSplitBf16<1>, StaticOrder, IdMap, true>(lds, (const bf16_t*)(ws + AB_XN), (const bf16_t*)(ws + WS_WKVQ), 1024, S, E, IdMap{});
    } SEAM(11);
    if (IN(12)) { fox_attn_naive(a, gw, NGW, lane); } SEAM(12);
    if (IN(13)) {
        StaticOrder S; S.init(T, 1024, G, blockIdx.x); EpiResF32 E{a.out, a.out};
        gemm_phase<EpiResF32, StaticOrder, IdMap, true>(lds, (const bf16_t*)(ws + AB_FQ), (const bf16_t*)(ws + WS_WFO), 1024, S, E, IdMap{});
    } SEAM(13);
    MOE_PHASES(1, 14)
    if (IN(17)) { p17_rows(a, lds, 1, gw, NGW, lane); }
#undef IN
#undef SEAM
}

#ifndef ONE_LAUNCH
#define ONE_LAUNCH 1
#endif
extern "C" void kernel_launch(void* const* d_in, const int* in_sizes, int n_in, void* d_out, int out_size, void* d_ws, size_t ws_size, hipStream_t stream) {
    static int grid = 0;
    if (grid == 0) {
        if (n_in != 22 || out_size != T * D || ws_size < WS_END) { fprintf(stderr, "kernel_launch: unexpected shapes (n_in %d, out %d, ws %zu < %zu)\n", n_in, out_size, ws_size, (size_t)WS_END); grid = -1; return; }
        int dev = 0, cus = 0, per_cu = 0;
        hipGetDevice(&dev); hipDeviceGetAttribute(&cus, hipDeviceAttributeMultiprocessorCount, dev);
        hipFuncSetAttribute((const void*)fwd, hipFuncAttributeMaxDynamicSharedMemorySize, LDS_BYTES);
        hipOccupancyMaxActiveBlocksPerMultiprocessor(&per_cu, (const void*)fwd, NTHREADS, LDS_BYTES);
        if (per_cu < 1) { fprintf(stderr, "kernel_launch: occupancy query says %d blocks per CU\n", per_cu); grid = -1; return; }
        grid = cus;
        fprintf(stderr, "kernel_launch: grid %d (per_cu %d), ws %zu\n", grid, per_cu, ws_size);
    }
    if (grid < 0) return;
    Args a{};
    for (int i = 0; i < 22; ++i) a.in[i] = (const float*)d_in[i];
    a.out = (float*)d_out; a.ws = (unsigned char*)d_ws;
#if ONE_LAUNCH
    a.ph_lo = 0; a.ph_hi = NPHASES;
    void* args[] = {&a};
    hipError_t e = hipLaunchCooperativeKernel((const void*)fwd, dim3(grid), dim3(NTHREADS), args, LDS_BYTES, stream);
    if (e != hipSuccess) fprintf(stderr, "cooperative launch failed: %s\n", hipGetErrorString(e));
#else
    for (int p = 0; p < NPHASES; ++p) {
        a.ph_lo = p; a.ph_hi = p + 1;
        hipLaunchKernelGGL(fwd, dim3(grid), dim3(NTHREADS), LDS_BYTES, stream, a);
    }
#endif
}
```

```cpp
#include <hip/hip_runtime.h>
#include <hip/hip_cooperative_groups.h>
#include <cstdio>
#include <cstdint>
namespace cg = cooperative_groups;

#define LAS __attribute__((address_space(3)))
typedef unsigned short bf16_t;
typedef short bf16x8 __attribute__((ext_vector_type(8)));
typedef float f32x4 __attribute__((ext_vector_type(4)));
typedef float f32x2 __attribute__((ext_vector_type(2)));
typedef unsigned u32x4 __attribute__((ext_vector_type(4)));
typedef unsigned u32x2 __attribute__((ext_vector_type(2)));
typedef int i32x4 __attribute__((ext_vector_type(4)));

constexpr int T = 32768, D = 1024, NBATCH = 16, SEQ = 2048;
constexpr int NWAVES = 8, NTHREADS = 512;
constexpr float RMS_EPS = 1e-6f;
constexpr float LOG2E = 1.4426950408889634f;
constexpr float ATT_C2 = 0.125f * LOG2E;
constexpr float GLA_QSCALE = 0.08838834764831845f;
constexpr int NEXP = 32;
constexpr int MAXTILES = 288;

constexpr size_t MiB = 1u << 20;
constexpr size_t WS_CTL = 0;
constexpr size_t WS_SKINNY = 256 * 1024;
constexpr size_t WS_WIN = 1 * MiB;
constexpr size_t WS_WOUT = WS_WIN + 6 * MiB;
constexpr size_t WS_WKVQ = WS_WOUT + 2 * MiB;
constexpr size_t WS_WFO = WS_WKVQ + 8 * MiB;
constexpr size_t WS_WEUP = WS_WFO + 2 * MiB;
constexpr size_t WS_WEDN = WS_WEUP + 128 * MiB;
constexpr size_t WS_AB = WS_WEDN + 64 * MiB;
constexpr size_t AB_XN = WS_AB;
constexpr size_t AB_Q = WS_AB + 64 * MiB;
constexpr size_t AB_K = WS_AB + 96 * MiB;
constexpr size_t AB_V = WS_AB + 128 * MiB;
constexpr size_t AB_R = WS_AB + 192 * MiB;
constexpr size_t AB_KHT = WS_AB + 256 * MiB;
constexpr size_t AB_PM = WS_AB + 288 * MiB;
constexpr size_t AB_EL = WS_AB + 304 * MiB;
constexpr size_t AB_AA = WS_AB + 305 * MiB;
constexpr size_t AB_SSQ = WS_AB + 307 * MiB;
constexpr size_t AB_ALPHA = AB_XN;
constexpr size_t AB_HB = WS_AB + 64 * MiB;
constexpr size_t AB_YS = WS_AB + 136 * MiB;
constexpr size_t AB_LIST = WS_AB + 280 * MiB;
constexpr size_t AB_TOKI = WS_AB + 284 * MiB;
constexpr size_t AB_TOKG = WS_AB + 285 * MiB;
constexpr size_t AB_FK = WS_AB + 64 * MiB;
constexpr size_t AB_FV = WS_AB + 128 * MiB;
constexpr size_t AB_FQ = WS_AB + 192 * MiB;
constexpr size_t AB_FOG = WS_AB + 256 * MiB;
constexpr size_t AB_LF = WS_AB + 320 * MiB;
constexpr size_t AB_C = WS_AB + 322 * MiB;
constexpr size_t WS_END = WS_AB + 324 * MiB;

constexpr int SK_WA = 0, SK_WR0 = 16 * 1024, SK_WR1 = SK_WR0 + 36 * 1024, SK_WF = SK_WR1 + 36 * 1024;

constexpr int RING_BYTES = 131072;
constexpr int LDS_MISC = RING_BYTES;
constexpr int LDS_BYTES = 147456;

__device__ __forceinline__ unsigned f2bf(float f) { unsigned u = __builtin_bit_cast(unsigned, f); return (u + 0x7fffu + ((u >> 16) & 1u)) >> 16; }
__device__ __forceinline__ unsigned pk2(float lo, float hi) { return f2bf(lo) | (f2bf(hi) << 16); }
__device__ __forceinline__ float bf2f(unsigned h) { return __builtin_bit_cast(float, h << 16); }
__device__ __forceinline__ float bflo(unsigned w) { return __builtin_bit_cast(float, w << 16); }
__device__ __forceinline__ float bfhi(unsigned w) { return __builtin_bit_cast(float, w & 0xffff0000u); }
__device__ __forceinline__ float wave_sum(float v) {
#pragma unroll
    for (int o = 1; o < 64; o <<= 1) v += __shfl_xor(v, o);
    return v;
}
__device__ __forceinline__ float log_sigmoid(float z) { return fminf(z, 0.f) - log1pf(__expf(-fabsf(z))); }
__device__ __forceinline__ float sigmoidf_(float z) { return 1.f / (1.f + __expf(-z)); }
__device__ __forceinline__ int lane_now() { int l; asm volatile("v_mbcnt_lo_u32_b32 %0, -1, 0\n\tv_mbcnt_hi_u32_b32 %0, -1, %0" : "=v"(l)); return l; }
#define TIDX (wave * 64 + lane_now())
__device__ __forceinline__ int perm32(int rho) { const int n = rho >> 4, i = rho & 15; return 8 * (i >> 2) + 4 * n + (i & 3); }

struct Args { const float* in[22]; float* out; unsigned char* ws; int ph_lo, ph_hi; };

struct Unit { int pm, pn; };
constexpr int BM = 256, HALF = 128, NXCD = 8, WGM = 8;
struct StaticOrder {
    int nM, nN, nwg, G, c;
    __device__ void init(int M, int N, int G_, int c_) { nM = M / BM; nN = N / BM; nwg = nM * nN; G = G_; c = c_; }
    __device__ bool next(int i, Unit& u) const {
        const long L = (long)i * G + c; if (L >= nwg) return false;
        int wgid = (int)L; { const int q = nwg / NXCD, r = nwg % NXCD, xcd = wgid % NXCD, off = wgid / NXCD; wgid = (xcd < r ? xcd * (q + 1) : r * (q + 1) + (xcd - r) * q) + off; }
        const int nig = WGM * nN, gid = wgid / nig, fm = gid * WGM, gsz = (nM - fm) < WGM ? (nM - fm) : WGM;
        u.pm = fm + ((wgid % nig) % gsz); u.pn = (wgid % nig) / gsz; return true;
    }
};
struct IdMap { __device__ __forceinline__ int row(const Unit& u, int r) const { return u.pm * BM + r; } };

struct MoeTab { LAS int* cnt; LAS int* tstart; LAS int* tile_e; };
__device__ __forceinline__ MoeTab moe_tab(LAS unsigned char* lds) { MoeTab t; t.cnt = (LAS int*)(lds + LDS_MISC); t.tstart = t.cnt + 32; t.tile_e = t.tstart + 64; return t; }
__device__ __forceinline__ void moe_tab_build(const MoeTab& t, const int* gcnt, int wave) {
    const int tidx = TIDX;
    if (tidx == 0) { int s = 0; for (int e = 0; e < NEXP; ++e) { const int c = gcnt[e]; t.cnt[e] = c; t.tstart[e] = s; s += (c + 255) >> 8; } t.tstart[32] = s; }
    __syncthreads();
    const int nt = t.tstart[32];
    for (int p = tidx; p < nt; p += NTHREADS) { int e = 0; for (int j = 1; j < NEXP; ++j) if (t.tstart[j] <= p) e = j; t.tile_e[p] = e; }
    __syncthreads();
}
struct MoeOrder {
    StaticOrder so; MoeTab tab;
    __device__ bool next(int i, Unit& u) const { if (!so.next(i, u)) return false; u.pn += 4 * tab.tile_e[u.pm]; return true; }
};
struct MoeGather {
    MoeTab tab; const int* list;
    __device__ __forceinline__ int row(const Unit& u, int r) const {
        const int e = u.pn >> 2; int idx = (u.pm - tab.tstart[e]) * BM + r; const int c = tab.cnt[e]; idx = idx < c ? idx : c - 1; return list[e * T + idx];
    }
};

template <int WHICH> struct EpiSplitBf16 {
    static constexpr bool PERM = true;
    unsigned char* ws;
    __device__ __forceinline__ void operator()(const f32x4 (&acc)[2][2][4][2], const Unit& u, int wr, int wc, int fr, int fq) const {
        size_t off; int ldc, f0;
        if (WHICH == 0) { if (u.pn < 2) { off = AB_Q; ldc = 512; f0 = 0; } else if (u.pn < 4) { off = AB_K; ldc = 512; f0 = 2; } else if (u.pn < 8) { off = AB_V; ldc = 1024; f0 = 4; } else { off = AB_R; ldc = 1024; f0 = 8; } }
        else { off = AB_FK + (size_t)(u.pn >> 2) * (64 * MiB); ldc = 1024; f0 = u.pn & ~3; }
        bf16_t* base = (bf16_t*)(ws + off);
        const int row0 = u.pm * BM + wr * 64 + fr, col0 = (u.pn - f0) * BM + wc * 32 + 8 * fq;
#pragma unroll
        for (int ai = 0; ai < 2; ++ai)
#pragma unroll
            for (int m = 0; m < 4; ++m) { bf16_t* rowp = base + (size_t)(row0 + ai * HALF + m * 16) * ldc + col0;
#pragma unroll
                for (int bj = 0; bj < 2; ++bj) { const f32x4 v0 = acc[ai][bj][m][0], v1 = acc[ai][bj][m][1];
                    u32x4 w; w.x = pk2(v0[0], v0[1]); w.y = pk2(v0[2], v0[3]); w.z = pk2(v1[0], v1[1]); w.w = pk2(v1[2], v1[3]);
                    *(u32x4*)(rowp + bj * HALF) = w; } }
    }
};
struct EpiResF32 {
    static constexpr bool PERM = false;
    const float* base; float* out;
    __device__ __forceinline__ void operator()(const f32x4 (&acc)[2][2][4][2], const Unit& u, int wr, int wc, int fr, int fq) const {
        const int row0 = u.pm * BM + wr * 64 + fr, col0 = u.pn * BM + wc * 32 + 4 * fq;
#pragma unroll
        for (int ai = 0; ai < 2; ++ai)
#pragma unroll
            for (int m = 0; m < 4; ++m) { const size_t off = (size_t)(row0 + ai * HALF + m * 16) * D + col0;
#pragma unroll
                for (int bj = 0; bj < 2; ++bj)
#pragma unroll
                    for (int n = 0; n < 2; ++n) { const f32x4 b = *(const f32x4*)(base + off + bj * HALF + n * 16); *(f32x4*)(out + off + bj * HALF + n * 16) = b + acc[ai][bj][m][n]; } }
    }
};
struct EpiSwiGLU {
    static constexpr bool PERM = true;
    bf16_t* hb;
    __device__ __forceinline__ void operator()(const f32x4 (&acc)[2][2][4][2], const Unit& u, int wr, int wc, int fr, int fq) const {
        const int row0 = u.pm * BM + wr * 64 + fr, col0 = (u.pn & 3) * 128 + wc * 32 + 8 * fq;
#pragma unroll
        for (int ai = 0; ai < 2; ++ai)
#pragma unroll
            for (int m = 0; m < 4; ++m) { float h[8];
#pragma unroll
                for (int n = 0; n < 2; ++n)
#pragma unroll
                    for (int j = 0; j < 4; ++j) { const float g = acc[ai][0][m][n][j], up = acc[ai][1][m][n][j]; h[n * 4 + j] = g * sigmoidf_(g) * up; }
                u32x4 w; w.x = pk2(h[0], h[1]); w.y = pk2(h[2], h[3]); w.z = pk2(h[4], h[5]); w.w = pk2(h[6], h[7]);
                *(u32x4*)(hb + (size_t)(row0 + ai * HALF + m * 16) * 512 + col0) = w; }
    }
};
struct EpiMoeDown {
    static constexpr bool PERM = true;
    bf16_t* ys;
    __device__ __forceinline__ void operator()(const f32x4 (&acc)[2][2][4][2], const Unit& u, int wr, int wc, int fr, int fq) const {
        const int row0 = u.pm * BM + wr * 64 + fr, col0 = (u.pn & 3) * BM + wc * 32 + 8 * fq;
#pragma unroll
        for (int ai = 0; ai < 2; ++ai)
#pragma unroll
            for (int m = 0; m < 4; ++m) { bf16_t* rowp = ys + (size_t)(row0 + ai * HALF + m * 16) * D + col0;
#pragma unroll
                for (int bj = 0; bj < 2; ++bj) { const f32x4 v0 = acc[ai][bj][m][0], v1 = acc[ai][bj][m][1];
                    u32x4 w; w.x = pk2(v0[0], v0[1]); w.y = pk2(v0[2], v0[3]); w.z = pk2(v1[0], v1[1]); w.w = pk2(v1[2], v1[3]);
                    *(u32x4*)(rowp + bj * HALF) = w; } }
    }
};

template <class Epi, class Sched, class AMap>
__device__ __forceinline__ void gemm_direct(const bf16_t* __restrict__ A, const bf16_t* __restrict__ Bt, int K, const Sched& S, const Epi& E, const AMap& AM, int wave) {
    const int wid = wave, lane = lane_now(), tid = wid * 64 + lane, wr = wid >> 2, wc = wid & 3, fr = lane & 15, fq = lane >> 4;
    Unit u;
    for (int i = 0; S.next(i, u); ++i) {
        f32x4 acc[2][2][4][2];
#pragma unroll
        for (int a = 0; a < 2; ++a)
#pragma unroll
            for (int b = 0; b < 2; ++b)
#pragma unroll
                for (int m = 0; m < 4; ++m)
#pragma unroll
                    for (int n = 0; n < 2; ++n) acc[a][b][m][n] = (f32x4){0.f, 0.f, 0.f, 0.f};
        const bf16_t* ap[2][4]; const bf16_t* bp[2][2];
#pragma unroll
        for (int ai = 0; ai < 2; ++ai)
#pragma unroll
            for (int m = 0; m < 4; ++m) ap[ai][m] = A + (size_t)AM.row(u, ai * HALF + wr * 64 + m * 16 + fr) * K + 8 * fq;
#pragma unroll
        for (int bj = 0; bj < 2; ++bj)
#pragma unroll
            for (int n = 0; n < 2; ++n) { const int rho = 16 * n + fr, rr = Epi::PERM ? perm32(rho) : rho; bp[bj][n] = Bt + (size_t)(u.pn * BM + bj * HALF + wc * 32 + rr) * K + 8 * fq; }
        for (int k0 = 0; k0 < K; k0 += 32) {
            bf16x8 af[2][4], bfr[2][2];
#pragma unroll
            for (int ai = 0; ai < 2; ++ai)
#pragma unroll
                for (int m = 0; m < 4; ++m) af[ai][m] = *(const bf16x8*)(ap[ai][m] + k0);
#pragma unroll
            for (int bj = 0; bj < 2; ++bj)
#pragma unroll
                for (int n = 0; n < 2; ++n) bfr[bj][n] = *(const bf16x8*)(bp[bj][n] + k0);
#pragma unroll
            for (int ai = 0; ai < 2; ++ai)
#pragma unroll
                for (int bj = 0; bj < 2; ++bj)
#pragma unroll
                    for (int m = 0; m < 4; ++m)
#pragma unroll
                        for (int n = 0; n < 2; ++n) acc[ai][bj][m][n] = __builtin_amdgcn_mfma_f32_16x16x32_bf16(bfr[bj][n], af[ai][m], acc[ai][bj][m][n], 0, 0, 0);
        }
        E(acc, u, wr, wc, fr, fq);
    }
}

constexpr int BK = 64, HTB = HALF * BK * 2;
__device__ __forceinline__ int lds_byte(int r, int c) { const int st = (r >> 4) * 2 + (c >> 5), rr = r & 15, cc = c & 31, ob = rr * 64 + cc * 2; return st * 1024 + (ob ^ (((ob >> 9) & 1) << 5)); }
__device__ __forceinline__ void stage_rc(int b, int& R, int& C) { const int st = b / 1024, sb = b % 1024, swz = sb ^ (((sb >> 9) & 1) << 5); R = (st >> 1) * 16 + swz / 64; C = (st & 1) * 32 + (swz % 64) / 2; }
template <class Epi, class Sched, class AMap, bool ALIGN_EPI>
__device__ __forceinline__ void gemm_phase(LAS unsigned char* lds, const bf16_t* A, const bf16_t* Bt, const int K, const Sched& S, const Epi& E, const AMap& AM, int wave) {
    const int wid = wave, lane = lane_now(), tid = wid * 64 + lane, wr = wid >> 2, wc = wid & 3, fr = lane & 15, fq = lane >> 4;
    const int nt = K / BK;
    int RA[2], CA[2]; unsigned voffB[2];
#pragma unroll
    for (int i = 0; i < 2; ++i) { int R, C; stage_rc(tid * 16 + i * 8192, R, C); const int Rb = Epi::PERM ? ((R & ~31) + perm32(R & 31)) : R; RA[i] = R; CA[i] = C; voffB[i] = (unsigned)(Rb * K + C) * 2u; }
    const size_t kstep = (size_t)(BK * 2);
    const size_t hstep = (size_t)HALF * K * 2;
    const size_t tstep = 2 * hstep;
    const unsigned ldsw = (unsigned)wid * 1024u;
    const int aoff = lds_byte(wr * 64 + fr, fq * 8), boff = lds_byte(wc * 32 + fr, fq * 8);
#define PG8_SA(b, h) (((b) * 2 + (h)) * HTB)
#define PG8_SB(b, h) ((4 + (b) * 2 + (h)) * HTB)
#define PG8_STAGE(bufoff, gbase, voff) do { _Pragma("unroll") for (int _i = 0; _i < 2; ++_i) \
        __builtin_amdgcn_global_load_lds((const unsigned*)((const char*)(gbase) + (voff)[_i]), (LAS unsigned*)(lds + (bufoff) + ldsw + _i * 8192), 16, 0, 0); } while (0)
#define PG8_LDA(dst, b, h) do { _Pragma("unroll") for (int m = 0; m < 4; ++m) _Pragma("unroll") for (int k = 0; k < 2; ++k) dst[m][k] = *(const LAS bf16x8*)(lds + PG8_SA(b, h) + aoff + m * 2048 + k * 1024); } while (0)
#define PG8_LDB(dst, b, h) do { _Pragma("unroll") for (int n = 0; n < 2; ++n) _Pragma("unroll") for (int k = 0; k < 2; ++k) dst[n][k] = *(const LAS bf16x8*)(lds + PG8_SB(b, h) + boff + n * 2048 + k * 1024); } while (0)
#define PG8_MMA(ai, bj, At, Bt_) do { __builtin_amdgcn_s_setprio(1); _Pragma("unroll") for (int m = 0; m < 4; ++m) _Pragma("unroll") for (int n = 0; n < 2; ++n) _Pragma("unroll") for (int k = 0; k < 2; ++k) \
        acc[ai][bj][m][n] = __builtin_amdgcn_mfma_f32_16x16x32_bf16(Bt_[n][k], At[m][k], acc[ai][bj][m][n], 0, 0, 0); __builtin_amdgcn_s_setprio(0); } while (0)
#define PG8_WAIT_V(n) asm volatile("s_waitcnt vmcnt(" #n ")" ::: "memory")
#define PG8_WAIT_L(n) asm volatile("s_waitcnt lgkmcnt(" #n ")" ::: "memory")
#define PG8_BAR __builtin_amdgcn_s_barrier()
#define PG8_SCHED __builtin_amdgcn_sched_barrier(0)
#define PG8_OFFS(dst, u) do { _Pragma("unroll") for (int h = 0; h < 2; ++h) _Pragma("unroll") for (int i = 0; i < 2; ++i) dst[h][i] = (unsigned)(((size_t)AM.row(u, h * HALF + RA[i]) * K + CA[i]) * 2); } while (0)
    Unit cur, nxt; int ui = 0;
    if (!S.next(0, cur)) return;
    f32x4 acc[2][2][4][2];
#pragma unroll
    for (int a = 0; a < 2; ++a)
#pragma unroll
        for (int b = 0; b < 2; ++b)
#pragma unroll
            for (int m = 0; m < 4; ++m)
#pragma unroll
                for (int n = 0; n < 2; ++n) acc[a][b][m][n] = (f32x4){0.f, 0.f, 0.f, 0.f};
    bf16x8 At[4][2], B0[2][2], B1[2][2];
    unsigned oc[2][2], on[2][2];
    PG8_OFFS(oc, cur);
    const char* const Ab = (const char*)A;
    const char* cB = (const char*)Bt + (size_t)cur.pn * tstep;
    PG8_STAGE(PG8_SB(0, 0), cB, voffB); PG8_STAGE(PG8_SB(0, 1), cB + hstep, voffB); PG8_STAGE(PG8_SA(0, 0), Ab, oc[0]); PG8_STAGE(PG8_SA(0, 1), Ab, oc[1]);
    if (wr == 1) PG8_BAR;
    PG8_WAIT_V(2); PG8_BAR;
    PG8_STAGE(PG8_SB(1, 0), cB + kstep, voffB); PG8_STAGE(PG8_SA(1, 0), Ab + kstep, oc[0]); PG8_STAGE(PG8_SB(1, 1), cB + hstep + kstep, voffB);
    PG8_WAIT_V(6); PG8_BAR;
    for (;;) {
        const bool has_next = S.next(ui + 1, nxt);
        const char* nB = cB;
        if (has_next) { PG8_OFFS(on, nxt); nB = (const char*)Bt + (size_t)nxt.pn * tstep; }
        else {
#pragma unroll
            for (int h = 0; h < 2; ++h)
#pragma unroll
                for (int i = 0; i < 2; ++i) on[h][i] = oc[h][i]; }
        for (int t = 0; t < nt; t += 2) {
            const bool last = (t == nt - 2);
            const char* a1 = Ab + (size_t)(t + 1) * kstep;
            const char* a2 = last ? Ab : Ab + (size_t)(t + 2) * kstep; const char* b2 = last ? nB : cB + (size_t)(t + 2) * kstep;
            const char* a3 = a2 + kstep; const char* b3 = b2 + kstep;
            unsigned o2[2][2];
#pragma unroll
            for (int h = 0; h < 2; ++h)
#pragma unroll
                for (int i = 0; i < 2; ++i) o2[h][i] = last ? on[h][i] : oc[h][i];
            PG8_LDB(B0, 0, 0); PG8_LDB(B1, 0, 1); PG8_SCHED; PG8_LDA(At, 0, 0); PG8_STAGE(PG8_SA(1, 1), a1, oc[1]);
            PG8_WAIT_V(8); PG8_WAIT_L(0); PG8_BAR; PG8_MMA(0, 0, At, B0); PG8_MMA(0, 1, At, B1); PG8_BAR; PG8_SCHED;
            PG8_LDA(At, 0, 1); PG8_STAGE(PG8_SB(0, 0), b2, voffB); PG8_STAGE(PG8_SB(0, 1), b2 + hstep, voffB); PG8_STAGE(PG8_SA(0, 0), a2, o2[0]);
            PG8_WAIT_V(8); PG8_WAIT_L(0); PG8_BAR; PG8_MMA(1, 0, At, B0); PG8_MMA(1, 1, At, B1); PG8_BAR; PG8_SCHED;
            PG8_LDB(B0, 1, 0); PG8_LDB(B1, 1, 1); PG8_SCHED; PG8_LDA(At, 1, 0); PG8_STAGE(PG8_SA(0, 1), a2, o2[1]);
            PG8_WAIT_V(8); PG8_WAIT_L(0); PG8_BAR; PG8_MMA(0, 0, At, B0); PG8_MMA(0, 1, At, B1); PG8_BAR; PG8_SCHED;
            PG8_LDA(At, 1, 1); PG8_STAGE(PG8_SB(1, 0), b3, voffB); PG8_STAGE(PG8_SB(1, 1), b3 + hstep, voffB); PG8_STAGE(PG8_SA(1, 0), a3, o2[0]);
            PG8_WAIT_V(8); PG8_WAIT_L(0); PG8_BAR; PG8_MMA(1, 0, At, B0); PG8_MMA(1, 1, At, B1); PG8_BAR; PG8_SCHED;
        }
        if constexpr (ALIGN_EPI) { if (wr == 0) PG8_BAR; }
        E(acc, cur, wr, wc, fr, fq);
        if (!has_next) break;
#pragma unroll
        for (int a = 0; a < 2; ++a)
#pragma unroll
            for (int b = 0; b < 2; ++b)
#pragma unroll
                for (int m = 0; m < 4; ++m)
#pragma unroll
                    for (int n = 0; n < 2; ++n) acc[a][b][m][n] = (f32x4){0.f, 0.f, 0.f, 0.f};
        cur = nxt; cB = nB; ++ui;
#pragma unroll
        for (int h = 0; h < 2; ++h)
#pragma unroll
            for (int i = 0; i < 2; ++i) oc[h][i] = on[h][i];
        if constexpr (ALIGN_EPI) { if (wr == 1) PG8_BAR; }
    }
    PG8_WAIT_V(0);
    if constexpr (!ALIGN_EPI) { if (wr == 0) PG8_BAR; }
    PG8_BAR;
#undef PG8_SA
#undef PG8_SB
#undef PG8_STAGE
#undef PG8_LDA
#undef PG8_LDB
#undef PG8_MMA
#undef PG8_WAIT_V
#undef PG8_WAIT_L
#undef PG8_BAR
#undef PG8_SCHED
#undef PG8_OFFS
}

__device__ __forceinline__ void tr_item(const float* __restrict__ W, int ldw, int k0, const float* __restrict__ gain, float scale, bf16_t* dst  , int Kd, LAS float* scr, int lane) {
#pragma unroll 8
    for (int i = 0; i < 32; ++i) { const int kk = 2 * i + (lane >> 5); float v = W[(size_t)(k0 + kk) * ldw + (lane & 31)]; const float g = gain ? gain[k0 + kk] : 1.f; scr[kk * 33 + (lane & 31)] = v * g * scale; }
    asm volatile("s_waitcnt lgkmcnt(0)" ::: "memory");
    const int c = lane & 7;
#pragma unroll
    for (int j = 0; j < 4; ++j) { const int n = (lane >> 3) + 8 * j; const LAS float* s = scr + (8 * c) * 33 + n;
        u32x4 o; o.x = pk2(s[0 * 33], s[1 * 33]); o.y = pk2(s[2 * 33], s[3 * 33]); o.z = pk2(s[4 * 33], s[5 * 33]); o.w = pk2(s[6 * 33], s[7 * 33]);
        *(u32x4*)(dst + (size_t)n * Kd + k0 + 8 * c) = o; }
    asm volatile("s_waitcnt lgkmcnt(0)" ::: "memory");
}
__device__ __forceinline__ void p0_weights(const Args& a, LAS unsigned char* lds, int gw, int NGW, int lane, int wave) {
    LAS float* scr = (LAS float*)(lds + wave * 16384);
    unsigned char* ws = a.ws;
    bf16_t* WIN = (bf16_t*)(ws + WS_WIN); bf16_t* WOUT = (bf16_t*)(ws + WS_WOUT); bf16_t* WKVQ = (bf16_t*)(ws + WS_WKVQ); bf16_t* WFO = (bf16_t*)(ws + WS_WFO);
    bf16_t* WEUP = (bf16_t*)(ws + WS_WEUP); bf16_t* WEDN = (bf16_t*)(ws + WS_WEDN);
    constexpr int I_IN = 16 * 96, I_OUT = 16 * 32, I_KV = 16 * 64, I_FQ = 16 * 32, I_FOG = 16 * 32, I_FO = 16 * 32;
    constexpr int I_SMALL = I_IN + I_OUT + I_KV + I_FQ + I_FOG + I_FO;
    constexpr int I_EG = 16 * 16, I_ED = 8 * 32;
    constexpr int I_EXP = 2 * I_EG + I_ED;
    constexpr int NITEMS = I_SMALL + 2 * NEXP * I_EXP;
    for (int it = gw; it < NITEMS; it += NGW) {
        int r = it;
        if (r < I_IN) { const int kb = r / 96, nb = r % 96; const int n0 = nb * 32; tr_item(a.in[2] + n0, 3088, kb * 64, a.in[1], n0 < 512 ? GLA_QSCALE : 1.f, WIN + (size_t)n0 * 1024, 1024, scr, lane); continue; } r -= I_IN;
        if (r < I_OUT) { const int kb = r / 32, n0 = (r % 32) * 32; tr_item(a.in[6] + n0, 1024, kb * 64, a.in[5], 1.f, WOUT + (size_t)n0 * 1024, 1024, scr, lane); continue; } r -= I_OUT;
        if (r < I_KV) { const int kb = r / 64, n0 = (r % 64) * 32; tr_item(a.in[8] + n0, 2064, kb * 64, a.in[7], 1.f, WKVQ + (size_t)n0 * 1024, 1024, scr, lane); continue; } r -= I_KV;
        if (r < I_FQ) { const int kb = r / 32, n0 = (r % 32) * 32; tr_item(a.in[11] + n0, 2048, kb * 64, a.in[10], ATT_C2, WKVQ + (size_t)(2048 + n0) * 1024, 1024, scr, lane); continue; } r -= I_FQ;
        if (r < I_FOG) { const int kb = r / 32, n0 = (r % 32) * 32; tr_item(a.in[11] + 1024 + n0, 2048, kb * 64, a.in[10], 1.f, WKVQ + (size_t)(3072 + n0) * 1024, 1024, scr, lane); continue; } r -= I_FOG;
        if (r < I_FO) { const int kb = r / 32, n0 = (r % 32) * 32; tr_item(a.in[12] + n0, 1024, kb * 64, nullptr, 1.f, WFO + (size_t)n0 * 1024, 1024, scr, lane); continue; } r -= I_FO;
        const int le = r / I_EXP, l = le / NEXP; int q = r % I_EXP;
        const float* gain = a.in[13] + l * 1024;
        if (q < 2 * I_EG) { const int up = q >= I_EG; if (up) q -= I_EG; const int kb = q / 16, n0 = (q % 16) * 32;
            const float* W = (up ? a.in[19] : a.in[18]) + (size_t)le * 1024 * 512 + n0;
            bf16_t* dst = WEUP + ((size_t)le * 1024 + (n0 >> 7) * 256 + up * 128 + (n0 & 127)) * 1024;
            tr_item(W, 512, kb * 64, gain, 1.f, dst, 1024, scr, lane); continue; }
        q -= 2 * I_EG;
        { const int kb = q / 32, n0 = (q % 32) * 32; tr_item(a.in[20] + (size_t)le * 512 * 1024 + n0, 1024, kb * 64, nullptr, 1.f, WEDN + ((size_t)le * 1024 + n0) * 512, 512, scr, lane); }
    }
    float* SK = (float*)(ws + WS_SKINNY);
    const int gt = gw * 64 + lane, NGT = NGW * 64;
    for (int i = gt; i < (16 + 36 + 36 + 16) * 1024; i += NGT) {
        const int n = i >> 10, k = i & 1023; float v;
        if (n < 16) v = a.in[1][k] * a.in[2][(size_t)k * 3088 + 3072 + n];
        else if (n < 52) { const int m = n - 16; v = a.in[13][k] * (m < 4 ? a.in[14][k * 4 + m] : a.in[16][k * 32 + (m - 4)]); }
        else if (n < 88) { const int m = n - 52; v = a.in[13][1024 + k] * (m < 4 ? a.in[14][4096 + k * 4 + m] : a.in[16][32768 + k * 32 + (m - 4)]); }
        else { const int m = n - 88; v = a.in[7][k] * a.in[8][(size_t)k * 2064 + 2048 + m]; }
        SK[i] = v;
    }
    if (blockIdx.x == 0 && wave == 0) ((int*)(ws + WS_CTL))[lane] = 0;
}

struct RowRegs { f32x4 v[4]; };
__device__ __forceinline__ RowRegs row_load(const float* p, int lane) { RowRegs r; const f32x4* q = (const f32x4*)p + lane;
#pragma unroll
    for (int j = 0; j < 4; ++j) r.v[j] = q[64 * j];
    return r; }
__device__ __forceinline__ float row_rs(const RowRegs& r) { float s = 0.f;
#pragma unroll
    for (int j = 0; j < 4; ++j) s += (r.v[j][0] * r.v[j][0] + r.v[j][1] * r.v[j][1]) + (r.v[j][2] * r.v[j][2] + r.v[j][3] * r.v[j][3]);
    return 1.0f / sqrtf(wave_sum(s) * (1.0f / 1024.0f) + RMS_EPS); }
__device__ __forceinline__ void row_store_bf16(bf16_t* p, const RowRegs& r, float rs, int lane) { u32x2* o = (u32x2*)p + lane;
#pragma unroll
    for (int j = 0; j < 4; ++j) { u32x2 w; w.x = pk2(r.v[j][0] * rs, r.v[j][1] * rs); w.y = pk2(r.v[j][2] * rs, r.v[j][3] * rs); o[64 * j] = w; } }
__device__ __forceinline__ float row_dot(const RowRegs& r, const float* w, int lane) { const f32x4* q = (const f32x4*)w + lane; float s = 0.f;
#pragma unroll
    for (int j = 0; j < 4; ++j) { const f32x4 x = q[64 * j]; s += (r.v[j][0] * x[0] + r.v[j][1] * x[1]) + (r.v[j][2] * x[2] + r.v[j][3] * x[3]); }
    return wave_sum(s); }
__device__ __forceinline__ void row_add_bf16(RowRegs& r, const bf16_t* p, float g, int lane) { const u32x2* q = (const u32x2*)p + lane;
#pragma unroll
    for (int j = 0; j < 4; ++j) { const u32x2 w = q[64 * j]; r.v[j][0] += g * bflo(w.x); r.v[j][1] += g * bfhi(w.x); r.v[j][2] += g * bflo(w.y); r.v[j][3] += g * bfhi(w.y); } }

__device__ __forceinline__ void p1_rows(const Args& a, int gw, int NGW, int lane) {
    bf16_t* XN = (bf16_t*)(a.ws + AB_XN); float* AA = (float*)(a.ws + AB_AA); const float* WA = (const float*)(a.ws + WS_SKINNY) + SK_WA;
    for (int t = gw; t < T; t += NGW) {
        const RowRegs r = row_load(a.in[0] + (size_t)t * D, lane); const float rs = row_rs(r);
        row_store_bf16(XN + (size_t)t * D, r, rs, lane);
        float mine = 0.f;
#pragma unroll
        for (int n = 0; n < 16; ++n) { const float d = row_dot(r, WA + n * 1024, lane) * rs; if (lane == n) mine = d; }
        if (lane < 16) AA[(size_t)t * 16 + lane] = mine;
    }
}

__device__ __forceinline__ void combine_row(RowRegs& r, const unsigned char* ws, const MoeTab& tab, int t, int lane) {
    const i32x4 ti = ((const i32x4*)(ws + AB_TOKI))[t]; const f32x2 tg = ((const f32x2*)(ws + AB_TOKG))[t];
    const bf16_t* YS = (const bf16_t*)(ws + AB_YS);
    const int p0 = tab.tstart[ti.x] * BM + ti.z, p1 = tab.tstart[ti.y] * BM + ti.w;
    row_add_bf16(r, YS + (size_t)p0 * D, tg.x, lane); row_add_bf16(r, YS + (size_t)p1 * D, tg.y, lane);
}
__device__ __forceinline__ void p10_rows(const Args& a, LAS unsigned char* lds, int layer, int gw, int NGW, int lane, int wave) {
    const MoeTab tab = moe_tab(lds); moe_tab_build(tab, (const int*)(a.ws + WS_CTL) + layer * 32, wave);
    bf16_t* XN = (bf16_t*)(a.ws + AB_XN); float* LF = (float*)(a.ws + AB_LF); const float* WF = (const float*)(a.ws + WS_SKINNY) + SK_WF;
    for (int t = gw; t < T; t += NGW) {
        RowRegs r = row_load(a.out + (size_t)t * D, lane); combine_row(r, a.ws, tab, t, lane);
        f32x4* o = (f32x4*)(a.out + (size_t)t * D) + lane;
#pragma unroll
        for (int j = 0; j < 4; ++j) o[64 * j] = r.v[j];
        const float rs = row_rs(r); row_store_bf16(XN + (size_t)t * D, r, rs, lane);
        float mine = 0.f;
#pragma unroll
        for (int n = 0; n < 16; ++n) { const float d = row_dot(r, WF + n * 1024, lane) * rs; if (lane == n) mine = d; }
        if (lane < 16) LF[(size_t)t * 16 + lane] = log_sigmoid(mine + a.in[9][lane]);
    }
}
__device__ __forceinline__ void p17_rows(const Args& a, LAS unsigned char* lds, int layer, int gw, int NGW, int lane, int wave) {
    const MoeTab tab = moe_tab(lds); moe_tab_build(tab, (const int*)(a.ws + WS_CTL) + layer * 32, wave);
    const f32x4* fn = (const f32x4*)a.in[21] + lane;
    for (int t = gw; t < T; t += NGW) {
        RowRegs r = row_load(a.out + (size_t)t * D, lane); combine_row(r, a.ws, tab, t, lane);
        const float rs = row_rs(r);
        f32x4* o = (f32x4*)(a.out + (size_t)t * D) + lane;
#pragma unroll
        for (int j = 0; j < 4; ++j) o[64 * j] = r.v[j] * rs * fn[64 * j];
    }
}

__device__ __forceinline__ void route_phase(const Args& a, LAS unsigned char* lds, int layer, int lane, int wave) {
    bf16_t* XN = (bf16_t*)(a.ws + AB_XN); const float* WR = (const float*)(a.ws + WS_SKINNY) + (layer ? SK_WR1 : SK_WR0);
    int* gcnt = (int*)(a.ws + WS_CTL) + layer * 32; int* LIST = (int*)(a.ws + AB_LIST); i32x4* TOKI = (i32x4*)(a.ws + AB_TOKI); f32x2* TOKG = (f32x2*)(a.ws + AB_TOKG);
    const float* bc = a.in[15] + layer * 4; const float* bfine = a.in[17] + layer * 32;
    LAS int* be = (LAS int*)(lds);
    LAS int* rk = be + 256;
    LAS int* lcnt = rk + 256;
    LAS int* lbase = lcnt + 32;
    LAS float* bg = (LAS float*)(lbase + 32);
    const int tidx = wave * 64 + lane;
    for (int batch = blockIdx.x; batch < T / 128; batch += gridDim.x) {
        if (tidx < 32) lcnt[tidx] = 0;
        for (int i = 0; i < 16; ++i) {
            const int lr = wave * 16 + i, t = batch * 128 + lr;
            const RowRegs r = row_load(a.out + (size_t)t * D, lane); const float rs = row_rs(r);
            row_store_bf16(XN + (size_t)t * D, r, rs, lane);
            float mine = 0.f;
#pragma unroll 2
            for (int n = 0; n < 36; ++n) { const float d = row_dot(r, WR + n * 1024, lane) * rs; if (lane == n) mine = d; }
            const float c0 = __shfl(mine, 0) + bc[0], c1 = __shfl(mine, 1) + bc[1], c2 = __shfl(mine, 2) + bc[2], c3 = __shfl(mine, 3) + bc[3];
            int gi = 0; float cm = c0; if (c1 > cm) { cm = c1; gi = 1; } if (c2 > cm) { cm = c2; gi = 2; } if (c3 > cm) { cm = c3; gi = 3; }
            const float pc = 1.f / (__expf(c0 - cm) + __expf(c1 - cm) + __expf(c2 - cm) + __expf(c3 - cm));
            float f[8];
#pragma unroll
            for (int j = 0; j < 8; ++j) f[j] = __shfl(mine, 4 + gi * 8 + j) + bfine[gi * 8 + j];
            int j0 = 0; float m0 = f[0];
#pragma unroll
            for (int j = 1; j < 8; ++j) if (f[j] > m0) { m0 = f[j]; j0 = j; }
            int j1 = -1; float m1 = -INFINITY;
#pragma unroll
            for (int j = 0; j < 8; ++j) if (j != j0 && f[j] > m1) { m1 = f[j]; j1 = j; }
            const float e1 = __expf(m1 - m0), inv = 1.f / (1.f + e1);
            if (lane == 0) { be[lr * 2] = gi * 8 + j0; be[lr * 2 + 1] = gi * 8 + j1; bg[lr * 2] = pc * inv; bg[lr * 2 + 1] = pc * e1 * inv; }
        }
        __syncthreads();
        if (tidx < 256) rk[tidx] = atomicAdd((int*)&lcnt[be[tidx]], 1);
        __syncthreads();
        if (tidx < 32) lbase[tidx] = lcnt[tidx] ? atomicAdd(&gcnt[tidx], lcnt[tidx]) : 0;
        __syncthreads();
        if (tidx < 256) { const int e = be[tidx], idx = lbase[e] + rk[tidx]; LIST[e * T + idx] = batch * 128 + (tidx >> 1); rk[tidx] = idx; }
        __syncthreads();
        if (tidx < 128) { const int lr = tidx; TOKI[batch * 128 + lr] = (i32x4){be[lr * 2], be[lr * 2 + 1], rk[lr * 2], rk[lr * 2 + 1]}; TOKG[batch * 128 + lr] = (f32x2){bg[lr * 2], bg[lr * 2 + 1]}; }
        __syncthreads();
    }
}

__device__ __forceinline__ void gla_alpha_naive(const Args& a, int wave) {
    const float* AA = (const float*)(a.ws + AB_AA); float* AL = (float*)(a.ws + AB_ALPHA); const float* w2 = a.in[3]; const float* ba = a.in[4];
    for (size_t i = (size_t)blockIdx.x * NTHREADS + TIDX; i < (size_t)T * 512; i += (size_t)gridDim.x * NTHREADS) {
        const int t = (int)(i >> 9), hd = (int)(i & 511); float z = ba[hd];
#pragma unroll
        for (int r = 0; r < 16; ++r) z += AA[(size_t)t * 16 + r] * w2[r * 512 + hd];
        AL[i] = __expf(log_sigmoid(z) * (1.f / 16.f));
    }
}
__device__ __forceinline__ void gla_scan_naive(const Args& a, int gw, int NGW, int lane) {
    const bf16_t* __restrict__ Q = (const bf16_t*)(a.ws + AB_Q); const bf16_t* __restrict__ K = (const bf16_t*)(a.ws + AB_K); bf16_t* V = (bf16_t*)(a.ws + AB_V);
    const float* __restrict__ AL = (const float*)(a.ws + AB_ALPHA); float* SSQ = (float*)(a.ws + AB_SSQ);
    for (int item = gw; item < 256; item += NGW) {
        const int b = item >> 4, h = (item >> 2) & 3, sl = item & 3, e = h * 256 + sl * 64 + lane;
        float St[128];
#pragma unroll
        for (int d = 0; d < 128; ++d) St[d] = 0.f;
        for (int t = 0; t < SEQ; ++t) {
            const size_t row = (size_t)b * SEQ + t;
            const float v = bf2f(V[row * D + e]);
            const u32x4* qp = (const u32x4*)(Q + row * 512 + h * 128); const u32x4* kp = (const u32x4*)(K + row * 512 + h * 128); const f32x4* ap = (const f32x4*)(AL + row * 512 + h * 128);
            float o = 0.f;
#pragma unroll
            for (int c = 0; c < 16; ++c) { const u32x4 qw = qp[c], kw = kp[c]; const f32x4 a0 = ap[2 * c], a1 = ap[2 * c + 1];
                const float qf[8] = {bflo(qw.x), bfhi(qw.x), bflo(qw.y), bfhi(qw.y), bflo(qw.z), bfhi(qw.z), bflo(qw.w), bfhi(qw.w)};
                const float kf[8] = {bflo(kw.x), bfhi(kw.x), bflo(kw.y), bfhi(kw.y), bflo(kw.z), bfhi(kw.z), bflo(kw.w), bfhi(kw.w)};
                const float af[8] = {a0[0], a0[1], a0[2], a0[3], a1[0], a1[1], a1[2], a1[3]};
#pragma unroll
                for (int j = 0; j < 8; ++j) { const int d = c * 8 + j; St[d] = af[j] * St[d] + kf[j] * v; o += qf[j] * St[d]; } }
            V[row * D + e] = (bf16_t)f2bf(o);
            const float ss = wave_sum(o * o);
            if (lane == 0) SSQ[row * 16 + h * 4 + sl] = ss;
        }
    }
}
__device__ __forceinline__ void gla_post(const Args& a, int wave) {
    bf16_t* V = (bf16_t*)(a.ws + AB_V); const bf16_t* R = (const bf16_t*)(a.ws + AB_R); const float* SSQ = (const float*)(a.ws + AB_SSQ);
    for (size_t i = (size_t)blockIdx.x * NTHREADS + TIDX; i < (size_t)T * 128; i += (size_t)gridDim.x * NTHREADS) {
        const size_t t = i >> 7; const int c8 = (int)(i & 127) * 8, h = c8 >> 8;
        const f32x4 sq = *(const f32x4*)(SSQ + t * 16 + h * 4);
        const float rstd = 1.0f / sqrtf(((sq[0] + sq[1]) + (sq[2] + sq[3])) * (1.f / 256.f) + RMS_EPS);
        const u32x4 ow = *(const u32x4*)(V + t * D + c8), rw = *(const u32x4*)(R + t * D + c8);
        const unsigned oo[4] = {ow.x, ow.y, ow.z, ow.w}, rr[4] = {rw.x, rw.y, rw.z, rw.w}; unsigned res[4];
#pragma unroll
        for (int j = 0; j < 4; ++j) { const float r0 = bflo(rr[j]), r1 = bfhi(rr[j]); res[j] = pk2(bflo(oo[j]) * rstd * r0 * sigmoidf_(r0), bfhi(oo[j]) * rstd * r1 * sigmoidf_(r1)); }
        *(u32x4*)(V + t * D + c8) = (u32x4){res[0], res[1], res[2], res[3]};
    }
}

__device__ __forceinline__ void fox_cumsum(const Args& a, int gw, int NGW, int lane) {
    const float* LF = (const float*)(a.ws + AB_LF); float* C = (float*)(a.ws + AB_C);
    for (int item = gw; item < 256; item += NGW) {
        const int b = item >> 4, h = item & 15; float loc[32]; float s = 0.f;
#pragma unroll
        for (int i = 0; i < 32; ++i) { s += LF[((size_t)b * SEQ + lane * 32 + i) * 16 + h]; loc[i] = s; }
        float incl = s;
#pragma unroll
        for (int o = 1; o < 64; o <<= 1) { const float n = __shfl_up(incl, o); if (lane >= o) incl += n; }
        const float excl = incl - s;
#pragma unroll
        for (int i = 0; i < 32; ++i) C[(size_t)item * SEQ + lane * 32 + i] = loc[i] + excl;
    }
}
__device__ __forceinline__ void fox_attn_naive(const Args& a, int gw, int NGW, int lane) {
    bf16_t* Q = (bf16_t*)(a.ws + AB_FQ); const bf16_t* __restrict__ K = (const bf16_t*)(a.ws + AB_FK); const bf16_t* __restrict__ V = (const bf16_t*)(a.ws + AB_FV);
    const bf16_t* __restrict__ OG = (const bf16_t*)(a.ws + AB_FOG); const float* __restrict__ C = (const float*)(a.ws + AB_C);
    for (int item = gw; item < 8192; item += NGW) {
        const int bh = item >> 5, tb = item & 31, b = bh >> 4, h = bh & 15, t = tb * 64 + lane;
        const size_t row = (size_t)b * SEQ + t;
        float q[64], o[64];
#pragma unroll
        for (int c = 0; c < 8; ++c) { const u32x4 w = *(const u32x4*)(Q + row * D + h * 64 + c * 8); q[c * 8 + 0] = bflo(w.x); q[c * 8 + 1] = bfhi(w.x); q[c * 8 + 2] = bflo(w.y); q[c * 8 + 3] = bfhi(w.y); q[c * 8 + 4] = bflo(w.z); q[c * 8 + 5] = bfhi(w.z); q[c * 8 + 6] = bflo(w.w); q[c * 8 + 7] = bfhi(w.w); }
#pragma unroll
        for (int d = 0; d < 64; ++d) o[d] = 0.f;
        float m = -INFINITY, l = 0.f; const float cref = C[(size_t)bh * SEQ + tb * 64 + 63];
        const int smax = tb * 64 + 63;
        for (int s = 0; s <= smax; ++s) {
            const size_t krow = (size_t)b * SEQ + s; float x = 0.f;
#pragma unroll
            for (int c = 0; c < 8; ++c) { const u32x4 w = *(const u32x4*)(K + krow * D + h * 64 + c * 8);
                x += q[c * 8 + 0] * bflo(w.x) + q[c * 8 + 1] * bfhi(w.x) + q[c * 8 + 2] * bflo(w.y) + q[c * 8 + 3] * bfhi(w.y) + q[c * 8 + 4] * bflo(w.z) + q[c * 8 + 5] * bfhi(w.z) + q[c * 8 + 6] * bflo(w.w) + q[c * 8 + 7] * bfhi(w.w); }
            x += (cref - C[(size_t)bh * SEQ + s]) * LOG2E;
            if (s > t) x = -INFINITY;
            const float mn = fmaxf(m, x); const float sc = (mn == -INFINITY) ? 1.f : exp2f(m - mn), p = (mn == -INFINITY) ? 0.f : exp2f(x - mn);
            m = mn; l = l * sc + p;
#pragma unroll
            for (int c = 0; c < 8; ++c) { const u32x4 w = *(const u32x4*)(V + krow * D + h * 64 + c * 8);
                const float vv[8] = {bflo(w.x), bfhi(w.x), bflo(w.y), bfhi(w.y), bflo(w.z), bfhi(w.z), bflo(w.w), bfhi(w.w)};
#pragma unroll
                for (int j = 0; j < 8; ++j) o[c * 8 + j] = o[c * 8 + j] * sc + p * vv[j]; }
        }
        const float il = 1.f / l;
#pragma unroll
        for (int c = 0; c < 8; ++c) { const u32x4 g = *(const u32x4*)(OG + row * D + h * 64 + c * 8); const unsigned gg[4] = {g.x, g.y, g.z, g.w}; unsigned res[4];
#pragma unroll
            for (int j = 0; j < 4; ++j) res[j] = pk2(o[c * 8 + 2 * j] * il * sigmoidf_(bflo(gg[j])), o[c * 8 + 2 * j + 1] * il * sigmoidf_(bfhi(gg[j])));
            *(u32x4*)(Q + row * D + h * 64 + c * 8) = (u32x4){res[0], res[1], res[2], res[3]}; }
    }
}

#include <hip/hip_bf16.h>
#include <cmath>
namespace attn_body {
using bf16=__hip_bfloat16;
using bf16x8=__attribute__((ext_vector_type(8)))short;
using s16x4=__attribute__((ext_vector_type(4)))short;
using f32x16=__attribute__((ext_vector_type(16)))float;
using u32x4=__attribute__((ext_vector_type(4)))unsigned;
constexpr int BATCH=16,NHEAD=16,SEQ=2048,D=64,DM=NHEAD*D;
constexpr int NW=8,QBLK=32,QB=QBLK*NW,KVBLK=64,NQB=SEQ/QB;
constexpr int ATTN_PITCH=DM, ATTN_UNIT_ROWS=QB;
__device__ __forceinline__ int crow(int r,int hi){return (r&3)+8*(r>>2)+4*hi;}
#define SBAR() __builtin_amdgcn_sched_barrier(0)
__device__ __forceinline__ void cmask(f32x16&p0,f32x16&p1,int jb,int qrel,int hi){
  const float NEG=-INFINITY; int kb=64*jb+4*hi;
  #pragma unroll
  for(int r=0;r<16;++r){int kv=kb+(r&3)+8*(r>>2); if(kv>qrel)p0[r]=NEG; if(kv+32>qrel)p1[r]=NEG;}
}

constexpr int NSLOT=3, SLOTB=8192;
constexpr int LDS_CL=90112;
typedef float f32x4a __attribute__((ext_vector_type(4)));
constexpr int LDS_K=0, LDS_V=NSLOT*SLOTB, LDS_WS=2*NSLOT*SLOTB, LDS_OST=LDS_WS+NW*64*4, LDS_BYTES=LDS_OST+NW*4096;
constexpr float C2=0.125f*1.4426950408889634f;
__device__ __forceinline__ void glds16(const void*sbase,unsigned voff,unsigned lds_dst){unsigned keep;
  asm volatile("s_mov_b32 %0, m0\n\ts_mov_b32 m0, %3\n\ts_nop 0\n\tglobal_load_lds_dwordx4 %1, %2\n\ts_mov_b32 m0, %0":"=&s"(keep):"v"(voff),"s"(sbase),"s"(lds_dst):"memory");}
__device__ __forceinline__ float max3f(float a,float b,float c){float r;asm("v_max3_f32 %0, %1, %2, %3":"=v"(r):"v"(a),"v"(b),"v"(c));return r;}
__device__ __forceinline__ float max2f(float a,float b){float r;asm("v_max_f32_e32 %0, %1, %2":"=v"(r):"v"(a),"v"(b));return r;}
__device__ __forceinline__ float fadd_s(float a,float b){float r;asm("v_add_f32_e32 %0, %1, %2":"=v"(r):"v"(a),"v"(b));return r;}
__device__ __forceinline__ float fsub_s(float a,float b){float r;asm("v_sub_f32_e32 %0, %1, %2":"=v"(r):"v"(a),"v"(b));return r;}
typedef float f32x2_t __attribute__((ext_vector_type(2))); typedef __bf16 bf16x2_t __attribute__((ext_vector_type(2)));
__device__ __forceinline__ unsigned cvtpk_s(float lo,float hi){f32x2_t v={lo,hi};bf16x2_t b=__builtin_convertvector(v,bf16x2_t);return __builtin_bit_cast(unsigned,b);}
#define WAIT_BAR(N) asm volatile("s_waitcnt vmcnt(" #N ") lgkmcnt(0)\n\ts_barrier":::"memory")

__device__ __forceinline__ void qkt(f32x16&p0,f32x16&p1,const char*Kslot,const bf16x8*qr,int r32,int hi){
  const char*kb=Kslot+hi*1024+r32*16;
  #pragma unroll
  for(int d0=0;d0<4;++d0){
    const bf16x8 b0=*reinterpret_cast<const bf16x8*>(kb+d0*2048);
    const bf16x8 b1=*reinterpret_cast<const bf16x8*>(kb+d0*2048+512);
    p0=__builtin_amdgcn_mfma_f32_32x32x16_bf16(b0,qr[d0],p0,0,0,0);p1=__builtin_amdgcn_mfma_f32_32x32x16_bf16(b1,qr[d0],p1,0,0,0);}
}
typedef __attribute__((address_space(3))) const char* lds_cptr;
typedef short v4i16_t __attribute__((ext_vector_type(4)));
__device__ __forceinline__ void kload8(bf16x8*kf,lds_cptr kp){
  kf[0]=*(const __attribute__((address_space(3))) bf16x8*)(kp);      kf[1]=*(const __attribute__((address_space(3))) bf16x8*)(kp+512);
  kf[2]=*(const __attribute__((address_space(3))) bf16x8*)(kp+2048); kf[3]=*(const __attribute__((address_space(3))) bf16x8*)(kp+2560);
  kf[4]=*(const __attribute__((address_space(3))) bf16x8*)(kp+4096); kf[5]=*(const __attribute__((address_space(3))) bf16x8*)(kp+4608);
  kf[6]=*(const __attribute__((address_space(3))) bf16x8*)(kp+6144); kf[7]=*(const __attribute__((address_space(3))) bf16x8*)(kp+6656);
}
__device__ __forceinline__ void kload2(bf16x8*kf,lds_cptr kp,int j){ kf[2*j]=*(const __attribute__((address_space(3))) bf16x8*)(kp+j*2048); kf[2*j+1]=*(const __attribute__((address_space(3))) bf16x8*)(kp+j*2048+512); }
__device__ __forceinline__ s16x4 vtr(lds_cptr p){ return __builtin_bit_cast(s16x4,__builtin_amdgcn_ds_read_tr16_b64_v4i16((__attribute__((address_space(3))) v4i16_t*)p)); }
__device__ __forceinline__ float rowmax(const f32x16&p0,const f32x16&p1){
  float a=max3f(p0[0],p0[1],p1[0]),b=max3f(p0[2],p0[3],p1[1]);a=max3f(a,p1[2],p1[3]);
  #pragma unroll
  for(int r=4;r<16;r+=4){a=max3f(a,p0[r],p0[r+1]);b=max3f(b,p0[r+2],p0[r+3]);a=max3f(a,p1[r],p1[r+1]);b=max3f(b,p1[r+2],p1[r+3]);}
  const float m=max2f(a,b);
  auto rr=__builtin_amdgcn_permlane32_swap(__float_as_uint(m),__float_as_uint(m),false,false);
  return max2f(__uint_as_float(rr[0]),__uint_as_float(rr[1]));
}
__device__ __forceinline__ void pv(f32x16*o,int vb,bf16x8 pa0,bf16x8 pa1,bf16x8 pa2,bf16x8 pa3){
  #pragma unroll
  for(int d0=0;d0<2;++d0){s16x4 lo[4],hi[4];
    #pragma unroll
    for(int ks=0;ks<4;++ks){
      asm volatile("ds_read_b64_tr_b16 %0,%1 offset:%c2":"=&v"(lo[ks]):"v"(vb),"i"(d0*4096+ks*1024):"memory");
      asm volatile("ds_read_b64_tr_b16 %0,%1 offset:%c2":"=&v"(hi[ks]):"v"(vb),"i"(d0*4096+ks*1024+512):"memory");}
    asm volatile("s_waitcnt lgkmcnt(0)":::"memory");SBAR();
    #define PK(k) (bf16x8){lo[k][0],lo[k][1],lo[k][2],lo[k][3],hi[k][0],hi[k][1],hi[k][2],hi[k][3]}
    o[d0]=__builtin_amdgcn_mfma_f32_32x32x16_bf16(pa0,PK(0),o[d0],0,0,0);
    o[d0]=__builtin_amdgcn_mfma_f32_32x32x16_bf16(pa1,PK(1),o[d0],0,0,0);
    o[d0]=__builtin_amdgcn_mfma_f32_32x32x16_bf16(pa2,PK(2),o[d0],0,0,0);
    o[d0]=__builtin_amdgcn_mfma_f32_32x32x16_bf16(pa3,PK(3),o[d0],0,0,0);
    #undef PK
  }
}

#ifndef ATTN_STORE16
#define ATTN_STORE16(p,v) (*(u32x4*)(p)=(v))
#endif
template<int THRL> __device__ __forceinline__ void attn_unit(int b,int h,int qb,const bf16*Q,const bf16*__restrict__ K,const bf16*__restrict__ V,const bf16*__restrict__ OG,bf16*O,char*shm,int wave){
  const int lane=lane_now(),r32=lane&31,hi=lane>>5; const int wid=wave;
  const long rowbase=(long)b*SEQ; const int q0=qb*QB;
  const bf16*Qw=Q+(rowbase+q0+wid*QBLK)*DM+h*D;
  const bf16*Kh=K+rowbase*DM+h*D,*Vh=V+rowbase*DM+h*D;
  const unsigned lds0=(unsigned)(uintptr_t)shm;
  float*wsf=(float*)(shm+LDS_WS)+wid*64;
  const unsigned koff=(unsigned)(lane*DM+wid*8)*2u;
  const unsigned voff=(unsigned)((16*(wid&3)+(lane>>2))*DM+(wid>>2)*32+(lane&3)*8)*2u;
  const unsigned kdst=lds0+LDS_K+wid*1024, vdst=lds0+LDS_V+wid*1024;
  #define DMA_K(t,slot) glds16(Kh+(long)(t)*KVBLK*DM,koff,(unsigned)__builtin_amdgcn_readfirstlane(kdst+(slot)))
  #define DMA_V(t,slot) glds16(Vh+(long)(t)*KVBLK*DM,voff,(unsigned)__builtin_amdgcn_readfirstlane(vdst+(slot)))
  const int vb0=(int)(lds0+LDS_V)+((lane>>4)&1)*32+(lane&3)*8+(4*hi+((lane&15)>>2))*64;
  const char*Kbase=shm+LDS_K; bf16x8 kf[8];
  const lds_cptr shm3=(lds_cptr)shm; const lds_cptr kp0=shm3+LDS_K+hi*1024+r32*16; const lds_cptr vp0=shm3+LDS_V+((lane>>4)&1)*32+(lane&3)*8+(4*hi+((lane&15)>>2))*64;
  const int NT=(q0+QB)/KVBLK;
  DMA_K(0,0);DMA_V(0,0);DMA_K(1,SLOTB);
  bf16x8 qr[4]; int rq_=r32; asm volatile("":"+v"(rq_));
  #pragma unroll
  for(int d0=0;d0<4;++d0)qr[d0]=*reinterpret_cast<const bf16x8*>(&Qw[(long)rq_*DM+d0*16+hi*8]);
  float mhat=0.f,l_reg=0.f;f32x16 o[2];o[0]=f32x16{};o[1]=f32x16{};
  #define BIASLD(P0,P1,tt) do{ const __attribute__((address_space(3))) f32x4a*c_=(const __attribute__((address_space(3))) f32x4a*)(shm3+LDS_CL+((tt)*64+4*hi)*4); \
    _Pragma("unroll") for(int g_=0;g_<4;++g_){ const f32x4a a_=c_[2*g_],b_=c_[2*g_+8]; _Pragma("unroll") for(int j_=0;j_<4;++j_){P0[4*g_+j_]=a_[j_];P1[4*g_+j_]=b_[j_];} } }while(0)
  const int qrel=wid*QBLK+r32;
  #define CMASK(P0,P1,t) do{int jb_=(t)-(NT-4); if(jb_>=0)cmask(P0,P1,jb_,qrel,hi);}while(0)
  bool resc=false;
  #define START(P0,P1) do{ const float rm=rowmax(P0,P1); resc=false; \
    { const float dl=rm; mhat=fadd_s(mhat,dl); \
      _Pragma("unroll") for(int r=0;r<16;++r){P0[r]=fsub_s(P0[r],dl);P1[r]=fsub_s(P1[r],dl);} } \
    _Pragma("unroll") for(int r=0;r<16;++r)P0[r]=__builtin_amdgcn_exp2f(P0[r]); }while(0)
  #define RESC() do{ if(resc){ asm volatile("s_waitcnt lgkmcnt(0)":::"memory"); \
      _Pragma("unroll") for(int d_=0;d_<2;++d_) _Pragma("unroll") for(int r=0;r<16;++r)o[d_][r]*=wsf[crow(r,hi)]; } }while(0)
  f32x16 pA0,pA1,pB0,pB1;
  int sl_prev=0,sl_cur=0,sl_next=SLOTB;
  #define ROT() do{sl_prev=sl_cur;sl_cur=sl_next;sl_next=(sl_next==(NSLOT-1)*SLOTB)?0:sl_next+SLOTB;}while(0)
  DMA_K(2,2*SLOTB);
  WAIT_BAR(3);
  BIASLD(pA0,pA1,0); _Pragma("unroll") for(int r=0;r<16;++r){pA0[r]=-pA0[r];pA1[r]=-pA1[r];}
  qkt(pA0,pA1,Kbase,qr,r32,hi);asm volatile("s_nop 15\n\ts_nop 7":"+v"(pA0),"+v"(pA1));CMASK(pA0,pA1,0);
  START(pA0,pA1);
  _Pragma("unroll") for(int r=0;r<16;++r)pA1[r]=__builtin_amdgcn_exp2f(pA1[r]);
  BIASLD(pB0,pB1,1);
  WAIT_BAR(0);
  DMA_K(3,0);DMA_V(1,SLOTB);
  ROT();
  kload8(kf,kp0+sl_cur);
  WAIT_BAR(2);
  s16x4 vlo[8],vhi[8]; u32x4 pw0,pw1,pw2,pw3;
  #define PKW(P,B) cvtpk_s(P[B],P[B+1])
  #define PAF(k) __builtin_bit_cast(bf16x8,pw##k)
  #define VFR(i) (bf16x8){vlo[i][0],vlo[i][1],vlo[i][2],vlo[i][3],vhi[i][0],vhi[i][1],vhi[i][2],vhi[i][3]}
  #define PIN(x) asm volatile("":"+v"(x))
  #define MX3(a,b,c) __builtin_fmaxf(__builtin_fmaxf((a),(b)),(c))
  #define GAPA(MF,A0,A1,A2,A3,W0,W1,PW) do{ MF; sacc+=A0; sacc+=A1; sacc+=A2; sacc+=A3; PIN(sacc); W0; W1; PIN(PW); SBAR(); }while(0)
  #define EX(v) __builtin_amdgcn_exp2f(v)
  #define GAPB(MF,X,B) do{ MF; X[B]=EX(X[B]); X[B+1]=EX(X[B+1]); X[B+2]=EX(X[B+2]); X[B+3]=EX(X[B+3]); PIN(X); SBAR(); }while(0)
  #define VRD(i) do{ vlo[i]=vtr(vp_+(((i)>>2)*4096+((i)&3)*1024)); vhi[i]=vtr(vp_+(((i)>>2)*4096+((i)&3)*1024+512)); }while(0)
  #define KRD(G,j) do{ if(G){ kload2(kf,kp0+sl_next,j); SBAR(); } }while(0)
  #define STEP(C0,C1,P0,P1,t,GK,GV,GL) do{ SBAR(); \
    { const float nm_=-mhat; _Pragma("unroll") for(int r=0;r<16;++r){C0[r]=nm_-C0[r];C1[r]=nm_-C1[r];} } \
    const lds_cptr vp_=vp0+sl_prev; \
    VRD(0); SBAR(); float sacc=(P0[0]+P0[1]); \
    GAPA(C0=__builtin_amdgcn_mfma_f32_32x32x16_bf16(kf[0],qr[0],C0,0,0,0), P0[2],P0[3],P0[4],P0[5],     pw0[0]=PKW(P0,0), pw0[1]=PKW(P0,2), pw0); \
    VRD(4); SBAR(); GAPA(C1=__builtin_amdgcn_mfma_f32_32x32x16_bf16(kf[1],qr[0],C1,0,0,0), P0[6],P0[7],P0[8],P0[9],     pw0[2]=PKW(P0,4), pw0[3]=PKW(P0,6), pw0); \
    VRD(1); SBAR(); GAPA(C0=__builtin_amdgcn_mfma_f32_32x32x16_bf16(kf[2],qr[1],C0,0,0,0),   P0[10],P0[11],P0[12],P0[13], pw1[0]=PKW(P0,8), pw1[1]=PKW(P0,10), pw1); \
    VRD(5); SBAR(); GAPA(C1=__builtin_amdgcn_mfma_f32_32x32x16_bf16(kf[3],qr[1],C1,0,0,0),   P0[14],P0[15],P1[0],P1[1],   pw1[2]=PKW(P0,12),pw1[3]=PKW(P0,14), pw1); \
    VRD(2); SBAR(); GAPA(C0=__builtin_amdgcn_mfma_f32_32x32x16_bf16(kf[4],qr[2],C0,0,0,0),   P1[2],P1[3],P1[4],P1[5],     pw2[0]=PKW(P1,0), pw2[1]=PKW(P1,2), pw2); \
    VRD(6); SBAR(); GAPA(C1=__builtin_amdgcn_mfma_f32_32x32x16_bf16(kf[5],qr[2],C1,0,0,0),   P1[6],P1[7],P1[8],P1[9],     pw2[2]=PKW(P1,4), pw2[3]=PKW(P1,6), pw2); \
    VRD(3); SBAR(); GAPA(C0=__builtin_amdgcn_mfma_f32_32x32x16_bf16(kf[6],qr[3],C0,0,0,0),   P1[10],P1[11],P1[12],P1[13], pw3[0]=PKW(P1,8), pw3[1]=PKW(P1,10), pw3); \
    VRD(7); SBAR(); GAPA(C1=__builtin_amdgcn_mfma_f32_32x32x16_bf16(kf[7],qr[3],C1,0,0,0),   P1[14],P1[15],0.f,0.f,       pw3[2]=PKW(P1,12),pw3[3]=PKW(P1,14), pw3); \
    l_reg+=sacc; \
    if(GK){DMA_K((t)+3,sl_cur);} if(GV){DMA_V((t)+1,sl_next);} \
    CMASK(C0,C1,t); \
    { float a=MX3(C0[0],C0[1],C1[0]),b=MX3(C0[2],C0[3],C1[1]); a=MX3(a,C1[2],C1[3]); \
      _Pragma("unroll") for(int r=4;r<16;r+=4){a=MX3(a,C0[r],C0[r+1]);b=MX3(b,C0[r+2],C0[r+3]);a=MX3(a,C1[r],C1[r+1]);b=MX3(b,C1[r+2],C1[r+3]);} \
      float rm=__builtin_fmaxf(a,b); { auto rr=__builtin_amdgcn_permlane32_swap(__float_as_uint(rm),__float_as_uint(rm),false,false); rm=__builtin_fmaxf(__uint_as_float(rr[0]),__uint_as_float(rr[1])); } \
      resc=false; \
      if(__builtin_expect(__any(rm>(float)THRL),0)){ const float dl=__builtin_fmaxf(rm,0.f); mhat+=dl; \
        _Pragma("unroll") for(int r=0;r<16;++r){C0[r]-=dl;C1[r]-=dl;} \
        const float f=__builtin_amdgcn_exp2f(-dl); l_reg*=f; if(hi==0)wsf[r32]=f; resc=true; } } \
    SBAR(); \
    GAPB(o[0]=__builtin_amdgcn_mfma_f32_32x32x16_bf16(PAF(0),VFR(0),o[0],0,0,0), C0,0); \
    GAPB(o[1]=__builtin_amdgcn_mfma_f32_32x32x16_bf16(PAF(0),VFR(4),o[1],0,0,0), C0,4); \
    KRD(GL,0); GAPB(o[0]=__builtin_amdgcn_mfma_f32_32x32x16_bf16(PAF(1),VFR(1),o[0],0,0,0), C0,8); \
    KRD(GL,1); GAPB(o[1]=__builtin_amdgcn_mfma_f32_32x32x16_bf16(PAF(1),VFR(5),o[1],0,0,0), C0,12); \
    KRD(GL,2); GAPB(o[0]=__builtin_amdgcn_mfma_f32_32x32x16_bf16(PAF(2),VFR(2),o[0],0,0,0), C1,0); \
    KRD(GL,3); GAPB(o[1]=__builtin_amdgcn_mfma_f32_32x32x16_bf16(PAF(2),VFR(6),o[1],0,0,0), C1,4); \
    GAPB(o[0]=__builtin_amdgcn_mfma_f32_32x32x16_bf16(PAF(3),VFR(3),o[0],0,0,0), C1,8); \
    GAPB(o[1]=__builtin_amdgcn_mfma_f32_32x32x16_bf16(PAF(3),VFR(7),o[1],0,0,0), C1,12); \
    }while(0)
  int t=1;
  #undef CMASK
  #define CMASK(P0,P1,t) do{}while(0)
  for(;t+5<NT;t+=2){
    STEP(pB0,pB1,pA0,pA1,t,true,true,true);     BIASLD(pA0,pA1,t+1); WAIT_BAR(2); RESC(); ROT();
    STEP(pA0,pA1,pB0,pB1,t+1,true,true,true);   BIASLD(pB0,pB1,t+2); WAIT_BAR(2); RESC(); ROT();
  }
  #undef CMASK
  #define CMASK(P0,P1,t) do{int jb_=(t)-(NT-4); if(jb_>=0)cmask(P0,P1,jb_,qrel,hi);}while(0)
  #define ENDW(tt) do{ if((tt)+3<NT){WAIT_BAR(2);} else if((tt)+2<NT){WAIT_BAR(1);} else {WAIT_BAR(0);} }while(0)
  for(;t+1<NT;t+=2){
    STEP(pB0,pB1,pA0,pA1,t,(t+3<NT),(t+1<NT),(t+1<NT));       BIASLD(pA0,pA1,t+1); ENDW(t);   RESC(); ROT();
    STEP(pA0,pA1,pB0,pB1,t+1,(t+4<NT),(t+2<NT),(t+2<NT));     BIASLD(pB0,pB1,t+2); ENDW(t+1); RESC(); ROT();
  }
  STEP(pB0,pB1,pA0,pA1,NT-1,false,false,false); RESC();
  { float sacc=pB0[0]+pB0[1]; _Pragma("unroll") for(int r=2;r<16;++r)sacc+=pB0[r]; _Pragma("unroll") for(int r=0;r<16;++r)sacc+=pB1[r]; l_reg+=sacc;
    pw0=(u32x4){PKW(pB0,0),PKW(pB0,2),PKW(pB0,4),PKW(pB0,6)};pw1=(u32x4){PKW(pB0,8),PKW(pB0,10),PKW(pB0,12),PKW(pB0,14)};pw2=(u32x4){PKW(pB1,0),PKW(pB1,2),PKW(pB1,4),PKW(pB1,6)};pw3=(u32x4){PKW(pB1,8),PKW(pB1,10),PKW(pB1,12),PKW(pB1,14)};
    SBAR(); pv(o,vb0+sl_cur,PAF(0),PAF(1),PAF(2),PAF(3)); }
  #undef PKW
  #undef PAF
  #undef VFR
  #undef PIN
  #undef MX3
  #undef GAPA
  #undef GAPB
  #undef EX
  #undef VRD
  #undef KRD
  #undef STEP
  #undef ENDW
  {auto rr=__builtin_amdgcn_permlane32_swap(__float_as_uint(l_reg),__float_as_uint(l_reg),false,false);l_reg=__uint_as_float(rr[0])+__uint_as_float(rr[1]);}
  if(hi==0)wsf[32+r32]=l_reg;asm volatile("s_waitcnt lgkmcnt(0)":::"memory");
  float rli[16];
  #pragma unroll
  for(int r=0;r<16;++r)rli[r]=__builtin_amdgcn_rcpf(wsf[32+crow(r,hi)]);
  bf16*Ow=O+(rowbase+q0+wid*QBLK)*DM+h*D;
  { bf16*stg=(bf16*)(shm+LDS_OST)+wid*2048;
    #pragma unroll
    for(int r=0;r<16;++r){const int orow=crow(r,hi);
      #pragma unroll
      for(int d0=0;d0<2;++d0)stg[orow*64+d0*32+r32]=__float2bfloat16(o[d0][r]*rli[r]);}
    asm volatile("s_waitcnt lgkmcnt(0)":::"memory");
    const bf16*Gw=OG+(rowbase+q0+wid*QBLK)*DM+h*D;
    int ln=lane; asm volatile("":"+v"(ln));
    #pragma unroll
    for(int i=0;i<4;++i){const int row=i*8+(ln>>3),ch=ln&7; u32x4 v=*(const u32x4*)(stg+row*64+ch*8); const u32x4 g=*(const u32x4*)(Gw+(long)row*DM+ch*8);
      #pragma unroll
      for(int j=0;j<4;++j){ const float g0=__uint_as_float(g[j]<<16),g1=__uint_as_float(g[j]&0xffff0000u),v0=__uint_as_float(v[j]<<16),v1=__uint_as_float(v[j]&0xffff0000u);
        v[j]=cvtpk_s(v0*__builtin_amdgcn_rcpf(1.f+__builtin_amdgcn_exp2f(-1.4426950408889634f*g0)),v1*__builtin_amdgcn_rcpf(1.f+__builtin_amdgcn_exp2f(-1.4426950408889634f*g1))); }
      ATTN_STORE16(Ow+(long)row*DM+ch*8,v);} }
  asm volatile("s_waitcnt lgkmcnt(0)\n\ts_barrier":::"memory");
  #undef DMA_K
  #undef DMA_V
  #undef CMASK
  #undef START
  #undef RESC
  #undef ROT
  #undef BIASLD
}
constexpr int ATTN_LDS_BYTES=LDS_BYTES;
template<int THRL=8> __device__ __forceinline__ void attn_phase(char*lds,const bf16*Q,const bf16*K,const bf16*V,const bf16*OG,bf16*O,const float*Ccum,int wave){
  for(int bh=blockIdx.x;bh<BATCH*NHEAD;bh+=gridDim.x){
    { const int tx=TIDX;
      const f32x4a c=*(const f32x4a*)(Ccum+(size_t)bh*SEQ+tx*4)*1.4426950408889634f;
      *(__attribute__((address_space(3))) f32x4a*)((__attribute__((address_space(3))) char*)lds+LDS_CL+tx*16)=c;
      asm volatile("s_waitcnt lgkmcnt(0)\n\ts_barrier":::"memory"); }
    #pragma unroll 1
    for(int qb=NQB-1;qb>=0;--qb) attn_unit<THRL>(bh/NHEAD,bh%NHEAD,qb,Q,K,V,OG,O,lds,wave);
  }
}
#undef SBAR
#undef WAIT_BAR
}

constexpr int NPHASES = 18;
__global__ void __launch_bounds__(NTHREADS, 2) fwd(Args a) {
    extern __shared__ __attribute__((aligned(16))) unsigned char lds_raw[];
    LAS unsigned char* lds = (LAS unsigned char*)lds_raw;
    cg::grid_group grid = cg::this_grid();
    const int wave = __builtin_amdgcn_readfirstlane(threadIdx.x >> 6);
#define lane lane_now()
    const int G = gridDim.x, gw = blockIdx.x * NWAVES + wave, NGW = G * NWAVES;
    unsigned char* ws = a.ws;
    const int lo = a.ph_lo, hi = a.ph_hi;
#ifdef ONLY_PHASE
#define IN(k) ((k) == ONLY_PHASE && lo <= (k) && (k) < hi)
#else
#define IN(k) (lo <= (k) && (k) < hi)
#endif
#define SEAM(k) do { if (IN(k) && IN((k) + 1)) grid.sync(); } while (0)
    if (IN(0)) { p0_weights(a, lds, gw, NGW, lane, wave); } SEAM(0);
    if (IN(1)) { p1_rows(a, gw, NGW, lane); } SEAM(1);
    if (IN(2)) {
        StaticOrder S; S.init(T, 3072, G, blockIdx.x);
        EpiSplitBf16<0> E{ws};
        gemm_phase<EpiSplitBf16<0>, StaticOrder, IdMap, true>(lds, (const bf16_t*)(ws + AB_XN), (const bf16_t*)(ws + WS_WIN), 1024, S, E, IdMap{}, wave);
    } SEAM(2);
    if (IN(3)) { gla_alpha_naive(a, wave); } SEAM(3);
    if (IN(4)) { gla_scan_naive(a, gw, NGW, lane); } SEAM(4);
    if (IN(5)) { gla_post(a, wave); } SEAM(5);
    if (IN(6)) {
        StaticOrder S; S.init(T, 1024, G, blockIdx.x); EpiResF32 E{a.in[0], a.out};
        gemm_phase<EpiResF32, StaticOrder, IdMap, true>(lds, (const bf16_t*)(ws + AB_V), (const bf16_t*)(ws + WS_WOUT), 1024, S, E, IdMap{}, wave);
    } SEAM(6);
#define MOE_PHASES(layer, pb) \
    if (IN(pb)) { route_phase(a, lds, layer, lane, wave); } SEAM(pb); \
    if (IN(pb + 1)) { \
        const MoeTab tab = moe_tab(lds); moe_tab_build(tab, (const int*)(ws + WS_CTL) + layer * 32, wave); \
        MoeOrder S; S.so.init(tab.tstart[32] * BM, 1024, G, blockIdx.x); S.tab = tab; \
        MoeGather AM{tab, (const int*)(ws + AB_LIST)}; EpiSwiGLU E{(bf16_t*)(ws + AB_HB)}; \
        gemm_phase<EpiSwiGLU, MoeOrder, MoeGather, true>(lds, (const bf16_t*)(ws + AB_XN), (const bf16_t*)(ws + WS_WEUP) + (size_t)layer * 32 * 1024 * 1024, 1024, S, E, AM, wave); \
        __syncthreads(); \
    } SEAM(pb + 1); \
    if (IN(pb + 2)) { \
        const MoeTab tab = moe_tab(lds); moe_tab_build(tab, (const int*)(ws + WS_CTL) + layer * 32, wave); \
        MoeOrder S; S.so.init(tab.tstart[32] * BM, 1024, G, blockIdx.x); S.tab = tab; \
        EpiMoeDown E{(bf16_t*)(ws + AB_YS)}; \
        gemm_phase<EpiMoeDown, MoeOrder, IdMap, true>(lds, (const bf16_t*)(ws + AB_HB), (const bf16_t*)(ws + WS_WEDN) + (size_t)layer * 32 * 1024 * 512, 512, S, E, IdMap{}, wave); \
        __syncthreads(); \
    } SEAM(pb + 2);
    MOE_PHASES(0, 7)
    if (IN(10)) { p10_rows(a, lds, 0, gw, NGW, lane, wave); __syncthreads(); } SEAM(10);
    if (IN(11)) {
        fox_cumsum(a, gw, NGW, lane);
        StaticOrder S; S.init(T, 4096, G, blockIdx.x);
        EpiSplitBf16<1> E{ws};
        gemm_phase<EpiSplitBf16<1>, StaticOrder, IdMap, true>(lds, (const bf16_t*)(ws + AB_XN), (const bf16_t*)(ws + WS_WKVQ), 1024, S, E, IdMap{}, wave);
    } SEAM(11);
    if (IN(12)) {
#ifdef NAIVE_ATTN
        fox_attn_naive(a, gw, NGW, lane);
#else
        attn_body::attn_phase<8>((char*)lds_raw, (const attn_body::bf16*)(ws + AB_FQ), (const attn_body::bf16*)(ws + AB_FK), (const attn_body::bf16*)(ws + AB_FV), (const attn_body::bf16*)(ws + AB_FOG), (attn_body::bf16*)(ws + AB_FQ), (const float*)(ws + AB_C), wave);
#endif
    } SEAM(12);
    if (IN(13)) {
        StaticOrder S; S.init(T, 1024, G, blockIdx.x); EpiResF32 E{a.out, a.out};
        gemm_phase<EpiResF32, StaticOrder, IdMap, true>(lds, (const bf16_t*)(ws + AB_FQ), (const bf16_t*)(ws + WS_WFO), 1024, S, E, IdMap{}, wave);
    } SEAM(13);
    MOE_PHASES(1, 14)
    if (IN(17)) { p17_rows(a, lds, 1, gw, NGW, lane, wave); }
#undef IN
#undef SEAM
#undef lane
}

#ifndef ONE_LAUNCH
#define ONE_LAUNCH 1
#endif
extern "C" void kernel_launch(void* const* d_in, const int* in_sizes, int n_in, void* d_out, int out_size, void* d_ws, size_t ws_size, hipStream_t stream) {
    static int grid = 0;
    if (grid == 0) {
        if (n_in != 22 || out_size != T * D || ws_size < WS_END) { fprintf(stderr, "kernel_launch: unexpected shapes (n_in %d, out %d, ws %zu < %zu)\n", n_in, out_size, ws_size, (size_t)WS_END); grid = -1; return; }
        int dev = 0, cus = 0, per_cu = 0;
        hipGetDevice(&dev); hipDeviceGetAttribute(&cus, hipDeviceAttributeMultiprocessorCount, dev);
        hipFuncSetAttribute((const void*)fwd, hipFuncAttributeMaxDynamicSharedMemorySize, LDS_BYTES);
        hipOccupancyMaxActiveBlocksPerMultiprocessor(&per_cu, (const void*)fwd, NTHREADS, LDS_BYTES);
        if (per_cu < 1) { fprintf(stderr, "kernel_launch: occupancy query says %d blocks per CU\n", per_cu); grid = -1; return; }
        grid = cus;
        fprintf(stderr, "kernel_launch: grid %d (per_cu %d), ws %zu\n", grid, per_cu, ws_size);
    }
    if (grid < 0) return;
    Args a{};
    for (int i = 0; i < 22; ++i) a.in[i] = (const float*)d_in[i];
    a.out = (float*)d_out; a.ws = (unsigned char*)d_ws;
#if ONE_LAUNCH
    a.ph_lo = 0; a.ph_hi = NPHASES;
    void* args[] = {&a};
    hipError_t e = hipLaunchCooperativeKernel((const void*)fwd, dim3(grid), dim3(NTHREADS), args, LDS_BYTES, stream);
    if (e != hipSuccess) fprintf(stderr, "cooperative launch failed: %s\n", hipGetErrorString(e));
#else
    for (int p = 0; p < NPHASES; ++p) {
        a.ph_lo = p; a.ph_hi = p + 1;
        hipLaunchKernelGGL(fwd, dim3(grid), dim3(NTHREADS), LDS_BYTES, stream, a);
    }
#endif
}
```

```cpp
#include <hip/hip_runtime.h>
#include <hip/hip_cooperative_groups.h>
#include <cstdio>
#include <cstdint>
namespace cg = cooperative_groups;

#define LAS __attribute__((address_space(3)))
typedef unsigned short bf16_t;
typedef short bf16x8 __attribute__((ext_vector_type(8)));
typedef float f32x4 __attribute__((ext_vector_type(4)));
typedef float f32x2 __attribute__((ext_vector_type(2)));
typedef unsigned u32x4 __attribute__((ext_vector_type(4)));
typedef unsigned u32x2 __attribute__((ext_vector_type(2)));
typedef int i32x4 __attribute__((ext_vector_type(4)));

constexpr int T = 32768, D = 1024, NBATCH = 16, SEQ = 2048;
constexpr int NWAVES = 8, NTHREADS = 512;
constexpr float RMS_EPS = 1e-6f;
constexpr float LOG2E = 1.4426950408889634f;
constexpr float ATT_C2 = 0.125f * LOG2E;
constexpr float GLA_QSCALE = 0.08838834764831845f;
constexpr int NEXP = 32;
constexpr int MAXTILES = 288;

constexpr size_t MiB = 1u << 20;
constexpr size_t WS_CTL = 0;
constexpr size_t WS_SKINNY = 256 * 1024;
constexpr size_t WS_WIN = 1 * MiB;
constexpr size_t WS_WOUT = WS_WIN + 6 * MiB;
constexpr size_t WS_WKVQ = WS_WOUT + 2 * MiB;
constexpr size_t WS_WFO = WS_WKVQ + 8 * MiB;
constexpr size_t WS_WEUP = WS_WFO + 2 * MiB;
constexpr size_t WS_WEDN = WS_WEUP + 128 * MiB;
constexpr size_t WS_AB = WS_WEDN + 64 * MiB;
constexpr size_t AB_XN = WS_AB;
constexpr size_t AB_Q = WS_AB + 64 * MiB;
constexpr size_t AB_K = WS_AB + 96 * MiB;
constexpr size_t AB_V = WS_AB + 128 * MiB;
constexpr size_t AB_R = WS_AB + 192 * MiB;
constexpr size_t AB_KHT = WS_AB + 256 * MiB;
constexpr size_t AB_PM = WS_AB + 288 * MiB;
constexpr size_t AB_EL = WS_AB + 304 * MiB;
constexpr size_t AB_AA = WS_AB + 305 * MiB;
constexpr size_t AB_SSQ = WS_AB + 307 * MiB;
constexpr size_t AB_ALPHA = AB_XN;
constexpr size_t AB_HB = WS_AB + 64 * MiB;
constexpr size_t AB_YS = WS_AB + 136 * MiB;
constexpr size_t AB_LIST = WS_AB + 280 * MiB;
constexpr size_t AB_TOKI = WS_AB + 284 * MiB;
constexpr size_t AB_TOKG = WS_AB + 285 * MiB;
constexpr size_t AB_FK = WS_AB + 64 * MiB;
constexpr size_t AB_FV = WS_AB + 128 * MiB;
constexpr size_t AB_FQ = WS_AB + 192 * MiB;
constexpr size_t AB_FOG = WS_AB + 256 * MiB;
constexpr size_t AB_LF = WS_AB + 320 * MiB;
constexpr size_t AB_C = WS_AB + 322 * MiB;
constexpr size_t WS_END = WS_AB + 324 * MiB;

constexpr int SK_WA = 0, SK_WR0 = 16 * 1024, SK_WR1 = SK_WR0 + 36 * 1024, SK_WF = SK_WR1 + 36 * 1024;

constexpr int RING_BYTES = 131072;
constexpr int LDS_MISC = RING_BYTES;
constexpr int LDS_BYTES = 147456;

__device__ __forceinline__ unsigned f2bf(float f) { unsigned u = __builtin_bit_cast(unsigned, f); return (u + 0x7fffu + ((u >> 16) & 1u)) >> 16; }
__device__ __forceinline__ unsigned pk2(float lo, float hi) { return f2bf(lo) | (f2bf(hi) << 16); }
__device__ __forceinline__ float bf2f(unsigned h) { return __builtin_bit_cast(float, h << 16); }
__device__ __forceinline__ float bflo(unsigned w) { return __builtin_bit_cast(float, w << 16); }
__device__ __forceinline__ float bfhi(unsigned w) { return __builtin_bit_cast(float, w & 0xffff0000u); }
__device__ __forceinline__ float wave_sum(float v) {
#pragma unroll
    for (int o = 1; o < 64; o <<= 1) v += __shfl_xor(v, o);
    return v;
}
__device__ __forceinline__ float log_sigmoid(float z) { return fminf(z, 0.f) - log1pf(__expf(-fabsf(z))); }
__device__ __forceinline__ float sigmoidf_(float z) { return 1.f / (1.f + __expf(-z)); }
__device__ __forceinline__ int lane_now() { int l; asm volatile("v_mbcnt_lo_u32_b32 %0, -1, 0\n\tv_mbcnt_hi_u32_b32 %0, -1, %0" : "=v"(l)); return l; }
#define TIDX (wave * 64 + lane_now())
__device__ __forceinline__ int perm32(int rho) { const int n = rho >> 4, i = rho & 15; return 8 * (i >> 2) + 4 * n + (i & 3); }

struct Args { const float* in[22]; float* out; unsigned char* ws; int ph_lo, ph_hi; };

struct Unit { int pm, pn; };
constexpr int BM = 256, HALF = 128, NXCD = 8, WGM = 8;
struct StaticOrder {
    int nM, nN, nwg, G, c;
    __device__ void init(int M, int N, int G_, int c_) { nM = M / BM; nN = N / BM; nwg = nM * nN; G = G_; c = c_; }
    __device__ bool next(int i, Unit& u) const {
        const long L = (long)i * G + c; if (L >= nwg) return false;
        int wgid = (int)L; { const int q = nwg / NXCD, r = nwg % NXCD, xcd = wgid % NXCD, off = wgid / NXCD; wgid = (xcd < r ? xcd * (q + 1) : r * (q + 1) + (xcd - r) * q) + off; }
        const int nig = WGM * nN, gid = wgid / nig, fm = gid * WGM, gsz = (nM - fm) < WGM ? (nM - fm) : WGM;
        u.pm = fm + ((wgid % nig) % gsz); u.pn = (wgid % nig) / gsz; return true;
    }
};
struct IdMap { __device__ __forceinline__ int row(const Unit& u, int r) const { return u.pm * BM + r; } };

struct MoeTab { LAS int* cnt; LAS int* tstart; LAS int* tile_e; };
__device__ __forceinline__ MoeTab moe_tab(LAS unsigned char* lds) { MoeTab t; t.cnt = (LAS int*)(lds + LDS_MISC); t.tstart = t.cnt + 32; t.tile_e = t.tstart + 64; return t; }
__device__ __forceinline__ void moe_tab_build(const MoeTab& t, const int* gcnt, int wave) {
    const int tidx = TIDX;
    if (tidx == 0) { int s = 0; for (int e = 0; e < NEXP; ++e) { const int c = gcnt[e]; t.cnt[e] = c; t.tstart[e] = s; s += (c + 255) >> 8; } t.tstart[32] = s; }
    __syncthreads();
    const int nt = t.tstart[32];
    for (int p = tidx; p < nt; p += NTHREADS) { int e = 0; for (int j = 1; j < NEXP; ++j) if (t.tstart[j] <= p) e = j; t.tile_e[p] = e; }
    __syncthreads();
}
struct MoeOrder {
    StaticOrder so; MoeTab tab;
    __device__ bool next(int i, Unit& u) const { if (!so.next(i, u)) return false; u.pn += 4 * tab.tile_e[u.pm]; return true; }
};
struct MoeGather {
    MoeTab tab; const int* list;
    __device__ __forceinline__ int row(const Unit& u, int r) const {
        const int e = u.pn >> 2; int idx = (u.pm - tab.tstart[e]) * BM + r; const int c = tab.cnt[e]; idx = idx < c ? idx : c - 1; return list[e * T + idx];
    }
};

template <int WHICH> struct EpiSplitBf16 {
    static constexpr bool PERM = true;
    unsigned char* ws;
    __device__ __forceinline__ void operator()(const f32x4 (&acc)[2][2][4][2], const Unit& u, int wr, int wc, int fr, int fq) const {
        size_t off; int ldc, f0;
        if (WHICH == 0) { if (u.pn < 2) { off = AB_Q; ldc = 512; f0 = 0; } else if (u.pn < 4) { off = AB_K; ldc = 512; f0 = 2; } else if (u.pn < 8) { off = AB_V; ldc = 1024; f0 = 4; } else { off = AB_R; ldc = 1024; f0 = 8; } }
        else { off = AB_FK + (size_t)(u.pn >> 2) * (64 * MiB); ldc = 1024; f0 = u.pn & ~3; }
        bf16_t* base = (bf16_t*)(ws + off);
        const int row0 = u.pm * BM + wr * 64 + fr, col0 = (u.pn - f0) * BM + wc * 32 + 8 * fq;
#pragma unroll
        for (int ai = 0; ai < 2; ++ai)
#pragma unroll
            for (int m = 0; m < 4; ++m) { bf16_t* rowp = base + (size_t)(row0 + ai * HALF + m * 16) * ldc + col0;
#pragma unroll
                for (int bj = 0; bj < 2; ++bj) { const f32x4 v0 = acc[ai][bj][m][0], v1 = acc[ai][bj][m][1];
                    u32x4 w; w.x = pk2(v0[0], v0[1]); w.y = pk2(v0[2], v0[3]); w.z = pk2(v1[0], v1[1]); w.w = pk2(v1[2], v1[3]);
                    *(u32x4*)(rowp + bj * HALF) = w; } }
    }
};
struct EpiResF32 {
    static constexpr bool PERM = false;
    const float* base; float* out;
    __device__ __forceinline__ void operator()(const f32x4 (&acc)[2][2][4][2], const Unit& u, int wr, int wc, int fr, int fq) const {
        const int row0 = u.pm * BM + wr * 64 + fr, col0 = u.pn * BM + wc * 32 + 4 * fq;
#pragma unroll
        for (int ai = 0; ai < 2; ++ai)
#pragma unroll
            for (int m = 0; m < 4; ++m) { const size_t off = (size_t)(row0 + ai * HALF + m * 16) * D + col0;
#pragma unroll
                for (int bj = 0; bj < 2; ++bj)
#pragma unroll
                    for (int n = 0; n < 2; ++n) { const f32x4 b = *(const f32x4*)(base + off + bj * HALF + n * 16); *(f32x4*)(out + off + bj * HALF + n * 16) = b + acc[ai][bj][m][n]; } }
    }
};
struct EpiSwiGLU {
    static constexpr bool PERM = true;
    bf16_t* hb;
    __device__ __forceinline__ void operator()(const f32x4 (&acc)[2][2][4][2], const Unit& u, int wr, int wc, int fr, int fq) const {
        const int row0 = u.pm * BM + wr * 64 + fr, col0 = (u.pn & 3) * 128 + wc * 32 + 8 * fq;
#pragma unroll
        for (int ai = 0; ai < 2; ++ai)
#pragma unroll
            for (int m = 0; m < 4; ++m) { float h[8];
#pragma unroll
                for (int n = 0; n < 2; ++n)
#pragma unroll
                    for (int j = 0; j < 4; ++j) { const float g = acc[ai][0][m][n][j], up = acc[ai][1][m][n][j]; h[n * 4 + j] = g * sigmoidf_(g) * up; }
                u32x4 w; w.x = pk2(h[0], h[1]); w.y = pk2(h[2], h[3]); w.z = pk2(h[4], h[5]); w.w = pk2(h[6], h[7]);
                *(u32x4*)(hb + (size_t)(row0 + ai * HALF + m * 16) * 512 + col0) = w; }
    }
};
struct EpiMoeDown {
    static constexpr bool PERM = true;
    bf16_t* ys;
    __device__ __forceinline__ void operator()(const f32x4 (&acc)[2][2][4][2], const Unit& u, int wr, int wc, int fr, int fq) const {
        const int row0 = u.pm * BM + wr * 64 + fr, col0 = (u.pn & 3) * BM + wc * 32 + 8 * fq;
#pragma unroll
        for (int ai = 0; ai < 2; ++ai)
#pragma unroll
            for (int m = 0; m < 4; ++m) { bf16_t* rowp = ys + (size_t)(row0 + ai * HALF + m * 16) * D + col0;
#pragma unroll
                for (int bj = 0; bj < 2; ++bj) { const f32x4 v0 = acc[ai][bj][m][0], v1 = acc[ai][bj][m][1];
                    u32x4 w; w.x = pk2(v0[0], v0[1]); w.y = pk2(v0[2], v0[3]); w.z = pk2(v1[0], v1[1]); w.w = pk2(v1[2], v1[3]);
                    *(u32x4*)(rowp + bj * HALF) = w; } }
    }
};

template <class Epi, class Sched, class AMap>
__device__ __forceinline__ void gemm_direct(const bf16_t* __restrict__ A, const bf16_t* __restrict__ Bt, int K, const Sched& S, const Epi& E, const AMap& AM, int wave) {
    const int wid = wave, lane = lane_now(), tid = wid * 64 + lane, wr = wid >> 2, wc = wid & 3, fr = lane & 15, fq = lane >> 4;
    Unit u;
    for (int i = 0; S.next(i, u); ++i) {
        f32x4 acc[2][2][4][2];
#pragma unroll
        for (int a = 0; a < 2; ++a)
#pragma unroll
            for (int b = 0; b < 2; ++b)
#pragma unroll
                for (int m = 0; m < 4; ++m)
#pragma unroll
                    for (int n = 0; n < 2; ++n) acc[a][b][m][n] = (f32x4){0.f, 0.f, 0.f, 0.f};
        const bf16_t* ap[2][4]; const bf16_t* bp[2][2];
#pragma unroll
        for (int ai = 0; ai < 2; ++ai)
#pragma unroll
            for (int m = 0; m < 4; ++m) ap[ai][m] = A + (size_t)AM.row(u, ai * HALF + wr * 64 + m * 16 + fr) * K + 8 * fq;
#pragma unroll
        for (int bj = 0; bj < 2; ++bj)
#pragma unroll
            for (int n = 0; n < 2; ++n) { const int rho = 16 * n + fr, rr = Epi::PERM ? perm32(rho) : rho; bp[bj][n] = Bt + (size_t)(u.pn * BM + bj * HALF + wc * 32 + rr) * K + 8 * fq; }
        for (int k0 = 0; k0 < K; k0 += 32) {
            bf16x8 af[2][4], bfr[2][2];
#pragma unroll
            for (int ai = 0; ai < 2; ++ai)
#pragma unroll
                for (int m = 0; m < 4; ++m) af[ai][m] = *(const bf16x8*)(ap[ai][m] + k0);
#pragma unroll
            for (int bj = 0; bj < 2; ++bj)
#pragma unroll
                for (int n = 0; n < 2; ++n) bfr[bj][n] = *(const bf16x8*)(bp[bj][n] + k0);
#pragma unroll
            for (int ai = 0; ai < 2; ++ai)
#pragma unroll
                for (int bj = 0; bj < 2; ++bj)
#pragma unroll
                    for (int m = 0; m < 4; ++m)
#pragma unroll
                        for (int n = 0; n < 2; ++n) acc[ai][bj][m][n] = __builtin_amdgcn_mfma_f32_16x16x32_bf16(bfr[bj][n], af[ai][m], acc[ai][bj][m][n], 0, 0, 0);
        }
        E(acc, u, wr, wc, fr, fq);
    }
}

constexpr int BK = 64, HTB = HALF * BK * 2;
__device__ __forceinline__ int lds_byte(int r, int c) { const int st = (r >> 4) * 2 + (c >> 5), rr = r & 15, cc = c & 31, ob = rr * 64 + cc * 2; return st * 1024 + (ob ^ (((ob >> 9) & 1) << 5)); }
__device__ __forceinline__ void stage_rc(int b, int& R, int& C) { const int st = b / 1024, sb = b % 1024, swz = sb ^ (((sb >> 9) & 1) << 5); R = (st >> 1) * 16 + swz / 64; C = (st & 1) * 32 + (swz % 64) / 2; }
template <class Epi, class Sched, class AMap, bool ALIGN_EPI>
__device__ __forceinline__ void gemm_phase(LAS unsigned char* lds, const bf16_t* A, const bf16_t* Bt, const int K, const Sched& S, const Epi& E, const AMap& AM, int wave) {
    const int wid = wave, lane = lane_now(), tid = wid * 64 + lane, wr = wid >> 2, wc = wid & 3, fr = lane & 15, fq = lane >> 4;
    const int nt = K / BK;
    int RA[2], CA[2]; unsigned voffB[2];
#pragma unroll
    for (int i = 0; i < 2; ++i) { int R, C; stage_rc(tid * 16 + i * 8192, R, C); const int Rb = Epi::PERM ? ((R & ~31) + perm32(R & 31)) : R; RA[i] = R; CA[i] = C; voffB[i] = (unsigned)(Rb * K + C) * 2u; }
    const size_t kstep = (size_t)(BK * 2);
    const size_t hstep = (size_t)HALF * K * 2;
    const size_t tstep = 2 * hstep;
    const unsigned ldsw = (unsigned)wid * 1024u;
    const int aoff = lds_byte(wr * 64 + fr, fq * 8), boff = lds_byte(wc * 32 + fr, fq * 8);
#define PG8_SA(b, h) (((b) * 2 + (h)) * HTB)
#define PG8_SB(b, h) ((4 + (b) * 2 + (h)) * HTB)
#define PG8_STAGE(bufoff, gbase, voff) do { _Pragma("unroll") for (int _i = 0; _i < 2; ++_i) \
        __builtin_amdgcn_global_load_lds((const unsigned*)((const char*)(gbase) + (voff)[_i]), (LAS unsigned*)(lds + (bufoff) + ldsw + _i * 8192), 16, 0, 0); } while (0)
#define PG8_LDA(dst, b, h) do { _Pragma("unroll") for (int m = 0; m < 4; ++m) _Pragma("unroll") for (int k = 0; k < 2; ++k) dst[m][k] = *(const LAS bf16x8*)(lds + PG8_SA(b, h) + aoff + m * 2048 + k * 1024); } while (0)
#define PG8_LDB(dst, b, h) do { _Pragma("unroll") for (int n = 0; n < 2; ++n) _Pragma("unroll") for (int k = 0; k < 2; ++k) dst[n][k] = *(const LAS bf16x8*)(lds + PG8_SB(b, h) + boff + n * 2048 + k * 1024); } while (0)
#define PG8_MMA(ai, bj, At, Bt_) do { __builtin_amdgcn_s_setprio(1); _Pragma("unroll") for (int m = 0; m < 4; ++m) _Pragma("unroll") for (int n = 0; n < 2; ++n) _Pragma("unroll") for (int k = 0; k < 2; ++k) \
        acc[ai][bj][m][n] = __builtin_amdgcn_mfma_f32_16x16x32_bf16(Bt_[n][k], At[m][k], acc[ai][bj][m][n], 0, 0, 0); __builtin_amdgcn_s_setprio(0); } while (0)
#define PG8_WAIT_V(n) asm volatile("s_waitcnt vmcnt(" #n ")" ::: "memory")
#define PG8_WAIT_L(n) asm volatile("s_waitcnt lgkmcnt(" #n ")" ::: "memory")
#define PG8_BAR __builtin_amdgcn_s_barrier()
#define PG8_SCHED __builtin_amdgcn_sched_barrier(0)
#define PG8_OFFS(dst, u) do { _Pragma("unroll") for (int h = 0; h < 2; ++h) _Pragma("unroll") for (int i = 0; i < 2; ++i) dst[h][i] = (unsigned)(((size_t)AM.row(u, h * HALF + RA[i]) * K + CA[i]) * 2); } while (0)
    Unit cur, nxt; int ui = 0;
    if (!S.next(0, cur)) return;
    f32x4 acc[2][2][4][2];
#pragma unroll
    for (int a = 0; a < 2; ++a)
#pragma unroll
        for (int b = 0; b < 2; ++b)
#pragma unroll
            for (int m = 0; m < 4; ++m)
#pragma unroll
                for (int n = 0; n < 2; ++n) acc[a][b][m][n] = (f32x4){0.f, 0.f, 0.f, 0.f};
    bf16x8 At[4][2], B0[2][2], B1[2][2];
    unsigned oc[2][2], on[2][2];
    PG8_OFFS(oc, cur);
    const char* const Ab = (const char*)A;
    const char* cB = (const char*)Bt + (size_t)cur.pn * tstep;
    PG8_STAGE(PG8_SB(0, 0), cB, voffB); PG8_STAGE(PG8_SB(0, 1), cB + hstep, voffB); PG8_STAGE(PG8_SA(0, 0), Ab, oc[0]); PG8_STAGE(PG8_SA(0, 1), Ab, oc[1]);
    if (wr == 1) PG8_BAR;
    PG8_WAIT_V(2); PG8_BAR;
    PG8_STAGE(PG8_SB(1, 0), cB + kstep, voffB); PG8_STAGE(PG8_SA(1, 0), Ab + kstep, oc[0]); PG8_STAGE(PG8_SB(1, 1), cB + hstep + kstep, voffB);
    PG8_WAIT_V(6); PG8_BAR;
    for (;;) {
        const bool has_next = S.next(ui + 1, nxt);
        const char* nB = cB;
        if (has_next) { PG8_OFFS(on, nxt); nB = (const char*)Bt + (size_t)nxt.pn * tstep; }
        else {
#pragma unroll
            for (int h = 0; h < 2; ++h)
#pragma unroll
                for (int i = 0; i < 2; ++i) on[h][i] = oc[h][i]; }
        for (int t = 0; t < nt; t += 2) {
            const bool last = (t == nt - 2);
            const char* a1 = Ab + (size_t)(t + 1) * kstep;
            const char* a2 = last ? Ab : Ab + (size_t)(t + 2) * kstep; const char* b2 = last ? nB : cB + (size_t)(t + 2) * kstep;
            const char* a3 = a2 + kstep; const char* b3 = b2 + kstep;
            unsigned o2[2][2];
#pragma unroll
            for (int h = 0; h < 2; ++h)
#pragma unroll
                for (int i = 0; i < 2; ++i) o2[h][i] = last ? on[h][i] : oc[h][i];
            PG8_LDB(B0, 0, 0); PG8_LDB(B1, 0, 1); PG8_SCHED; PG8_LDA(At, 0, 0); PG8_STAGE(PG8_SA(1, 1), a1, oc[1]);
            PG8_WAIT_V(8); PG8_WAIT_L(0); PG8_BAR; PG8_MMA(0, 0, At, B0); PG8_MMA(0, 1, At, B1); PG8_BAR; PG8_SCHED;
            PG8_LDA(At, 0, 1); PG8_STAGE(PG8_SB(0, 0), b2, voffB); PG8_STAGE(PG8_SB(0, 1), b2 + hstep, voffB); PG8_STAGE(PG8_SA(0, 0), a2, o2[0]);
            PG8_WAIT_V(8); PG8_WAIT_L(0); PG8_BAR; PG8_MMA(1, 0, At, B0); PG8_MMA(1, 1, At, B1); PG8_BAR; PG8_SCHED;
            PG8_LDB(B0, 1, 0); PG8_LDB(B1, 1, 1); PG8_SCHED; PG8_LDA(At, 1, 0); PG8_STAGE(PG8_SA(0, 1), a2, o2[1]);
            PG8_WAIT_V(8); PG8_WAIT_L(0); PG8_BAR; PG8_MMA(0, 0, At, B0); PG8_MMA(0, 1, At, B1); PG8_BAR; PG8_SCHED;
            PG8_LDA(At, 1, 1); PG8_STAGE(PG8_SB(1, 0), b3, voffB); PG8_STAGE(PG8_SB(1, 1), b3 + hstep, voffB); PG8_STAGE(PG8_SA(1, 0), a3, o2[0]);
            PG8_WAIT_V(8); PG8_WAIT_L(0); PG8_BAR; PG8_MMA(1, 0, At, B0); PG8_MMA(1, 1, At, B1); PG8_BAR; PG8_SCHED;
        }
        if constexpr (ALIGN_EPI) { if (wr == 0) PG8_BAR; }
        E(acc, cur, wr, wc, fr, fq);
        if (!has_next) break;
#pragma unroll
        for (int a = 0; a < 2; ++a)
#pragma unroll
            for (int b = 0; b < 2; ++b)
#pragma unroll
                for (int m = 0; m < 4; ++m)
#pragma unroll
                    for (int n = 0; n < 2; ++n) acc[a][b][m][n] = (f32x4){0.f, 0.f, 0.f, 0.f};
        cur = nxt; cB = nB; ++ui;
#pragma unroll
        for (int h = 0; h < 2; ++h)
#pragma unroll
            for (int i = 0; i < 2; ++i) oc[h][i] = on[h][i];
        if constexpr (ALIGN_EPI) { if (wr == 1) PG8_BAR; }
    }
    PG8_WAIT_V(0);
    if constexpr (!ALIGN_EPI) { if (wr == 0) PG8_BAR; }
    PG8_BAR;
#undef PG8_SA
#undef PG8_SB
#undef PG8_STAGE
#undef PG8_LDA
#undef PG8_LDB
#undef PG8_MMA
#undef PG8_WAIT_V
#undef PG8_WAIT_L
#undef PG8_BAR
#undef PG8_SCHED
#undef PG8_OFFS
}

__device__ __forceinline__ void tr_item(const float* __restrict__ W, int ldw, int k0, const float* __restrict__ gain, float scale, bf16_t* dst  , int Kd, LAS float* scr, int lane) {
#pragma unroll 8
    for (int i = 0; i < 32; ++i) { const int kk = 2 * i + (lane >> 5); float v = W[(size_t)(k0 + kk) * ldw + (lane & 31)]; const float g = gain ? gain[k0 + kk] : 1.f; scr[kk * 33 + (lane & 31)] = v * g * scale; }
    asm volatile("s_waitcnt lgkmcnt(0)" ::: "memory");
    const int c = lane & 7;
#pragma unroll
    for (int j = 0; j < 4; ++j) { const int n = (lane >> 3) + 8 * j; const LAS float* s = scr + (8 * c) * 33 + n;
        u32x4 o; o.x = pk2(s[0 * 33], s[1 * 33]); o.y = pk2(s[2 * 33], s[3 * 33]); o.z = pk2(s[4 * 33], s[5 * 33]); o.w = pk2(s[6 * 33], s[7 * 33]);
        *(u32x4*)(dst + (size_t)n * Kd + k0 + 8 * c) = o; }
    asm volatile("s_waitcnt lgkmcnt(0)" ::: "memory");
}
__device__ __forceinline__ void p0_weights(const Args& a, LAS unsigned char* lds, int gw, int NGW, int lane, int wave) {
    LAS float* scr = (LAS float*)(lds + wave * 16384);
    unsigned char* ws = a.ws;
    bf16_t* WIN = (bf16_t*)(ws + WS_WIN); bf16_t* WOUT = (bf16_t*)(ws + WS_WOUT); bf16_t* WKVQ = (bf16_t*)(ws + WS_WKVQ); bf16_t* WFO = (bf16_t*)(ws + WS_WFO);
    bf16_t* WEUP = (bf16_t*)(ws + WS_WEUP); bf16_t* WEDN = (bf16_t*)(ws + WS_WEDN);
    constexpr int I_IN = 16 * 96, I_OUT = 16 * 32, I_KV = 16 * 64, I_FQ = 16 * 32, I_FOG = 16 * 32, I_FO = 16 * 32;
    constexpr int I_SMALL = I_IN + I_OUT + I_KV + I_FQ + I_FOG + I_FO;
    constexpr int I_EG = 16 * 16, I_ED = 8 * 32;
    constexpr int I_EXP = 2 * I_EG + I_ED;
    constexpr int NITEMS = I_SMALL + 2 * NEXP * I_EXP;
    for (int it = gw; it < NITEMS; it += NGW) {
        int r = it;
        if (r < I_IN) { const int kb = r / 96, nb = r % 96; const int n0 = nb * 32; tr_item(a.in[2] + n0, 3088, kb * 64, a.in[1], n0 < 512 ? GLA_QSCALE : 1.f, WIN + (size_t)n0 * 1024, 1024, scr, lane); continue; } r -= I_IN;
        if (r < I_OUT) { const int kb = r / 32, n0 = (r % 32) * 32; tr_item(a.in[6] + n0, 1024, kb * 64, a.in[5], 1.f, WOUT + (size_t)n0 * 1024, 1024, scr, lane); continue; } r -= I_OUT;
        if (r < I_KV) { const int kb = r / 64, n0 = (r % 64) * 32; tr_item(a.in[8] + n0, 2064, kb * 64, a.in[7], 1.f, WKVQ + (size_t)n0 * 1024, 1024, scr, lane); continue; } r -= I_KV;
        if (r < I_FQ) { const int kb = r / 32, n0 = (r % 32) * 32; tr_item(a.in[11] + n0, 2048, kb * 64, a.in[10], ATT_C2, WKVQ + (size_t)(2048 + n0) * 1024, 1024, scr, lane); continue; } r -= I_FQ;
        if (r < I_FOG) { const int kb = r / 32, n0 = (r % 32) * 32; tr_item(a.in[11] + 1024 + n0, 2048, kb * 64, a.in[10], 1.f, WKVQ + (size_t)(3072 + n0) * 1024, 1024, scr, lane); continue; } r -= I_FOG;
        if (r < I_FO) { const int kb = r / 32, n0 = (r % 32) * 32; tr_item(a.in[12] + n0, 1024, kb * 64, nullptr, 1.f, WFO + (size_t)n0 * 1024, 1024, scr, lane); continue; } r -= I_FO;
        const int le = r / I_EXP, l = le / NEXP; int q = r % I_EXP;
        const float* gain = a.in[13] + l * 1024;
        if (q < 2 * I_EG) { const int up = q >= I_EG; if (up) q -= I_EG; const int kb = q / 16, n0 = (q % 16) * 32;
            const float* W = (up ? a.in[19] : a.in[18]) + (size_t)le * 1024 * 512 + n0;
            bf16_t* dst = WEUP + ((size_t)le * 1024 + (n0 >> 7) * 256 + up * 128 + (n0 & 127)) * 1024;
            tr_item(W, 512, kb * 64, gain, 1.f, dst, 1024, scr, lane); continue; }
        q -= 2 * I_EG;
        { const int kb = q / 32, n0 = (q % 32) * 32; tr_item(a.in[20] + (size_t)le * 512 * 1024 + n0, 1024, kb * 64, nullptr, 1.f, WEDN + ((size_t)le * 1024 + n0) * 512, 512, scr, lane); }
    }
    float* SK = (float*)(ws + WS_SKINNY);
    const int gt = gw * 64 + lane, NGT = NGW * 64;
    for (int i = gt; i < (16 + 36 + 36 + 16) * 1024; i += NGT) {
        const int n = i >> 10, k = i & 1023; float v;
        if (n < 16) v = a.in[1][k] * a.in[2][(size_t)k * 3088 + 3072 + n];
        else if (n < 52) { const int m = n - 16; v = a.in[13][k] * (m < 4 ? a.in[14][k * 4 + m] : a.in[16][k * 32 + (m - 4)]); }
        else if (n < 88) { const int m = n - 52; v = a.in[13][1024 + k] * (m < 4 ? a.in[14][4096 + k * 4 + m] : a.in[16][32768 + k * 32 + (m - 4)]); }
        else { const int m = n - 88; v = a.in[7][k] * a.in[8][(size_t)k * 2064 + 2048 + m]; }
        SK[i] = v;
    }
    if (blockIdx.x == 0 && wave == 0) ((int*)(ws + WS_CTL))[lane] = 0;
}

struct RowRegs { f32x4 v[4]; };
__device__ __forceinline__ RowRegs row_load(const float* p, int lane) { RowRegs r; const f32x4* q = (const f32x4*)p + lane;
#pragma unroll
    for (int j = 0; j < 4; ++j) r.v[j] = q[64 * j];
    return r; }
__device__ __forceinline__ float row_rs(const RowRegs& r) { float s = 0.f;
#pragma unroll
    for (int j = 0; j < 4; ++j) s += (r.v[j][0] * r.v[j][0] + r.v[j][1] * r.v[j][1]) + (r.v[j][2] * r.v[j][2] + r.v[j][3] * r.v[j][3]);
    return 1.0f / sqrtf(wave_sum(s) * (1.0f / 1024.0f) + RMS_EPS); }
__device__ __forceinline__ void row_store_bf16(bf16_t* p, const RowRegs& r, float rs, int lane) { u32x2* o = (u32x2*)p + lane;
#pragma unroll
    for (int j = 0; j < 4; ++j) { u32x2 w; w.x = pk2(r.v[j][0] * rs, r.v[j][1] * rs); w.y = pk2(r.v[j][2] * rs, r.v[j][3] * rs); o[64 * j] = w; } }
__device__ __forceinline__ float row_dot(const RowRegs& r, const float* w, int lane) { const f32x4* q = (const f32x4*)w + lane; float s = 0.f;
#pragma unroll
    for (int j = 0; j < 4; ++j) { const f32x4 x = q[64 * j]; s += (r.v[j][0] * x[0] + r.v[j][1] * x[1]) + (r.v[j][2] * x[2] + r.v[j][3] * x[3]); }
    return wave_sum(s); }
__device__ __forceinline__ void row_add_bf16(RowRegs& r, const bf16_t* p, float g, int lane) { const u32x2* q = (const u32x2*)p + lane;
#pragma unroll
    for (int j = 0; j < 4; ++j) { const u32x2 w = q[64 * j]; r.v[j][0] += g * bflo(w.x); r.v[j][1] += g * bfhi(w.x); r.v[j][2] += g * bflo(w.y); r.v[j][3] += g * bfhi(w.y); } }

__device__ __forceinline__ void p1_rows(const Args& a, int gw, int NGW, int lane) {
    bf16_t* XN = (bf16_t*)(a.ws + AB_XN); float* AA = (float*)(a.ws + AB_AA); const float* WA = (const float*)(a.ws + WS_SKINNY) + SK_WA;
    for (int t = gw; t < T; t += NGW) {
        const RowRegs r = row_load(a.in[0] + (size_t)t * D, lane); const float rs = row_rs(r);
        row_store_bf16(XN + (size_t)t * D, r, rs, lane);
        float mine = 0.f;
#pragma unroll
        for (int n = 0; n < 16; ++n) { const float d = row_dot(r, WA + n * 1024, lane) * rs; if (lane == n) mine = d; }
        if (lane < 16) AA[(size_t)t * 16 + lane] = mine;
    }
}

__device__ __forceinline__ void combine_row(RowRegs& r, const unsigned char* ws, const MoeTab& tab, int t, int lane) {
    const i32x4 ti = ((const i32x4*)(ws + AB_TOKI))[t]; const f32x2 tg = ((const f32x2*)(ws + AB_TOKG))[t];
    const bf16_t* YS = (const bf16_t*)(ws + AB_YS);
    const int p0 = tab.tstart[ti.x] * BM + ti.z, p1 = tab.tstart[ti.y] * BM + ti.w;
    row_add_bf16(r, YS + (size_t)p0 * D, tg.x, lane); row_add_bf16(r, YS + (size_t)p1 * D, tg.y, lane);
}
__device__ __forceinline__ void p10_rows(const Args& a, LAS unsigned char* lds, int layer, int gw, int NGW, int lane, int wave) {
    const MoeTab tab = moe_tab(lds); moe_tab_build(tab, (const int*)(a.ws + WS_CTL) + layer * 32, wave);
    bf16_t* XN = (bf16_t*)(a.ws + AB_XN); float* LF = (float*)(a.ws + AB_LF); const float* WF = (const float*)(a.ws + WS_SKINNY) + SK_WF;
    for (int t = gw; t < T; t += NGW) {
        RowRegs r = row_load(a.out + (size_t)t * D, lane); combine_row(r, a.ws, tab, t, lane);
        f32x4* o = (f32x4*)(a.out + (size_t)t * D) + lane;
#pragma unroll
        for (int j = 0; j < 4; ++j) o[64 * j] = r.v[j];
        const float rs = row_rs(r); row_store_bf16(XN + (size_t)t * D, r, rs, lane);
        float mine = 0.f;
#pragma unroll
        for (int n = 0; n < 16; ++n) { const float d = row_dot(r, WF + n * 1024, lane) * rs; if (lane == n) mine = d; }
        if (lane < 16) LF[(size_t)t * 16 + lane] = log_sigmoid(mine + a.in[9][lane]);
    }
}
__device__ __forceinline__ void p17_rows(const Args& a, LAS unsigned char* lds, int layer, int gw, int NGW, int lane, int wave) {
    const MoeTab tab = moe_tab(lds); moe_tab_build(tab, (const int*)(a.ws + WS_CTL) + layer * 32, wave);
    const f32x4* fn = (const f32x4*)a.in[21] + lane;
    for (int t = gw; t < T; t += NGW) {
        RowRegs r = row_load(a.out + (size_t)t * D, lane); combine_row(r, a.ws, tab, t, lane);
        const float rs = row_rs(r);
        f32x4* o = (f32x4*)(a.out + (size_t)t * D) + lane;
#pragma unroll
        for (int j = 0; j < 4; ++j) o[64 * j] = r.v[j] * rs * fn[64 * j];
    }
}

__device__ __forceinline__ void route_phase(const Args& a, LAS unsigned char* lds, int layer, int lane, int wave) {
    bf16_t* XN = (bf16_t*)(a.ws + AB_XN); const float* WR = (const float*)(a.ws + WS_SKINNY) + (layer ? SK_WR1 : SK_WR0);
    int* gcnt = (int*)(a.ws + WS_CTL) + layer * 32; int* LIST = (int*)(a.ws + AB_LIST); i32x4* TOKI = (i32x4*)(a.ws + AB_TOKI); f32x2* TOKG = (f32x2*)(a.ws + AB_TOKG);
    const float* bc = a.in[15] + layer * 4; const float* bfine = a.in[17] + layer * 32;
    LAS int* be = (LAS int*)(lds);
    LAS int* rk = be + 256;
    LAS int* lcnt = rk + 256;
    LAS int* lbase = lcnt + 32;
    LAS float* bg = (LAS float*)(lbase + 32);
    const int tidx = wave * 64 + lane;
    for (int batch = blockIdx.x; batch < T / 128; batch += gridDim.x) {
        if (tidx < 32) lcnt[tidx] = 0;
        for (int i = 0; i < 16; ++i) {
            const int lr = wave * 16 + i, t = batch * 128 + lr;
            const RowRegs r = row_load(a.out + (size_t)t * D, lane); const float rs = row_rs(r);
            row_store_bf16(XN + (size_t)t * D, r, rs, lane);
            float mine = 0.f;
#pragma unroll 2
            for (int n = 0; n < 36; ++n) { const float d = row_dot(r, WR + n * 1024, lane) * rs; if (lane == n) mine = d; }
            const float c0 = __shfl(mine, 0) + bc[0], c1 = __shfl(mine, 1) + bc[1], c2 = __shfl(mine, 2) + bc[2], c3 = __shfl(mine, 3) + bc[3];
            int gi = 0; float cm = c0; if (c1 > cm) { cm = c1; gi = 1; } if (c2 > cm) { cm = c2; gi = 2; } if (c3 > cm) { cm = c3; gi = 3; }
            const float pc = 1.f / (__expf(c0 - cm) + __expf(c1 - cm) + __expf(c2 - cm) + __expf(c3 - cm));
            float f[8];
#pragma unroll
            for (int j = 0; j < 8; ++j) f[j] = __shfl(mine, 4 + gi * 8 + j) + bfine[gi * 8 + j];
            int j0 = 0; float m0 = f[0];
#pragma unroll
            for (int j = 1; j < 8; ++j) if (f[j] > m0) { m0 = f[j]; j0 = j; }
            int j1 = -1; float m1 = -INFINITY;
#pragma unroll
            for (int j = 0; j < 8; ++j) if (j != j0 && f[j] > m1) { m1 = f[j]; j1 = j; }
            const float e1 = __expf(m1 - m0), inv = 1.f / (1.f + e1);
            if (lane == 0) { be[lr * 2] = gi * 8 + j0; be[lr * 2 + 1] = gi * 8 + j1; bg[lr * 2] = pc * inv; bg[lr * 2 + 1] = pc * e1 * inv; }
        }
        __syncthreads();
        if (tidx < 256) rk[tidx] = atomicAdd((int*)&lcnt[be[tidx]], 1);
        __syncthreads();
        if (tidx < 32) lbase[tidx] = lcnt[tidx] ? atomicAdd(&gcnt[tidx], lcnt[tidx]) : 0;
        __syncthreads();
        if (tidx < 256) { const int e = be[tidx], idx = lbase[e] + rk[tidx]; LIST[e * T + idx] = batch * 128 + (tidx >> 1); rk[tidx] = idx; }
        __syncthreads();
        if (tidx < 128) { const int lr = tidx; TOKI[batch * 128 + lr] = (i32x4){be[lr * 2], be[lr * 2 + 1], rk[lr * 2], rk[lr * 2 + 1]}; TOKG[batch * 128 + lr] = (f32x2){bg[lr * 2], bg[lr * 2 + 1]}; }
        __syncthreads();
    }
}

__device__ __forceinline__ void gla_alpha_naive(const Args& a, int wave) {
    const float* AA = (const float*)(a.ws + AB_AA); float* AL = (float*)(a.ws + AB_ALPHA); const float* w2 = a.in[3]; const float* ba = a.in[4];
    for (size_t i = (size_t)blockIdx.x * NTHREADS + TIDX; i < (size_t)T * 512; i += (size_t)gridDim.x * NTHREADS) {
        const int t = (int)(i >> 9), hd = (int)(i & 511); float z = ba[hd];
#pragma unroll
        for (int r = 0; r < 16; ++r) z += AA[(size_t)t * 16 + r] * w2[r * 512 + hd];
        AL[i] = __expf(log_sigmoid(z) * (1.f / 16.f));
    }
}
__device__ __forceinline__ void gla_scan_naive(const Args& a, int gw, int NGW, int lane) {
    const bf16_t* __restrict__ Q = (const bf16_t*)(a.ws + AB_Q); const bf16_t* __restrict__ K = (const bf16_t*)(a.ws + AB_K); bf16_t* V = (bf16_t*)(a.ws + AB_V);
    const float* __restrict__ AL = (const float*)(a.ws + AB_ALPHA); float* SSQ = (float*)(a.ws + AB_SSQ);
    for (int item = gw; item < 256; item += NGW) {
        const int b = item >> 4, h = (item >> 2) & 3, sl = item & 3, e = h * 256 + sl * 64 + lane;
        float St[128];
#pragma unroll
        for (int d = 0; d < 128; ++d) St[d] = 0.f;
        for (int t = 0; t < SEQ; ++t) {
            const size_t row = (size_t)b * SEQ + t;
            const float v = bf2f(V[row * D + e]);
            const u32x4* qp = (const u32x4*)(Q + row * 512 + h * 128); const u32x4* kp = (const u32x4*)(K + row * 512 + h * 128); const f32x4* ap = (const f32x4*)(AL + row * 512 + h * 128);
            float o = 0.f;
#pragma unroll
            for (int c = 0; c < 16; ++c) { const u32x4 qw = qp[c], kw = kp[c]; const f32x4 a0 = ap[2 * c], a1 = ap[2 * c + 1];
                const float qf[8] = {bflo(qw.x), bfhi(qw.x), bflo(qw.y), bfhi(qw.y), bflo(qw.z), bfhi(qw.z), bflo(qw.w), bfhi(qw.w)};
                const float kf[8] = {bflo(kw.x), bfhi(kw.x), bflo(kw.y), bfhi(kw.y), bflo(kw.z), bfhi(kw.z), bflo(kw.w), bfhi(kw.w)};
                const float af[8] = {a0[0], a0[1], a0[2], a0[3], a1[0], a1[1], a1[2], a1[3]};
#pragma unroll
                for (int j = 0; j < 8; ++j) { const int d = c * 8 + j; St[d] = af[j] * St[d] + kf[j] * v; o += qf[j] * St[d]; } }
            V[row * D + e] = (bf16_t)f2bf(o);
            const float ss = wave_sum(o * o);
            if (lane < 2) SSQ[row * 32 + h * 8 + sl * 2 + lane] = lane ? 0.f : ss;
        }
    }
}
__device__ __forceinline__ void gla_post(const Args& a, int wave) {
    bf16_t* V = (bf16_t*)(a.ws + AB_V); const bf16_t* R = (const bf16_t*)(a.ws + AB_R); const float* SSQ = (const float*)(a.ws + AB_SSQ);
    for (size_t i = (size_t)blockIdx.x * NTHREADS + TIDX; i < (size_t)T * 128; i += (size_t)gridDim.x * NTHREADS) {
        const size_t t = i >> 7; const int c8 = (int)(i & 127) * 8, h = c8 >> 8;
        const f32x4 sq = *(const f32x4*)(SSQ + t * 32 + h * 8), sq2 = *(const f32x4*)(SSQ + t * 32 + h * 8 + 4);
        const float rstd = 1.0f / sqrtf((((sq[0] + sq[1]) + (sq[2] + sq[3])) + ((sq2[0] + sq2[1]) + (sq2[2] + sq2[3]))) * (1.f / 256.f) + RMS_EPS);
        const u32x4 ow = *(const u32x4*)(V + t * D + c8), rw = *(const u32x4*)(R + t * D + c8);
        const unsigned oo[4] = {ow.x, ow.y, ow.z, ow.w}, rr[4] = {rw.x, rw.y, rw.z, rw.w}; unsigned res[4];
#pragma unroll
        for (int j = 0; j < 4; ++j) { const float r0 = bflo(rr[j]), r1 = bfhi(rr[j]); res[j] = pk2(bflo(oo[j]) * rstd * r0 * sigmoidf_(r0), bfhi(oo[j]) * rstd * r1 * sigmoidf_(r1)); }
        *(u32x4*)(V + t * D + c8) = (u32x4){res[0], res[1], res[2], res[3]};
    }
}

namespace gla {
typedef short v4i16 __attribute__((ext_vector_type(4)));
typedef float f32x16 __attribute__((ext_vector_type(16)));
constexpr int QP = 136, VP = 72;
constexpr int OFF_Q = 0, OFF_K = 64 * QP * 2, OFF_V = 2 * 64 * QP * 2, OFF_P = OFF_V + 64 * VP * 2, STAGE = OFF_P + 64 * VP * 2;
constexpr int OFF_ST = 2 * STAGE, SZ_ST = 64 * QP * 2, OFF_EL = OFF_ST + 2 * SZ_ST;
static_assert(OFF_EL + 1024 <= LDS_BYTES, "GLA LDS map");
__device__ __forceinline__ int crow(int r, int hi) { return (r & 3) + 8 * (r >> 2) + 4 * hi; }
__device__ __forceinline__ bf16x8 row_frag(const LAS unsigned char* base, int pitchB, int row, int s, int hi) { return *(const LAS bf16x8*)(base + row * pitchB + (16 * s + 8 * hi) * 2); }
__device__ __forceinline__ bf16x8 tr_frag(const LAS unsigned char* base, int pitchB, int s, int col0, int lane) {
    const int hi = lane >> 5, q4 = (lane >> 2) & 3, p4 = lane & 3, cb = (col0 + 16 * ((lane >> 4) & 1) + 4 * p4) * 2;
    const LAS unsigned char* p0 = base + (16 * s + 8 * hi + q4) * pitchB + cb;
    const v4i16 lo = __builtin_amdgcn_ds_read_tr16_b64_v4i16((LAS v4i16*)p0);
    const v4i16 hh = __builtin_amdgcn_ds_read_tr16_b64_v4i16((LAS v4i16*)(p0 + 4 * pitchB));
    return (bf16x8){lo[0], lo[1], lo[2], lo[3], hh[0], hh[1], hh[2], hh[3]};
}
__device__ __forceinline__ void prep(const Args& a, LAS unsigned char* lds, int wave) {
    const int lane = lane_now(), tid = wave * 64 + lane, g = wave, dp = lane, r32 = lane & 31, hi = lane >> 5;
    bf16_t* Qb = (bf16_t*)(a.ws + AB_Q); bf16_t* Kb = (bf16_t*)(a.ws + AB_K); bf16_t* PM = (bf16_t*)(a.ws + AB_PM); float* EL = (float*)(a.ws + AB_EL);
    const float* AA = (const float*)(a.ws + AB_AA); const float* w2 = a.in[3]; const float* ba = a.in[4];
    LAS float* As = (LAS float*)lds; LAS float* GT = (LAS float*)(lds + 4096); LAS unsigned char* Qs = lds + 8192; LAS unsigned char* Ks = lds + 8192 + 64 * QP * 2;
    for (int item = blockIdx.x; item < 2048; item += gridDim.x) {
        const int bh = item >> 5, c = item & 31, h = bh & 3; const size_t row0 = (size_t)(bh >> 2) * SEQ + c * 64;
        *(LAS f32x2*)(As + tid * 2) = *(const f32x2*)(AA + row0 * 16 + tid * 2);
        f32x2 w[16];
#pragma unroll
        for (int r = 0; r < 16; ++r) w[r] = *(const f32x2*)(w2 + r * 512 + h * 128 + 2 * dp);
        const f32x2 bb = *(const f32x2*)(ba + h * 128 + 2 * dp);
        __syncthreads();
        float c0[8], c1[8]; float cs0 = 0.f, cs1 = 0.f;
#pragma unroll
        for (int ii = 0; ii < 8; ++ii) { const int i = 8 * g + ii; float z0 = bb.x, z1 = bb.y;
#pragma unroll
            for (int r4 = 0; r4 < 4; ++r4) { const f32x4 av = *(const LAS f32x4*)(As + i * 16 + r4 * 4);
#pragma unroll
                for (int j = 0; j < 4; ++j) { z0 += av[j] * w[r4 * 4 + j].x; z1 += av[j] * w[r4 * 4 + j].y; } }
            cs0 += log_sigmoid(z0) * (1.f / 16.f); cs1 += log_sigmoid(z1) * (1.f / 16.f); c0[ii] = cs0; c1[ii] = cs1; }
        *(LAS f32x2*)(GT + g * 128 + 2 * dp) = (f32x2){cs0, cs1};
        __syncthreads();
        float off0 = 0.f, off1 = 0.f, last0 = 0.f, last1 = 0.f;
#pragma unroll
        for (int gg = 0; gg < 8; ++gg) { const f32x2 t = *(const LAS f32x2*)(GT + gg * 128 + 2 * dp); if (gg < g) { off0 += t.x; off1 += t.y; } last0 += t.x; last1 += t.y; }
        if (g == 0) *(f32x2*)(EL + (size_t)item * 128 + 2 * dp) = (f32x2){__expf(last0), __expf(last1)};
#pragma unroll
        for (int ii = 0; ii < 8; ++ii) { const int i = 8 * g + ii; const float m0 = off0 + c0[ii], m1 = off1 + c1[ii];
            unsigned* qp = (unsigned*)(Qb + (row0 + i) * 512 + h * 128 + 2 * dp); unsigned* kp = (unsigned*)(Kb + (row0 + i) * 512 + h * 128 + 2 * dp);
            const unsigned qw = *qp, kw = *kp;
            const unsigned qt = pk2(bflo(qw) * __expf(m0), bfhi(qw) * __expf(m1));
            const unsigned kt = pk2(bflo(kw) * __expf(-m0), bfhi(kw) * __expf(-m1));
            const unsigned kh = pk2(bflo(kw) * __expf(last0 - m0), bfhi(kw) * __expf(last1 - m1));
            *qp = qt; *kp = kh;
            *(LAS unsigned*)(Qs + i * QP * 2 + 4 * dp) = qt; *(LAS unsigned*)(Ks + i * QP * 2 + 4 * dp) = kt; }
        __syncthreads();
        if (wave < 4) {
            const int ti = wave >> 1, tj = wave & 1; f32x16 acc = {};
#pragma unroll
            for (int s = 0; s < 8; ++s) acc = __builtin_amdgcn_mfma_f32_32x32x16_bf16(row_frag(Ks, QP * 2, 32 * tj + r32, s, hi), row_frag(Qs, QP * 2, 32 * ti + r32, s, hi), acc, 0, 0, 0);
            const int i = 32 * ti + r32;
#pragma unroll
            for (int g4 = 0; g4 < 4; ++g4) { const int j0 = 32 * tj + 8 * g4 + 4 * hi; float v[4];
#pragma unroll
                for (int x = 0; x < 4; ++x) v[x] = (j0 + x <= i) ? acc[4 * g4 + x] : 0.f;
                *(u32x2*)(PM + (size_t)item * 4096 + i * 64 + j0) = (u32x2){pk2(v[0], v[1]), pk2(v[2], v[3])}; }
        }
        __syncthreads();
    }
}
__device__ __forceinline__ void scan(const Args& a, LAS unsigned char* lds, int wave) {
    const int lane = lane_now(), tid = wave * 64 + lane, r32 = lane & 31, hi = lane >> 5;
    const bf16_t* Qb = (const bf16_t*)(a.ws + AB_Q); const bf16_t* Kb = (const bf16_t*)(a.ws + AB_K); bf16_t* Vb = (bf16_t*)(a.ws + AB_V);
    const bf16_t* PM = (const bf16_t*)(a.ws + AB_PM); const float* EL = (const float*)(a.ws + AB_EL); float* SSQ = (float*)(a.ws + AB_SSQ);
    const int te = wave & 1, td = wave >> 1, ti = (wave >> 1) & 1;
    for (int item = blockIdx.x; item < 256; item += gridDim.x) {
        const int b = item >> 4, h = (item >> 2) & 3, sl = item & 3, bh = b * 4 + h; const size_t row0 = (size_t)b * SEQ;
        const int qrow0 = tid >> 4, qch = tid & 15, vrow = tid >> 3, vch = tid & 7;
        const bf16_t* gq = Qb + (row0 + qrow0) * 512 + h * 128 + qch * 8; const bf16_t* gk = Kb + (row0 + qrow0) * 512 + h * 128 + qch * 8;
        const bf16_t* gv = Vb + (row0 + vrow) * D + h * 256 + sl * 64 + vch * 8; const bf16_t* gp = PM + (size_t)bh * 32 * 4096 + vrow * 64 + vch * 8;
        const float* ge = EL + (size_t)bh * 32 * 128 + (tid & 31) * 4;
        const int lq = qrow0 * QP * 2 + qch * 16, lv = vrow * VP * 2 + vch * 16;
        u32x4 rq0, rq1, rk0, rk1, rv, rp; f32x4 re;
#define GLA_LOAD(c) do { rq0 = *(const u32x4*)(gq + (size_t)(c) * 64 * 512); rq1 = *(const u32x4*)(gq + (size_t)(c) * 64 * 512 + 32 * 512); rk0 = *(const u32x4*)(gk + (size_t)(c) * 64 * 512); rk1 = *(const u32x4*)(gk + (size_t)(c) * 64 * 512 + 32 * 512); \
        rv = *(const u32x4*)(gv + (size_t)(c) * 64 * D); rp = *(const u32x4*)(gp + (size_t)(c) * 4096); re = *(const f32x4*)(ge + (c) * 128); } while (0)
#define GLA_WRITE(bf) do { LAS unsigned char* sb = lds + (bf) * STAGE; *(LAS u32x4*)(sb + OFF_Q + lq) = rq0; *(LAS u32x4*)(sb + OFF_Q + lq + 32 * QP * 2) = rq1; *(LAS u32x4*)(sb + OFF_K + lq) = rk0; *(LAS u32x4*)(sb + OFF_K + lq + 32 * QP * 2) = rk1; \
        *(LAS u32x4*)(sb + OFF_V + lv) = rv; *(LAS u32x4*)(sb + OFF_P + lv) = rp; if (tid < 32) *(LAS f32x4*)(lds + OFF_EL + (bf) * 512 + tid * 16) = re; } while (0)
        f32x16 Sacc = {};
        for (int i = tid; i < SZ_ST / 16; i += NTHREADS) *(LAS u32x4*)(lds + OFF_ST + i * 16) = (u32x4){0u, 0u, 0u, 0u};
        GLA_LOAD(0); GLA_WRITE(0); GLA_LOAD(1);
        __syncthreads();
        for (int c = 0; c < 32; ++c) {
            const int bf = c & 1; const LAS unsigned char* sb = lds + bf * STAGE; const LAS unsigned char* ST = lds + OFF_ST + bf * SZ_ST;
            bf16x8 vfr[4], kfr[4];
#pragma unroll
            for (int s = 0; s < 4; ++s) { vfr[s] = tr_frag(sb + OFF_V, VP * 2, s, 32 * te, lane); kfr[s] = tr_frag(sb + OFF_K, QP * 2, s, 32 * td, lane); }
            const float elv = *(const LAS float*)(lds + OFF_EL + bf * 512 + (32 * td + r32) * 4);
            if (wave < 4) {
                f32x16 oacc = {};
#pragma unroll
                for (int s = 0; s < 8; ++s) oacc = __builtin_amdgcn_mfma_f32_32x32x16_bf16(row_frag(ST, QP * 2, 32 * te + r32, s, hi), row_frag(sb + OFF_Q, QP * 2, 32 * ti + r32, s, hi), oacc, 0, 0, 0);
#pragma unroll
                for (int s = 0; s < 4; ++s) oacc = __builtin_amdgcn_mfma_f32_32x32x16_bf16(vfr[s], row_frag(sb + OFF_P, VP * 2, 32 * ti + r32, s, hi), oacc, 0, 0, 0);
                const size_t orow = row0 + c * 64 + 32 * ti + r32; float ss = 0.f;
#pragma unroll
                for (int g4 = 0; g4 < 4; ++g4) { const int e0 = 32 * te + 8 * g4 + 4 * hi;
                    *(u32x2*)(Vb + orow * D + h * 256 + sl * 64 + e0) = (u32x2){pk2(oacc[4 * g4], oacc[4 * g4 + 1]), pk2(oacc[4 * g4 + 2], oacc[4 * g4 + 3])};
#pragma unroll
                    for (int x = 0; x < 4; ++x) ss += oacc[4 * g4 + x] * oacc[4 * g4 + x]; }
                ss += __shfl_xor(ss, 32);
                if (hi == 0) SSQ[orow * 32 + h * 8 + sl * 2 + te] = ss;
            }
#pragma unroll
            for (int r = 0; r < 16; ++r) Sacc[r] *= elv;
#pragma unroll
            for (int s = 0; s < 4; ++s) Sacc = __builtin_amdgcn_mfma_f32_32x32x16_bf16(vfr[s], kfr[s], Sacc, 0, 0, 0);
            { LAS unsigned char* STn = lds + OFF_ST + (bf ^ 1) * SZ_ST;
#pragma unroll
              for (int r = 0; r < 16; ++r) *(LAS unsigned short*)(STn + (32 * te + crow(r, hi)) * QP * 2 + (32 * td + r32) * 2) = (unsigned short)f2bf(Sacc[r]); }
            if (c + 1 < 32) GLA_WRITE(bf ^ 1);
            if (c + 2 < 32) GLA_LOAD(c + 2);
            __syncthreads();
        }
#undef GLA_LOAD
#undef GLA_WRITE
    }
}
}

__device__ __forceinline__ void fox_cumsum(const Args& a, int gw, int NGW, int lane) {
    const float* LF = (const float*)(a.ws + AB_LF); float* C = (float*)(a.ws + AB_C);
    for (int item = gw; item < 256; item += NGW) {
        const int b = item >> 4, h = item & 15; float loc[32]; float s = 0.f;
#pragma unroll
        for (int i = 0; i < 32; ++i) { s += LF[((size_t)b * SEQ + lane * 32 + i) * 16 + h]; loc[i] = s; }
        float incl = s;
#pragma unroll
        for (int o = 1; o < 64; o <<= 1) { const float n = __shfl_up(incl, o); if (lane >= o) incl += n; }
        const float excl = incl - s;
#pragma unroll
        for (int i = 0; i < 32; ++i) C[(size_t)item * SEQ + lane * 32 + i] = loc[i] + excl;
    }
}
__device__ __forceinline__ void fox_attn_naive(const Args& a, int gw, int NGW, int lane) {
    bf16_t* Q = (bf16_t*)(a.ws + AB_FQ); const bf16_t* __restrict__ K = (const bf16_t*)(a.ws + AB_FK); const bf16_t* __restrict__ V = (const bf16_t*)(a.ws + AB_FV);
    const bf16_t* __restrict__ OG = (const bf16_t*)(a.ws + AB_FOG); const float* __restrict__ C = (const float*)(a.ws + AB_C);
    for (int item = gw; item < 8192; item += NGW) {
        const int bh = item >> 5, tb = item & 31, b = bh >> 4, h = bh & 15, t = tb * 64 + lane;
        const size_t row = (size_t)b * SEQ + t;
        float q[64], o[64];
#pragma unroll
        for (int c = 0; c < 8; ++c) { const u32x4 w = *(const u32x4*)(Q + row * D + h * 64 + c * 8); q[c * 8 + 0] = bflo(w.x); q[c * 8 + 1] = bfhi(w.x); q[c * 8 + 2] = bflo(w.y); q[c * 8 + 3] = bfhi(w.y); q[c * 8 + 4] = bflo(w.z); q[c * 8 + 5] = bfhi(w.z); q[c * 8 + 6] = bflo(w.w); q[c * 8 + 7] = bfhi(w.w); }
#pragma unroll
        for (int d = 0; d < 64; ++d) o[d] = 0.f;
        float m = -INFINITY, l = 0.f; const float cref = C[(size_t)bh * SEQ + tb * 64 + 63];
        const int smax = tb * 64 + 63;
        for (int s = 0; s <= smax; ++s) {
            const size_t krow = (size_t)b * SEQ + s; float x = 0.f;
#pragma unroll
            for (int c = 0; c < 8; ++c) { const u32x4 w = *(const u32x4*)(K + krow * D + h * 64 + c * 8);
                x += q[c * 8 + 0] * bflo(w.x) + q[c * 8 + 1] * bfhi(w.x) + q[c * 8 + 2] * bflo(w.y) + q[c * 8 + 3] * bfhi(w.y) + q[c * 8 + 4] * bflo(w.z) + q[c * 8 + 5] * bfhi(w.z) + q[c * 8 + 6] * bflo(w.w) + q[c * 8 + 7] * bfhi(w.w); }
            x += (cref - C[(size_t)bh * SEQ + s]) * LOG2E;
            if (s > t) x = -INFINITY;
            const float mn = fmaxf(m, x); const float sc = (mn == -INFINITY) ? 1.f : exp2f(m - mn), p = (mn == -INFINITY) ? 0.f : exp2f(x - mn);
            m = mn; l = l * sc + p;
#pragma unroll
            for (int c = 0; c < 8; ++c) { const u32x4 w = *(const u32x4*)(V + krow * D + h * 64 + c * 8);
                const float vv[8] = {bflo(w.x), bfhi(w.x), bflo(w.y), bfhi(w.y), bflo(w.z), bfhi(w.z), bflo(w.w), bfhi(w.w)};
#pragma unroll
                for (int j = 0; j < 8; ++j) o[c * 8 + j] = o[c * 8 + j] * sc + p * vv[j]; }
        }
        const float il = 1.f / l;
#pragma unroll
        for (int c = 0; c < 8; ++c) { const u32x4 g = *(const u32x4*)(OG + row * D + h * 64 + c * 8); const unsigned gg[4] = {g.x, g.y, g.z, g.w}; unsigned res[4];
#pragma unroll
            for (int j = 0; j < 4; ++j) res[j] = pk2(o[c * 8 + 2 * j] * il * sigmoidf_(bflo(gg[j])), o[c * 8 + 2 * j + 1] * il * sigmoidf_(bfhi(gg[j])));
            *(u32x4*)(Q + row * D + h * 64 + c * 8) = (u32x4){res[0], res[1], res[2], res[3]}; }
    }
}

#include <hip/hip_bf16.h>
#include <cmath>
namespace attn_body {
using bf16=__hip_bfloat16;
using bf16x8=__attribute__((ext_vector_type(8)))short;
using s16x4=__attribute__((ext_vector_type(4)))short;
using f32x16=__attribute__((ext_vector_type(16)))float;
using u32x4=__attribute__((ext_vector_type(4)))unsigned;
constexpr int BATCH=16,NHEAD=16,SEQ=2048,D=64,DM=NHEAD*D;
constexpr int NW=8,QBLK=32,QB=QBLK*NW,KVBLK=64,NQB=SEQ/QB;
constexpr int ATTN_PITCH=DM, ATTN_UNIT_ROWS=QB;
__device__ __forceinline__ int crow(int r,int hi){return (r&3)+8*(r>>2)+4*hi;}
#define SBAR() __builtin_amdgcn_sched_barrier(0)
__device__ __forceinline__ void cmask(f32x16&p0,f32x16&p1,int jb,int qrel,int hi){
  const float NEG=-INFINITY; int kb=64*jb+4*hi;
  #pragma unroll
  for(int r=0;r<16;++r){int kv=kb+(r&3)+8*(r>>2); if(kv>qrel)p0[r]=NEG; if(kv+32>qrel)p1[r]=NEG;}
}

constexpr int NSLOT=3, SLOTB=8192;
constexpr int LDS_CL=90112;
typedef float f32x4a __attribute__((ext_vector_type(4)));
constexpr int LDS_K=0, LDS_V=NSLOT*SLOTB, LDS_WS=2*NSLOT*SLOTB, LDS_OST=LDS_WS+NW*64*4, LDS_BYTES=LDS_OST+NW*4096;
constexpr float C2=0.125f*1.4426950408889634f;
__device__ __forceinline__ void glds16(const void*sbase,unsigned voff,unsigned lds_dst){unsigned keep;
  asm volatile("s_mov_b32 %0, m0\n\ts_mov_b32 m0, %3\n\ts_nop 0\n\tglobal_load_lds_dwordx4 %1, %2\n\ts_mov_b32 m0, %0":"=&s"(keep):"v"(voff),"s"(sbase),"s"(lds_dst):"memory");}
__device__ __forceinline__ float max3f(float a,float b,float c){float r;asm("v_max3_f32 %0, %1, %2, %3":"=v"(r):"v"(a),"v"(b),"v"(c));return r;}
__device__ __forceinline__ float max2f(float a,float b){float r;asm("v_max_f32_e32 %0, %1, %2":"=v"(r):"v"(a),"v"(b));return r;}
__device__ __forceinline__ float fadd_s(float a,float b){float r;asm("v_add_f32_e32 %0, %1, %2":"=v"(r):"v"(a),"v"(b));return r;}
__device__ __forceinline__ float fsub_s(float a,float b){float r;asm("v_sub_f32_e32 %0, %1, %2":"=v"(r):"v"(a),"v"(b));return r;}
typedef float f32x2_t __attribute__((ext_vector_type(2))); typedef __bf16 bf16x2_t __attribute__((ext_vector_type(2)));
__device__ __forceinline__ unsigned cvtpk_s(float lo,float hi){f32x2_t v={lo,hi};bf16x2_t b=__builtin_convertvector(v,bf16x2_t);return __builtin_bit_cast(unsigned,b);}
#define WAIT_BAR(N) asm volatile("s_waitcnt vmcnt(" #N ") lgkmcnt(0)\n\ts_barrier":::"memory")

__device__ __forceinline__ void qkt(f32x16&p0,f32x16&p1,const char*Kslot,const bf16x8*qr,int r32,int hi){
  const char*kb=Kslot+hi*1024+r32*16;
  #pragma unroll
  for(int d0=0;d0<4;++d0){
    const bf16x8 b0=*reinterpret_cast<const bf16x8*>(kb+d0*2048);
    const bf16x8 b1=*reinterpret_cast<const bf16x8*>(kb+d0*2048+512);
    p0=__builtin_amdgcn_mfma_f32_32x32x16_bf16(b0,qr[d0],p0,0,0,0);p1=__builtin_amdgcn_mfma_f32_32x32x16_bf16(b1,qr[d0],p1,0,0,0);}
}
typedef __attribute__((address_space(3))) const char* lds_cptr;
typedef short v4i16_t __attribute__((ext_vector_type(4)));
__device__ __forceinline__ void kload8(bf16x8*kf,lds_cptr kp){
  kf[0]=*(const __attribute__((address_space(3))) bf16x8*)(kp);      kf[1]=*(const __attribute__((address_space(3))) bf16x8*)(kp+512);
  kf[2]=*(const __attribute__((address_space(3))) bf16x8*)(kp+2048); kf[3]=*(const __attribute__((address_space(3))) bf16x8*)(kp+2560);
  kf[4]=*(const __attribute__((address_space(3))) bf16x8*)(kp+4096); kf[5]=*(const __attribute__((address_space(3))) bf16x8*)(kp+4608);
  kf[6]=*(const __attribute__((address_space(3))) bf16x8*)(kp+6144); kf[7]=*(const __attribute__((address_space(3))) bf16x8*)(kp+6656);
}
__device__ __forceinline__ void kload2(bf16x8*kf,lds_cptr kp,int j){ kf[2*j]=*(const __attribute__((address_space(3))) bf16x8*)(kp+j*2048); kf[2*j+1]=*(const __attribute__((address_space(3))) bf16x8*)(kp+j*2048+512); }
__device__ __forceinline__ s16x4 vtr(lds_cptr p){ return __builtin_bit_cast(s16x4,__builtin_amdgcn_ds_read_tr16_b64_v4i16((__attribute__((address_space(3))) v4i16_t*)p)); }
__device__ __forceinline__ float rowmax(const f32x16&p0,const f32x16&p1){
  float a=max3f(p0[0],p0[1],p1[0]),b=max3f(p0[2],p0[3],p1[1]);a=max3f(a,p1[2],p1[3]);
  #pragma unroll
  for(int r=4;r<16;r+=4){a=max3f(a,p0[r],p0[r+1]);b=max3f(b,p0[r+2],p0[r+3]);a=max3f(a,p1[r],p1[r+1]);b=max3f(b,p1[r+2],p1[r+3]);}
  const float m=max2f(a,b);
  auto rr=__builtin_amdgcn_permlane32_swap(__float_as_uint(m),__float_as_uint(m),false,false);
  return max2f(__uint_as_float(rr[0]),__uint_as_float(rr[1]));
}
__device__ __forceinline__ void pv(f32x16*o,int vb,bf16x8 pa0,bf16x8 pa1,bf16x8 pa2,bf16x8 pa3){
  #pragma unroll
  for(int d0=0;d0<2;++d0){s16x4 lo[4],hi[4];
    #pragma unroll
    for(int ks=0;ks<4;++ks){
      asm volatile("ds_read_b64_tr_b16 %0,%1 offset:%c2":"=&v"(lo[ks]):"v"(vb),"i"(d0*4096+ks*1024):"memory");
      asm volatile("ds_read_b64_tr_b16 %0,%1 offset:%c2":"=&v"(hi[ks]):"v"(vb),"i"(d0*4096+ks*1024+512):"memory");}
    asm volatile("s_waitcnt lgkmcnt(0)":::"memory");SBAR();
    #define PK(k) (bf16x8){lo[k][0],lo[k][1],lo[k][2],lo[k][3],hi[k][0],hi[k][1],hi[k][2],hi[k][3]}
    o[d0]=__builtin_amdgcn_mfma_f32_32x32x16_bf16(pa0,PK(0),o[d0],0,0,0);
    o[d0]=__builtin_amdgcn_mfma_f32_32x32x16_bf16(pa1,PK(1),o[d0],0,0,0);
    o[d0]=__builtin_amdgcn_mfma_f32_32x32x16_bf16(pa2,PK(2),o[d0],0,0,0);
    o[d0]=__builtin_amdgcn_mfma_f32_32x32x16_bf16(pa3,PK(3),o[d0],0,0,0);
    #undef PK
  }
}

#ifndef ATTN_STORE16
#define ATTN_STORE16(p,v) (*(u32x4*)(p)=(v))
#endif
template<int THRL> __device__ __forceinline__ void attn_unit(int b,int h,int qb,const bf16*Q,const bf16*__restrict__ K,const bf16*__restrict__ V,const bf16*__restrict__ OG,bf16*O,char*shm,int wave){
  const int lane=lane_now(),r32=lane&31,hi=lane>>5; const int wid=wave;
  const long rowbase=(long)b*SEQ; const int q0=qb*QB;
  const bf16*Qw=Q+(rowbase+q0+wid*QBLK)*DM+h*D;
  const bf16*Kh=K+rowbase*DM+h*D,*Vh=V+rowbase*DM+h*D;
  const unsigned lds0=(unsigned)(uintptr_t)shm;
  float*wsf=(float*)(shm+LDS_WS)+wid*64;
  const unsigned koff=(unsigned)(lane*DM+wid*8)*2u;
  const unsigned voff=(unsigned)((16*(wid&3)+(lane>>2))*DM+(wid>>2)*32+(lane&3)*8)*2u;
  const unsigned kdst=lds0+LDS_K+wid*1024, vdst=lds0+LDS_V+wid*1024;
  #define DMA_K(t,slot) glds16(Kh+(long)(t)*KVBLK*DM,koff,(unsigned)__builtin_amdgcn_readfirstlane(kdst+(slot)))
  #define DMA_V(t,slot) glds16(Vh+(long)(t)*KVBLK*DM,voff,(unsigned)__builtin_amdgcn_readfirstlane(vdst+(slot)))
  const int vb0=(int)(lds0+LDS_V)+((lane>>4)&1)*32+(lane&3)*8+(4*hi+((lane&15)>>2))*64;
  const char*Kbase=shm+LDS_K; bf16x8 kf[8];
  const lds_cptr shm3=(lds_cptr)shm; const lds_cptr kp0=shm3+LDS_K+hi*1024+r32*16; const lds_cptr vp0=shm3+LDS_V+((lane>>4)&1)*32+(lane&3)*8+(4*hi+((lane&15)>>2))*64;
  const int NT=(q0+QB)/KVBLK;
  DMA_K(0,0);DMA_V(0,0);DMA_K(1,SLOTB);
  bf16x8 qr[4]; int rq_=r32; asm volatile("":"+v"(rq_));
  #pragma unroll
  for(int d0=0;d0<4;++d0)qr[d0]=*reinterpret_cast<const bf16x8*>(&Qw[(long)rq_*DM+d0*16+hi*8]);
  float mhat=0.f,l_reg=0.f;f32x16 o[2];o[0]=f32x16{};o[1]=f32x16{};
  #define BIASLD(P0,P1,tt) do{ const __attribute__((address_space(3))) f32x4a*c_=(const __attribute__((address_space(3))) f32x4a*)(shm3+LDS_CL+((tt)*64+4*hi)*4); \
    _Pragma("unroll") for(int g_=0;g_<4;++g_){ const f32x4a a_=c_[2*g_],b_=c_[2*g_+8]; _Pragma("unroll") for(int j_=0;j_<4;++j_){P0[4*g_+j_]=a_[j_];P1[4*g_+j_]=b_[j_];} } }while(0)
  const int qrel=wid*QBLK+r32;
  #define CMASK(P0,P1,t) do{int jb_=(t)-(NT-4); if(jb_>=0)cmask(P0,P1,jb_,qrel,hi);}while(0)
  bool resc=false;
  #define START(P0,P1) do{ const float rm=rowmax(P0,P1); resc=false; \
    { const float dl=rm; mhat=fadd_s(mhat,dl); \
      _Pragma("unroll") for(int r=0;r<16;++r){P0[r]=fsub_s(P0[r],dl);P1[r]=fsub_s(P1[r],dl);} } \
    _Pragma("unroll") for(int r=0;r<16;++r)P0[r]=__builtin_amdgcn_exp2f(P0[r]); }while(0)
  #define RESC() do{ if(resc){ asm volatile("s_waitcnt lgkmcnt(0)":::"memory"); \
      _Pragma("unroll") for(int d_=0;d_<2;++d_) _Pragma("unroll") for(int r=0;r<16;++r)o[d_][r]*=wsf[crow(r,hi)]; } }while(0)
  f32x16 pA0,pA1,pB0,pB1;
  int sl_prev=0,sl_cur=0,sl_next=SLOTB;
  #define ROT() do{sl_prev=sl_cur;sl_cur=sl_next;sl_next=(sl_next==(NSLOT-1)*SLOTB)?0:sl_next+SLOTB;}while(0)
  DMA_K(2,2*SLOTB);
  WAIT_BAR(3);
  BIASLD(pA0,pA1,0); _Pragma("unroll") for(int r=0;r<16;++r){pA0[r]=-pA0[r];pA1[r]=-pA1[r];}
  qkt(pA0,pA1,Kbase,qr,r32,hi);asm volatile("s_nop 15\n\ts_nop 7":"+v"(pA0),"+v"(pA1));CMASK(pA0,pA1,0);
  START(pA0,pA1);
  _Pragma("unroll") for(int r=0;r<16;++r)pA1[r]=__builtin_amdgcn_exp2f(pA1[r]);
  BIASLD(pB0,pB1,1);
  WAIT_BAR(0);
  DMA_K(3,0);DMA_V(1,SLOTB);
  ROT();
  kload8(kf,kp0+sl_cur);
  WAIT_BAR(2);
  s16x4 vlo[8],vhi[8]; u32x4 pw0,pw1,pw2,pw3;
  #define PKW(P,B) cvtpk_s(P[B],P[B+1])
  #define PAF(k) __builtin_bit_cast(bf16x8,pw##k)
  #define VFR(i) (bf16x8){vlo[i][0],vlo[i][1],vlo[i][2],vlo[i][3],vhi[i][0],vhi[i][1],vhi[i][2],vhi[i][3]}
  #define PIN(x) asm volatile("":"+v"(x))
  #define MX3(a,b,c) __builtin_fmaxf(__builtin_fmaxf((a),(b)),(c))
  #define GAPA(MF,A0,A1,A2,A3,W0,W1,PW) do{ MF; sacc+=A0; sacc+=A1; sacc+=A2; sacc+=A3; PIN(sacc); W0; W1; PIN(PW); SBAR(); }while(0)
  #define EX(v) __builtin_amdgcn_exp2f(v)
  #define GAPB(MF,X,B) do{ MF; X[B]=EX(X[B]); X[B+1]=EX(X[B+1]); X[B+2]=EX(X[B+2]); X[B+3]=EX(X[B+3]); PIN(X); SBAR(); }while(0)
  #define VRD(i) do{ vlo[i]=vtr(vp_+(((i)>>2)*4096+((i)&3)*1024)); vhi[i]=vtr(vp_+(((i)>>2)*4096+((i)&3)*1024+512)); }while(0)
  #define KRD(G,j) do{ if(G){ kload2(kf,kp0+sl_next,j); SBAR(); } }while(0)
  #define STEP(C0,C1,P0,P1,t,GK,GV,GL) do{ SBAR(); \
    { const float nm_=-mhat; _Pragma("unroll") for(int r=0;r<16;++r){C0[r]=nm_-C0[r];C1[r]=nm_-C1[r];} } \
    const lds_cptr vp_=vp0+sl_prev; \
    VRD(0); SBAR(); float sacc=(P0[0]+P0[1]); \
    GAPA(C0=__builtin_amdgcn_mfma_f32_32x32x16_bf16(kf[0],qr[0],C0,0,0,0), P0[2],P0[3],P0[4],P0[5],     pw0[0]=PKW(P0,0), pw0[1]=PKW(P0,2), pw0); \
    VRD(4); SBAR(); GAPA(C1=__builtin_amdgcn_mfma_f32_32x32x16_bf16(kf[1],qr[0],C1,0,0,0), P0[6],P0[7],P0[8],P0[9],     pw0[2]=PKW(P0,4), pw0[3]=PKW(P0,6), pw0); \
    VRD(1); SBAR(); GAPA(C0=__builtin_amdgcn_mfma_f32_32x32x16_bf16(kf[2],qr[1],C0,0,0,0),   P0[10],P0[11],P0[12],P0[13], pw1[0]=PKW(P0,8), pw1[1]=PKW(P0,10), pw1); \
    VRD(5); SBAR(); GAPA(C1=__builtin_amdgcn_mfma_f32_32x32x16_bf16(kf[3],qr[1],C1,0,0,0),   P0[14],P0[15],P1[0],P1[1],   pw1[2]=PKW(P0,12),pw1[3]=PKW(P0,14), pw1); \
    VRD(2); SBAR(); GAPA(C0=__builtin_amdgcn_mfma_f32_32x32x16_bf16(kf[4],qr[2],C0,0,0,0),   P1[2],P1[3],P1[4],P1[5],     pw2[0]=PKW(P1,0), pw2[1]=PKW(P1,2), pw2); \
    VRD(6); SBAR(); GAPA(C1=__builtin_amdgcn_mfma_f32_32x32x16_bf16(kf[5],qr[2],C1,0,0,0),   P1[6],P1[7],P1[8],P1[9],     pw2[2]=PKW(P1,4), pw2[3]=PKW(P1,6), pw2); \
    VRD(3); SBAR(); GAPA(C0=__builtin_amdgcn_mfma_f32_32x32x16_bf16(kf[6],qr[3],C0,0,0,0),   P1[10],P1[11],P1[12],P1[13], pw3[0]=PKW(P1,8), pw3[1]=PKW(P1,10), pw3); \
    VRD(7); SBAR(); GAPA(C1=__builtin_amdgcn_mfma_f32_32x32x16_bf16(kf[7],qr[3],C1,0,0,0),   P1[14],P1[15],0.f,0.f,       pw3[2]=PKW(P1,12),pw3[3]=PKW(P1,14), pw3); \
    l_reg+=sacc; \
    if(GK){DMA_K((t)+3,sl_cur);} if(GV){DMA_V((t)+1,sl_next);} \
    CMASK(C0,C1,t); \
    { float a=MX3(C0[0],C0[1],C1[0]),b=MX3(C0[2],C0[3],C1[1]); a=MX3(a,C1[2],C1[3]); \
      _Pragma("unroll") for(int r=4;r<16;r+=4){a=MX3(a,C0[r],C0[r+1]);b=MX3(b,C0[r+2],C0[r+3]);a=MX3(a,C1[r],C1[r+1]);b=MX3(b,C1[r+2],C1[r+3]);} \
      float rm=__builtin_fmaxf(a,b); { auto rr=__builtin_amdgcn_permlane32_swap(__float_as_uint(rm),__float_as_uint(rm),false,false); rm=__builtin_fmaxf(__uint_as_float(rr[0]),__uint_as_float(rr[1])); } \
      resc=false; \
      if(__builtin_expect(__any(rm>(float)THRL),0)){ const float dl=__builtin_fmaxf(rm,0.f); mhat+=dl; \
        _Pragma("unroll") for(int r=0;r<16;++r){C0[r]-=dl;C1[r]-=dl;} \
        const float f=__builtin_amdgcn_exp2f(-dl); l_reg*=f; if(hi==0)wsf[r32]=f; resc=true; } } \
    SBAR(); \
    GAPB(o[0]=__builtin_amdgcn_mfma_f32_32x32x16_bf16(PAF(0),VFR(0),o[0],0,0,0), C0,0); \
    GAPB(o[1]=__builtin_amdgcn_mfma_f32_32x32x16_bf16(PAF(0),VFR(4),o[1],0,0,0), C0,4); \
    KRD(GL,0); GAPB(o[0]=__builtin_amdgcn_mfma_f32_32x32x16_bf16(PAF(1),VFR(1),o[0],0,0,0), C0,8); \
    KRD(GL,1); GAPB(o[1]=__builtin_amdgcn_mfma_f32_32x32x16_bf16(PAF(1),VFR(5),o[1],0,0,0), C0,12); \
    KRD(GL,2); GAPB(o[0]=__builtin_amdgcn_mfma_f32_32x32x16_bf16(PAF(2),VFR(2),o[0],0,0,0), C1,0); \
    KRD(GL,3); GAPB(o[1]=__builtin_amdgcn_mfma_f32_32x32x16_bf16(PAF(2),VFR(6),o[1],0,0,0), C1,4); \
    GAPB(o[0]=__builtin_amdgcn_mfma_f32_32x32x16_bf16(PAF(3),VFR(3),o[0],0,0,0), C1,8); \
    GAPB(o[1]=__builtin_amdgcn_mfma_f32_32x32x16_bf16(PAF(3),VFR(7),o[1],0,0,0), C1,12); \
    }while(0)
  int t=1;
  #undef CMASK
  #define CMASK(P0,P1,t) do{}while(0)
  for(;t+5<NT;t+=2){
    STEP(pB0,pB1,pA0,pA1,t,true,true,true);     BIASLD(pA0,pA1,t+1); WAIT_BAR(2); RESC(); ROT();
    STEP(pA0,pA1,pB0,pB1,t+1,true,true,true);   BIASLD(pB0,pB1,t+2); WAIT_BAR(2); RESC(); ROT();
  }
  #undef CMASK
  #define CMASK(P0,P1,t) do{int jb_=(t)-(NT-4); if(jb_>=0)cmask(P0,P1,jb_,qrel,hi);}while(0)
  #define ENDW(tt) do{ if((tt)+3<NT){WAIT_BAR(2);} else if((tt)+2<NT){WAIT_BAR(1);} else {WAIT_BAR(0);} }while(0)
  for(;t+1<NT;t+=2){
    STEP(pB0,pB1,pA0,pA1,t,(t+3<NT),(t+1<NT),(t+1<NT));       BIASLD(pA0,pA1,t+1); ENDW(t);   RESC(); ROT();
    STEP(pA0,pA1,pB0,pB1,t+1,(t+4<NT),(t+2<NT),(t+2<NT));     BIASLD(pB0,pB1,t+2); ENDW(t+1); RESC(); ROT();
  }
  STEP(pB0,pB1,pA0,pA1,NT-1,false,false,false); RESC();
  { float sacc=pB0[0]+pB0[1]; _Pragma("unroll") for(int r=2;r<16;++r)sacc+=pB0[r]; _Pragma("unroll") for(int r=0;r<16;++r)sacc+=pB1[r]; l_reg+=sacc;
    pw0=(u32x4){PKW(pB0,0),PKW(pB0,2),PKW(pB0,4),PKW(pB0,6)};pw1=(u32x4){PKW(pB0,8),PKW(pB0,10),PKW(pB0,12),PKW(pB0,14)};pw2=(u32x4){PKW(pB1,0),PKW(pB1,2),PKW(pB1,4),PKW(pB1,6)};pw3=(u32x4){PKW(pB1,8),PKW(pB1,10),PKW(pB1,12),PKW(pB1,14)};
    SBAR(); pv(o,vb0+sl_cur,PAF(0),PAF(1),PAF(2),PAF(3)); }
  #undef PKW
  #undef PAF
  #undef VFR
  #undef PIN
  #undef MX3
  #undef GAPA
  #undef GAPB
  #undef EX
  #undef VRD
  #undef KRD
  #undef STEP
  #undef ENDW
  {auto rr=__builtin_amdgcn_permlane32_swap(__float_as_uint(l_reg),__float_as_uint(l_reg),false,false);l_reg=__uint_as_float(rr[0])+__uint_as_float(rr[1]);}
  if(hi==0)wsf[32+r32]=l_reg;asm volatile("s_waitcnt lgkmcnt(0)":::"memory");
  float rli[16];
  #pragma unroll
  for(int r=0;r<16;++r)rli[r]=__builtin_amdgcn_rcpf(wsf[32+crow(r,hi)]);
  bf16*Ow=O+(rowbase+q0+wid*QBLK)*DM+h*D;
  { bf16*stg=(bf16*)(shm+LDS_OST)+wid*2048;
    #pragma unroll
    for(int r=0;r<16;++r){const int orow=crow(r,hi);
      #pragma unroll
      for(int d0=0;d0<2;++d0)stg[orow*64+d0*32+r32]=__float2bfloat16(o[d0][r]*rli[r]);}
    asm volatile("s_waitcnt lgkmcnt(0)":::"memory");
    const bf16*Gw=OG+(rowbase+q0+wid*QBLK)*DM+h*D;
    int ln=lane; asm volatile("":"+v"(ln));
    #pragma unroll
    for(int i=0;i<4;++i){const int row=i*8+(ln>>3),ch=ln&7; u32x4 v=*(const u32x4*)(stg+row*64+ch*8); const u32x4 g=*(const u32x4*)(Gw+(long)row*DM+ch*8);
      #pragma unroll
      for(int j=0;j<4;++j){ const float g0=__uint_as_float(g[j]<<16),g1=__uint_as_float(g[j]&0xffff0000u),v0=__uint_as_float(v[j]<<16),v1=__uint_as_float(v[j]&0xffff0000u);
        v[j]=cvtpk_s(v0*__builtin_amdgcn_rcpf(1.f+__builtin_amdgcn_exp2f(-1.4426950408889634f*g0)),v1*__builtin_amdgcn_rcpf(1.f+__builtin_amdgcn_exp2f(-1.4426950408889634f*g1))); }
      ATTN_STORE16(Ow+(long)row*DM+ch*8,v);} }
  asm volatile("s_waitcnt lgkmcnt(0)\n\ts_barrier":::"memory");
  #undef DMA_K
  #undef DMA_V
  #undef CMASK
  #undef START
  #undef RESC
  #undef ROT
  #undef BIASLD
}
constexpr int ATTN_LDS_BYTES=LDS_BYTES;
template<int THRL=8> __device__ __forceinline__ void attn_phase(char*lds,const bf16*Q,const bf16*K,const bf16*V,const bf16*OG,bf16*O,const float*Ccum,int wave){
  for(int bh=blockIdx.x;bh<BATCH*NHEAD;bh+=gridDim.x){
    { const int tx=TIDX;
      const f32x4a c=*(const f32x4a*)(Ccum+(size_t)bh*SEQ+tx*4)*1.4426950408889634f;
      *(__attribute__((address_space(3))) f32x4a*)((__attribute__((address_space(3))) char*)lds+LDS_CL+tx*16)=c;
      asm volatile("s_waitcnt lgkmcnt(0)\n\ts_barrier":::"memory"); }
    #pragma unroll 1
    for(int qb=NQB-1;qb>=0;--qb) attn_unit<THRL>(bh/NHEAD,bh%NHEAD,qb,Q,K,V,OG,O,lds,wave);
  }
}
#undef SBAR
#undef WAIT_BAR
}

constexpr int NPHASES = 18;
__global__ void __launch_bounds__(NTHREADS, 2) fwd(Args a) {
    extern __shared__ __attribute__((aligned(16))) unsigned char lds_raw[];
    LAS unsigned char* lds = (LAS unsigned char*)lds_raw;
    cg::grid_group grid = cg::this_grid();
    const int wave = __builtin_amdgcn_readfirstlane(threadIdx.x >> 6);
#define lane lane_now()
    const int G = gridDim.x, gw = blockIdx.x * NWAVES + wave, NGW = G * NWAVES;
    unsigned char* ws = a.ws;
    const int lo = a.ph_lo, hi = a.ph_hi;
#ifdef ONLY_PHASE
#define IN(k) ((k) == ONLY_PHASE && lo <= (k) && (k) < hi)
#else
#define IN(k) (lo <= (k) && (k) < hi)
#endif
#define SEAM(k) do { if (IN(k) && IN((k) + 1)) grid.sync(); } while (0)
    if (IN(0)) { p0_weights(a, lds, gw, NGW, lane, wave); } SEAM(0);
    if (IN(1)) { p1_rows(a, gw, NGW, lane); } SEAM(1);
    if (IN(2)) {
        StaticOrder S; S.init(T, 3072, G, blockIdx.x);
        EpiSplitBf16<0> E{ws};
        gemm_phase<EpiSplitBf16<0>, StaticOrder, IdMap, true>(lds, (const bf16_t*)(ws + AB_XN), (const bf16_t*)(ws + WS_WIN), 1024, S, E, IdMap{}, wave);
    } SEAM(2);
#ifdef NAIVE_GLA
    if (IN(3)) { gla_alpha_naive(a, wave); } SEAM(3);
    if (IN(4)) { gla_scan_naive(a, gw, NGW, lane); } SEAM(4);
#else
    if (IN(3)) { gla::prep(a, lds, wave); } SEAM(3);
    if (IN(4)) { gla::scan(a, lds, wave); } SEAM(4);
#endif
    if (IN(5)) { gla_post(a, wave); } SEAM(5);
    if (IN(6)) {
        StaticOrder S; S.init(T, 1024, G, blockIdx.x); EpiResF32 E{a.in[0], a.out};
        gemm_phase<EpiResF32, StaticOrder, IdMap, true>(lds, (const bf16_t*)(ws + AB_V), (const bf16_t*)(ws + WS_WOUT), 1024, S, E, IdMap{}, wave);
    } SEAM(6);
#define MOE_PHASES(layer, pb) \
    if (IN(pb)) { route_phase(a, lds, layer, lane, wave); } SEAM(pb); \
    if (IN(pb + 1)) { \
        const MoeTab tab = moe_tab(lds); moe_tab_build(tab, (const int*)(ws + WS_CTL) + layer * 32, wave); \
        MoeOrder S; S.so.init(tab.tstart[32] * BM, 1024, G, blockIdx.x); S.tab = tab; \
        MoeGather AM{tab, (const int*)(ws + AB_LIST)}; EpiSwiGLU E{(bf16_t*)(ws + AB_HB)}; \
        gemm_phase<EpiSwiGLU, MoeOrder, MoeGather, true>(lds, (const bf16_t*)(ws + AB_XN), (const bf16_t*)(ws + WS_WEUP) + (size_t)layer * 32 * 1024 * 1024, 1024, S, E, AM, wave); \
        __syncthreads(); \
    } SEAM(pb + 1); \
    if (IN(pb + 2)) { \
        const MoeTab tab = moe_tab(lds); moe_tab_build(tab, (const int*)(ws + WS_CTL) + layer * 32, wave); \
        MoeOrder S; S.so.init(tab.tstart[32] * BM, 1024, G, blockIdx.x); S.tab = tab; \
        EpiMoeDown E{(bf16_t*)(ws + AB_YS)}; \
        gemm_phase<EpiMoeDown, MoeOrder, IdMap, true>(lds, (const bf16_t*)(ws + AB_HB), (const bf16_t*)(ws + WS_WEDN) + (size_t)layer * 32 * 1024 * 512, 512, S, E, IdMap{}, wave); \
        __syncthreads(); \
    } SEAM(pb + 2);
    MOE_PHASES(0, 7)
    if (IN(10)) { p10_rows(a, lds, 0, gw, NGW, lane, wave); __syncthreads(); } SEAM(10);
    if (IN(11)) {
        fox_cumsum(a, gw, NGW, lane);
        StaticOrder S; S.init(T, 4096, G, blockIdx.x);
        EpiSplitBf16<1> E{ws};
        gemm_phase<EpiSplitBf16<1>, StaticOrder, IdMap, true>(lds, (const bf16_t*)(ws + AB_XN), (const bf16_t*)(ws + WS_WKVQ), 1024, S, E, IdMap{}, wave);
    } SEAM(11);
    if (IN(12)) {
#ifdef NAIVE_ATTN
        fox_attn_naive(a, gw, NGW, lane);
#else
        attn_body::attn_phase<8>((char*)lds_raw, (const attn_body::bf16*)(ws + AB_FQ), (const attn_body::bf16*)(ws + AB_FK), (const attn_body::bf16*)(ws + AB_FV), (const attn_body::bf16*)(ws + AB_FOG), (attn_body::bf16*)(ws + AB_FQ), (const float*)(ws + AB_C), wave);
#endif
    } SEAM(12);
    if (IN(13)) {
        StaticOrder S; S.init(T, 1024, G, blockIdx.x); EpiResF32 E{a.out, a.out};
        gemm_phase<EpiResF32, StaticOrder, IdMap, true>(lds, (const bf16_t*)(ws + AB_FQ), (const bf16_t*)(ws + WS_WFO), 1024, S, E, IdMap{}, wave);
    } SEAM(13);
    MOE_PHASES(1, 14)
    if (IN(17)) { p17_rows(a, lds, 1, gw, NGW, lane, wave); }
#undef IN
#undef SEAM
#undef lane
}

#ifndef ONE_LAUNCH
#define ONE_LAUNCH 1
#endif
extern "C" void kernel_launch(void* const* d_in, const int* in_sizes, int n_in, void* d_out, int out_size, void* d_ws, size_t ws_size, hipStream_t stream) {
    static int grid = 0;
    if (grid == 0) {
        if (n_in != 22 || out_size != T * D || ws_size < WS_END) { fprintf(stderr, "kernel_launch: unexpected shapes (n_in %d, out %d, ws %zu < %zu)\n", n_in, out_size, ws_size, (size_t)WS_END); grid = -1; return; }
        int dev = 0, cus = 0, per_cu = 0;
        hipGetDevice(&dev); hipDeviceGetAttribute(&cus, hipDeviceAttributeMultiprocessorCount, dev);
        hipFuncSetAttribute((const void*)fwd, hipFuncAttributeMaxDynamicSharedMemorySize, LDS_BYTES);
        hipOccupancyMaxActiveBlocksPerMultiprocessor(&per_cu, (const void*)fwd, NTHREADS, LDS_BYTES);
        if (per_cu < 1) { fprintf(stderr, "kernel_launch: occupancy query says %d blocks per CU\n", per_cu); grid = -1; return; }
        grid = cus;
        fprintf(stderr, "kernel_launch: grid %d (per_cu %d), ws %zu\n", grid, per_cu, ws_size);
    }
    if (grid < 0) return;
    Args a{};
    for (int i = 0; i < 22; ++i) a.in[i] = (const float*)d_in[i];
    a.out = (float*)d_out; a.ws = (unsigned char*)d_ws;
#if ONE_LAUNCH
    a.ph_lo = 0; a.ph_hi = NPHASES;
    void* args[] = {&a};
    hipError_t e = hipLaunchCooperativeKernel((const void*)fwd, dim3(grid), dim3(NTHREADS), args, LDS_BYTES, stream);
    if (e != hipSuccess) fprintf(stderr, "cooperative launch failed: %s\n", hipGetErrorString(e));
#else
    for (int p = 0; p < NPHASES; ++p) {
        a.ph_lo = p; a.ph_hi = p + 1;
        hipLaunchKernelGGL(fwd, dim3(grid), dim3(NTHREADS), LDS_BYTES, stream, a);
    }
#endif
}
```

```cpp
#include <hip/hip_runtime.h>
#include <hip/hip_cooperative_groups.h>
#include <cstdio>
#include <cstdint>
namespace cg = cooperative_groups;
#ifndef PROBE_DUP
#define PROBE_DUP -1
#endif

#define LAS __attribute__((address_space(3)))
typedef unsigned short bf16_t;
typedef short bf16x8 __attribute__((ext_vector_type(8)));
typedef float f32x4 __attribute__((ext_vector_type(4)));
typedef float f32x2 __attribute__((ext_vector_type(2)));
typedef unsigned u32x4 __attribute__((ext_vector_type(4)));
typedef unsigned u32x2 __attribute__((ext_vector_type(2)));
typedef int i32x4 __attribute__((ext_vector_type(4)));

constexpr int T = 32768, D = 1024, NBATCH = 16, SEQ = 2048;
constexpr int NWAVES = 8, NTHREADS = 512;
constexpr float RMS_EPS = 1e-6f;
constexpr float LOG2E = 1.4426950408889634f;
constexpr float ATT_C2 = 0.125f * LOG2E;
constexpr float GLA_QSCALE = 0.08838834764831845f;
constexpr int NEXP = 32;
constexpr int MAXTILES = 288;

constexpr size_t MiB = 1u << 20;
constexpr size_t WS_CTL = 0;
constexpr size_t WS_BAR = 4096;
constexpr size_t WS_SKH = 256 * 1024, WS_SKL = 512 * 1024;
constexpr size_t WS_RS = 768 * 1024;
constexpr size_t WS_WIN = 1 * MiB;
constexpr size_t WS_WOUT = WS_WIN + 6 * MiB;
constexpr size_t WS_WKVQ = WS_WOUT + 2 * MiB;
constexpr size_t WS_WFO = WS_WKVQ + 8 * MiB;
constexpr size_t WS_WEUP = WS_WFO + 2 * MiB;
constexpr size_t WS_WEDN = WS_WEUP + 128 * MiB;
constexpr size_t WS_AB = WS_WEDN + 64 * MiB;
constexpr size_t AB_XN = WS_AB;
constexpr size_t AB_Q = WS_AB + 64 * MiB;
constexpr size_t AB_K = WS_AB + 96 * MiB;
constexpr size_t AB_V = WS_AB + 128 * MiB;
constexpr size_t AB_R = WS_AB + 192 * MiB;
constexpr size_t AB_KHT = WS_AB + 256 * MiB;
constexpr size_t AB_PM = WS_AB + 288 * MiB;
constexpr size_t AB_EL = WS_AB + 304 * MiB;
constexpr size_t AB_AA = WS_AB + 305 * MiB;
constexpr size_t AB_SSQ = WS_AB + 307 * MiB;
constexpr size_t AB_ALPHA = AB_XN;
constexpr size_t AB_HB = WS_AB + 64 * MiB;
constexpr size_t AB_YS = WS_AB + 136 * MiB;
constexpr size_t AB_LIST = WS_AB + 280 * MiB;
constexpr size_t AB_TOKI = WS_AB + 284 * MiB;
constexpr size_t AB_TOKG = WS_AB + 285 * MiB;
constexpr size_t AB_FK = WS_AB + 64 * MiB;
constexpr size_t AB_FV = WS_AB + 128 * MiB;
constexpr size_t AB_FQ = WS_AB + 192 * MiB;
constexpr size_t AB_FOG = WS_AB + 256 * MiB;
constexpr size_t AB_LF = WS_AB + 320 * MiB;
constexpr size_t AB_C = WS_AB + 322 * MiB;
constexpr size_t WS_END = WS_AB + 324 * MiB;

constexpr int SKR_A = 0, SKR_R0 = 16, SKR_R1 = 64, SKR_F = 112;

constexpr int RING_BYTES = 131072;
constexpr int LDS_MISC = RING_BYTES;
constexpr int LDS_BYTES = 147456;

__device__ __forceinline__ unsigned f2bf(float f) { unsigned u = __builtin_bit_cast(unsigned, f); return (u + 0x7fffu + ((u >> 16) & 1u)) >> 16; }
__device__ __forceinline__ unsigned pk2(float lo, float hi) { return f2bf(lo) | (f2bf(hi) << 16); }
__device__ __forceinline__ float bf2f(unsigned h) { return __builtin_bit_cast(float, h << 16); }
__device__ __forceinline__ float bflo(unsigned w) { return __builtin_bit_cast(float, w << 16); }
__device__ __forceinline__ float bfhi(unsigned w) { return __builtin_bit_cast(float, w & 0xffff0000u); }
__device__ __forceinline__ float wave_sum(float v) {
#pragma unroll
    for (int o = 1; o < 64; o <<= 1) v += __shfl_xor(v, o);
    return v;
}
__device__ __forceinline__ float log_sigmoid(float z) { return fminf(z, 0.f) - log1pf(__expf(-fabsf(z))); }
__device__ __forceinline__ float sigmoidf_(float z) { return 1.f / (1.f + __expf(-z)); }
__device__ __forceinline__ int lane_now() { int l; asm volatile("v_mbcnt_lo_u32_b32 %0, -1, 0\n\tv_mbcnt_hi_u32_b32 %0, -1, %0" : "=v"(l)); return l; }
#define TIDX (wave * 64 + lane_now())
__device__ __forceinline__ int perm32(int rho) { const int n = rho >> 4, i = rho & 15; return 8 * (i >> 2) + 4 * n + (i & 3); }

struct Args { const float* in[22]; float* out; unsigned char* ws; };

struct Unit { int pm, pn; };
constexpr int BM = 256, HALF = 128, NXCD = 8, WGM = 8;
struct StaticOrder {
    int nM, nN, nwg, G, c;
    __device__ void init(int M, int N, int G_, int c_) { nM = M / BM; nN = N / BM; nwg = nM * nN; G = G_; c = c_; }
    __device__ bool next(int i, Unit& u) const {
        const long L = (long)i * G + c; if (L >= nwg) return false;
        int wgid = (int)L; { const int q = nwg / NXCD, r = nwg % NXCD, xcd = wgid % NXCD, off = wgid / NXCD; wgid = (xcd < r ? xcd * (q + 1) : r * (q + 1) + (xcd - r) * q) + off; }
        const int nig = WGM * nN, gid = wgid / nig, fm = gid * WGM, gsz = (nM - fm) < WGM ? (nM - fm) : WGM;
        u.pm = fm + ((wgid % nig) % gsz); u.pn = (wgid % nig) / gsz; return true;
    }
};
struct IdMap { __device__ __forceinline__ int row(const Unit& u, int r) const { return u.pm * BM + r; } };

struct MoeTab { LAS int* cnt; LAS int* tstart; LAS int* tile_e; };
__device__ __forceinline__ MoeTab moe_tab(LAS unsigned char* lds) { MoeTab t; t.cnt = (LAS int*)(lds + LDS_MISC); t.tstart = t.cnt + 32; t.tile_e = t.tstart + 64; return t; }
__device__ __forceinline__ void moe_tab_build(const MoeTab& t, const int* gcnt, int wave) {
    const int tidx = TIDX;
    if (tidx == 0) { int s = 0; for (int e = 0; e < NEXP; ++e) { const int c = gcnt[e]; t.cnt[e] = c; t.tstart[e] = s; s += (c + 255) >> 8; } t.tstart[32] = s; }
    __syncthreads();
    const int nt = t.tstart[32];
    for (int p = tidx; p < nt; p += NTHREADS) { int e = 0; for (int j = 1; j < NEXP; ++j) if (t.tstart[j] <= p) e = j; t.tile_e[p] = e; }
    __syncthreads();
}
struct MoeOrder {
    StaticOrder so; MoeTab tab;
    __device__ bool next(int i, Unit& u) const { if (!so.next(i, u)) return false; u.pn += 4 * tab.tile_e[u.pm]; return true; }
};
struct MoeGather {
    MoeTab tab; const int* list;
    __device__ __forceinline__ int row(const Unit& u, int r) const {
        const int e = u.pn >> 2; int idx = (u.pm - tab.tstart[e]) * BM + r; const int c = tab.cnt[e]; idx = idx < c ? idx : c - 1; return list[e * T + idx];
    }
};

template <int WHICH> struct EpiSplitBf16 {
    static constexpr bool PERM = true;
    unsigned char* ws; const float* rs;
    __device__ __forceinline__ void operator()(const f32x4 (&acc)[2][2][4][2], const Unit& u, int wr, int wc, int fr, int fq) const {
        size_t off; int ldc, f0;
        if (WHICH == 0) { if (u.pn < 2) { off = AB_Q; ldc = 512; f0 = 0; } else if (u.pn < 4) { off = AB_K; ldc = 512; f0 = 2; } else if (u.pn < 8) { off = AB_V; ldc = 1024; f0 = 4; } else { off = AB_R; ldc = 1024; f0 = 8; } }
        else { off = AB_FK + (size_t)(u.pn >> 2) * (64 * MiB); ldc = 1024; f0 = u.pn & ~3; }
        bf16_t* base = (bf16_t*)(ws + off);
        const int row0 = u.pm * BM + wr * 64 + fr, col0 = (u.pn - f0) * BM + wc * 32 + 8 * fq;
#pragma unroll
        for (int ai = 0; ai < 2; ++ai)
#pragma unroll
            for (int m = 0; m < 4; ++m) { bf16_t* rowp = base + (size_t)(row0 + ai * HALF + m * 16) * ldc + col0; const float r = rs[row0 + ai * HALF + m * 16];
#pragma unroll
                for (int bj = 0; bj < 2; ++bj) { const f32x4 v0 = acc[ai][bj][m][0] * r, v1 = acc[ai][bj][m][1] * r;
                    u32x4 w; w.x = pk2(v0[0], v0[1]); w.y = pk2(v0[2], v0[3]); w.z = pk2(v1[0], v1[1]); w.w = pk2(v1[2], v1[3]);
                    *(u32x4*)(rowp + bj * HALF) = w; } }
    }
};
struct EpiResF32 {
    static constexpr bool PERM = false;
    const float* base; float* out;
    __device__ __forceinline__ void operator()(const f32x4 (&acc)[2][2][4][2], const Unit& u, int wr, int wc, int fr, int fq) const {
        const int row0 = u.pm * BM + wr * 64 + fr, col0 = u.pn * BM + wc * 32 + 4 * fq;
#pragma unroll
        for (int ai = 0; ai < 2; ++ai)
#pragma unroll
            for (int m = 0; m < 4; ++m) { const size_t off = (size_t)(row0 + ai * HALF + m * 16) * D + col0;
#pragma unroll
                for (int bj = 0; bj < 2; ++bj)
#pragma unroll
                    for (int n = 0; n < 2; ++n) { const f32x4 b = *(const f32x4*)(base + off + bj * HALF + n * 16); *(f32x4*)(out + off + bj * HALF + n * 16) = b + acc[ai][bj][m][n]; } }
    }
};
struct EpiSwiGLU {
    static constexpr bool PERM = true;
    bf16_t* hb; MoeGather am; const float* rs;
    __device__ __forceinline__ void operator()(const f32x4 (&acc)[2][2][4][2], const Unit& u, int wr, int wc, int fr, int fq) const {
        const int row0 = u.pm * BM + wr * 64 + fr, col0 = (u.pn & 3) * 128 + wc * 32 + 8 * fq;
#pragma unroll
        for (int ai = 0; ai < 2; ++ai)
#pragma unroll
            for (int m = 0; m < 4; ++m) { float h[8]; const float r = rs[am.row(u, ai * HALF + wr * 64 + m * 16 + fr)];
#pragma unroll
                for (int n = 0; n < 2; ++n)
#pragma unroll
                    for (int j = 0; j < 4; ++j) { const float g = acc[ai][0][m][n][j] * r, up = acc[ai][1][m][n][j] * r; h[n * 4 + j] = g * sigmoidf_(g) * up; }
                u32x4 w; w.x = pk2(h[0], h[1]); w.y = pk2(h[2], h[3]); w.z = pk2(h[4], h[5]); w.w = pk2(h[6], h[7]);
                *(u32x4*)(hb + (size_t)(row0 + ai * HALF + m * 16) * 512 + col0) = w; }
    }
};
struct EpiMoeDown {
    static constexpr bool PERM = true;
    bf16_t* ys;
    __device__ __forceinline__ void operator()(const f32x4 (&acc)[2][2][4][2], const Unit& u, int wr, int wc, int fr, int fq) const {
        const int row0 = u.pm * BM + wr * 64 + fr, col0 = (u.pn & 3) * BM + wc * 32 + 8 * fq;
#pragma unroll
        for (int ai = 0; ai < 2; ++ai)
#pragma unroll
            for (int m = 0; m < 4; ++m) { bf16_t* rowp = ys + (size_t)(row0 + ai * HALF + m * 16) * D + col0;
#pragma unroll
                for (int bj = 0; bj < 2; ++bj) { const f32x4 v0 = acc[ai][bj][m][0], v1 = acc[ai][bj][m][1];
                    u32x4 w; w.x = pk2(v0[0], v0[1]); w.y = pk2(v0[2], v0[3]); w.z = pk2(v1[0], v1[1]); w.w = pk2(v1[2], v1[3]);
                    *(u32x4*)(rowp + bj * HALF) = w; } }
    }
};

template <class Epi, class Sched, class AMap>
__device__ __forceinline__ void gemm_direct(const bf16_t* __restrict__ A, const bf16_t* __restrict__ Bt, int K, const Sched& S, const Epi& E, const AMap& AM, int wave) {
    const int wid = wave, lane = lane_now(), tid = wid * 64 + lane, wr = wid >> 2, wc = wid & 3, fr = lane & 15, fq = lane >> 4;
    Unit u;
    for (int i = 0; S.next(i, u); ++i) {
        f32x4 acc[2][2][4][2];
#pragma unroll
        for (int a = 0; a < 2; ++a)
#pragma unroll
            for (int b = 0; b < 2; ++b)
#pragma unroll
                for (int m = 0; m < 4; ++m)
#pragma unroll
                    for (int n = 0; n < 2; ++n) acc[a][b][m][n] = (f32x4){0.f, 0.f, 0.f, 0.f};
        const bf16_t* ap[2][4]; const bf16_t* bp[2][2];
#pragma unroll
        for (int ai = 0; ai < 2; ++ai)
#pragma unroll
            for (int m = 0; m < 4; ++m) ap[ai][m] = A + (size_t)AM.row(u, ai * HALF + wr * 64 + m * 16 + fr) * K + 8 * fq;
#pragma unroll
        for (int bj = 0; bj < 2; ++bj)
#pragma unroll
            for (int n = 0; n < 2; ++n) { const int rho = 16 * n + fr, rr = Epi::PERM ? perm32(rho) : rho; bp[bj][n] = Bt + (size_t)(u.pn * BM + bj * HALF + wc * 32 + rr) * K + 8 * fq; }
        for (int k0 = 0; k0 < K; k0 += 32) {
            bf16x8 af[2][4], bfr[2][2];
#pragma unroll
            for (int ai = 0; ai < 2; ++ai)
#pragma unroll
                for (int m = 0; m < 4; ++m) af[ai][m] = *(const bf16x8*)(ap[ai][m] + k0);
#pragma unroll
            for (int bj = 0; bj < 2; ++bj)
#pragma unroll
                for (int n = 0; n < 2; ++n) bfr[bj][n] = *(const bf16x8*)(bp[bj][n] + k0);
#pragma unroll
            for (int ai = 0; ai < 2; ++ai)
#pragma unroll
                for (int bj = 0; bj < 2; ++bj)
#pragma unroll
                    for (int m = 0; m < 4; ++m)
#pragma unroll
                        for (int n = 0; n < 2; ++n) acc[ai][bj][m][n] = __builtin_amdgcn_mfma_f32_16x16x32_bf16(bfr[bj][n], af[ai][m], acc[ai][bj][m][n], 0, 0, 0);
        }
        E(acc, u, wr, wc, fr, fq);
    }
}

constexpr int BK = 64, HTB = HALF * BK * 2;
__device__ __forceinline__ int lds_byte(int r, int c) { const int st = (r >> 4) * 2 + (c >> 5), rr = r & 15, cc = c & 31, ob = rr * 64 + cc * 2; return st * 1024 + (ob ^ (((ob >> 9) & 1) << 5)); }
__device__ __forceinline__ void stage_rc(int b, int& R, int& C) { const int st = b / 1024, sb = b % 1024, swz = sb ^ (((sb >> 9) & 1) << 5); R = (st >> 1) * 16 + swz / 64; C = (st & 1) * 32 + (swz % 64) / 2; }
template <class Epi, class Sched, class AMap, bool ALIGN_EPI>
__device__ __forceinline__ void gemm_phase(LAS unsigned char* lds, const bf16_t* A, const bf16_t* Bt, const int K, const Sched& S, const Epi& E, const AMap& AM, int wave) {
    const int wid = wave, lane = lane_now(), tid = wid * 64 + lane, wr = wid >> 2, wc = wid & 3, fr = lane & 15, fq = lane >> 4;
    const int nt = K / BK;
    int RA[2], CA[2]; unsigned voffB[2];
#pragma unroll
    for (int i = 0; i < 2; ++i) { int R, C; stage_rc(tid * 16 + i * 8192, R, C); const int Rb = Epi::PERM ? ((R & ~31) + perm32(R & 31)) : R; RA[i] = R; CA[i] = C; voffB[i] = (unsigned)(Rb * K + C) * 2u; }
    const size_t kstep = (size_t)(BK * 2);
    const size_t hstep = (size_t)HALF * K * 2;
    const size_t tstep = 2 * hstep;
    const unsigned ldsw = (unsigned)wid * 1024u;
    const int aoff = lds_byte(wr * 64 + fr, fq * 8), boff = lds_byte(wc * 32 + fr, fq * 8);
#define PG8_SA(b, h) (((b) * 2 + (h)) * HTB)
#define PG8_SB(b, h) ((4 + (b) * 2 + (h)) * HTB)
#define PG8_STAGE(bufoff, gbase, voff) do { _Pragma("unroll") for (int _i = 0; _i < 2; ++_i) \
        __builtin_amdgcn_global_load_lds((const unsigned*)((const char*)(gbase) + (voff)[_i]), (LAS unsigned*)(lds + (bufoff) + ldsw + _i * 8192), 16, 0, 0); } while (0)
#define PG8_LDA(dst, b, h) do { _Pragma("unroll") for (int m = 0; m < 4; ++m) _Pragma("unroll") for (int k = 0; k < 2; ++k) dst[m][k] = *(const LAS bf16x8*)(lds + PG8_SA(b, h) + aoff + m * 2048 + k * 1024); } while (0)
#define PG8_LDB(dst, b, h) do { _Pragma("unroll") for (int n = 0; n < 2; ++n) _Pragma("unroll") for (int k = 0; k < 2; ++k) dst[n][k] = *(const LAS bf16x8*)(lds + PG8_SB(b, h) + boff + n * 2048 + k * 1024); } while (0)
#define PG8_MMA(ai, bj, At, Bt_) do { __builtin_amdgcn_s_setprio(1); _Pragma("unroll") for (int m = 0; m < 4; ++m) _Pragma("unroll") for (int n = 0; n < 2; ++n) _Pragma("unroll") for (int k = 0; k < 2; ++k) \
        acc[ai][bj][m][n] = __builtin_amdgcn_mfma_f32_16x16x32_bf16(Bt_[n][k], At[m][k], acc[ai][bj][m][n], 0, 0, 0); __builtin_amdgcn_s_setprio(0); } while (0)
#define PG8_WAIT_V(n) asm volatile("s_waitcnt vmcnt(" #n ")" ::: "memory")
#define PG8_WAIT_L(n) asm volatile("s_waitcnt lgkmcnt(" #n ")" ::: "memory")
#define PG8_BAR __builtin_amdgcn_s_barrier()
#define PG8_SCHED __builtin_amdgcn_sched_barrier(0)
#define PG8_OFFS(dst, u) do { _Pragma("unroll") for (int h = 0; h < 2; ++h) _Pragma("unroll") for (int i = 0; i < 2; ++i) dst[h][i] = (unsigned)(((size_t)AM.row(u, h * HALF + RA[i]) * K + CA[i]) * 2); } while (0)
    Unit cur, nxt; int ui = 0;
    if (!S.next(0, cur)) return;
    f32x4 acc[2][2][4][2];
#pragma unroll
    for (int a = 0; a < 2; ++a)
#pragma unroll
        for (int b = 0; b < 2; ++b)
#pragma unroll
            for (int m = 0; m < 4; ++m)
#pragma unroll
                for (int n = 0; n < 2; ++n) acc[a][b][m][n] = (f32x4){0.f, 0.f, 0.f, 0.f};
    bf16x8 At[4][2], B0[2][2], B1[2][2];
    unsigned oc[2][2], on[2][2];
    PG8_OFFS(oc, cur);
    const char* const Ab = (const char*)A;
    const char* cB = (const char*)Bt + (size_t)cur.pn * tstep;
    PG8_STAGE(PG8_SB(0, 0), cB, voffB); PG8_STAGE(PG8_SB(0, 1), cB + hstep, voffB); PG8_STAGE(PG8_SA(0, 0), Ab, oc[0]); PG8_STAGE(PG8_SA(0, 1), Ab, oc[1]);
    if (wr == 1) PG8_BAR;
    PG8_WAIT_V(2); PG8_BAR;
    PG8_STAGE(PG8_SB(1, 0), cB + kstep, voffB); PG8_STAGE(PG8_SA(1, 0), Ab + kstep, oc[0]); PG8_STAGE(PG8_SB(1, 1), cB + hstep + kstep, voffB);
    PG8_WAIT_V(6); PG8_BAR;
    for (;;) {
        const bool has_next = S.next(ui + 1, nxt);
        const char* nB = cB;
        if (has_next) { PG8_OFFS(on, nxt); nB = (const char*)Bt + (size_t)nxt.pn * tstep; }
        else {
#pragma unroll
            for (int h = 0; h < 2; ++h)
#pragma unroll
                for (int i = 0; i < 2; ++i) on[h][i] = oc[h][i]; }
        for (int t = 0; t < nt; t += 2) {
            const bool last = (t == nt - 2);
            const char* a1 = Ab + (size_t)(t + 1) * kstep;
            const char* a2 = last ? Ab : Ab + (size_t)(t + 2) * kstep; const char* b2 = last ? nB : cB + (size_t)(t + 2) * kstep;
            const char* a3 = a2 + kstep; const char* b3 = b2 + kstep;
            unsigned o2[2][2];
#pragma unroll
            for (int h = 0; h < 2; ++h)
#pragma unroll
                for (int i = 0; i < 2; ++i) o2[h][i] = last ? on[h][i] : oc[h][i];
            PG8_LDB(B0, 0, 0); PG8_LDB(B1, 0, 1); PG8_SCHED; PG8_LDA(At, 0, 0); PG8_STAGE(PG8_SA(1, 1), a1, oc[1]);
            PG8_WAIT_V(8); PG8_WAIT_L(0); PG8_BAR; PG8_MMA(0, 0, At, B0); PG8_MMA(0, 1, At, B1); PG8_BAR; PG8_SCHED;
            PG8_LDA(At, 0, 1); PG8_STAGE(PG8_SB(0, 0), b2, voffB); PG8_STAGE(PG8_SB(0, 1), b2 + hstep, voffB); PG8_STAGE(PG8_SA(0, 0), a2, o2[0]);
            PG8_WAIT_V(8); PG8_WAIT_L(0); PG8_BAR; PG8_MMA(1, 0, At, B0); PG8_MMA(1, 1, At, B1); PG8_BAR; PG8_SCHED;
            PG8_LDB(B0, 1, 0); PG8_LDB(B1, 1, 1); PG8_SCHED; PG8_LDA(At, 1, 0); PG8_STAGE(PG8_SA(0, 1), a2, o2[1]);
            PG8_WAIT_V(8); PG8_WAIT_L(0); PG8_BAR; PG8_MMA(0, 0, At, B0); PG8_MMA(0, 1, At, B1); PG8_BAR; PG8_SCHED;
            PG8_LDA(At, 1, 1); PG8_STAGE(PG8_SB(1, 0), b3, voffB); PG8_STAGE(PG8_SB(1, 1), b3 + hstep, voffB); PG8_STAGE(PG8_SA(1, 0), a3, o2[0]);
            PG8_WAIT_V(8); PG8_WAIT_L(0); PG8_BAR; PG8_MMA(1, 0, At, B0); PG8_MMA(1, 1, At, B1); PG8_BAR; PG8_SCHED;
        }
        if constexpr (ALIGN_EPI) { if (wr == 0) PG8_BAR; }
        E(acc, cur, wr, wc, fr, fq);
        if (!has_next) break;
#pragma unroll
        for (int a = 0; a < 2; ++a)
#pragma unroll
            for (int b = 0; b < 2; ++b)
#pragma unroll
                for (int m = 0; m < 4; ++m)
#pragma unroll
                    for (int n = 0; n < 2; ++n) acc[a][b][m][n] = (f32x4){0.f, 0.f, 0.f, 0.f};
        cur = nxt; cB = nB; ++ui;
#pragma unroll
        for (int h = 0; h < 2; ++h)
#pragma unroll
            for (int i = 0; i < 2; ++i) oc[h][i] = on[h][i];
        if constexpr (ALIGN_EPI) { if (wr == 1) PG8_BAR; }
    }
    PG8_WAIT_V(0);
    if constexpr (!ALIGN_EPI) { if (wr == 0) PG8_BAR; }
    PG8_BAR;
#undef PG8_SA
#undef PG8_SB
#undef PG8_STAGE
#undef PG8_LDA
#undef PG8_LDB
#undef PG8_MMA
#undef PG8_WAIT_V
#undef PG8_WAIT_L
#undef PG8_BAR
#undef PG8_SCHED
#undef PG8_OFFS
}

__device__ __forceinline__ void tr_item(const float* __restrict__ W, int ldw, int k0, const float* __restrict__ gain, float scale, bf16_t* dst  , int Kd, LAS float* scr, int lane) {
#pragma unroll 8
    for (int i = 0; i < 32; ++i) { const int kk = 2 * i + (lane >> 5); float v = W[(size_t)(k0 + kk) * ldw + (lane & 31)]; const float g = gain ? gain[k0 + kk] : 1.f; scr[kk * 33 + (lane & 31)] = v * g * scale; }
    asm volatile("s_waitcnt lgkmcnt(0)" ::: "memory");
    const int c = lane & 7;
#pragma unroll
    for (int j = 0; j < 4; ++j) { const int n = (lane >> 3) + 8 * j; const LAS float* s = scr + (8 * c) * 33 + n;
        u32x4 o; o.x = pk2(s[0 * 33], s[1 * 33]); o.y = pk2(s[2 * 33], s[3 * 33]); o.z = pk2(s[4 * 33], s[5 * 33]); o.w = pk2(s[6 * 33], s[7 * 33]);
        *(u32x4*)(dst + (size_t)n * Kd + k0 + 8 * c) = o; }
    asm volatile("s_waitcnt lgkmcnt(0)" ::: "memory");
}
__device__ __forceinline__ void p0_weights(const Args& a, LAS unsigned char* lds, int gw, int NGW, int lane, int wave) {
    LAS float* scr = (LAS float*)(lds + wave * 16384);
    unsigned char* ws = a.ws;
    bf16_t* WIN = (bf16_t*)(ws + WS_WIN); bf16_t* WOUT = (bf16_t*)(ws + WS_WOUT); bf16_t* WKVQ = (bf16_t*)(ws + WS_WKVQ); bf16_t* WFO = (bf16_t*)(ws + WS_WFO);
    bf16_t* WEUP = (bf16_t*)(ws + WS_WEUP); bf16_t* WEDN = (bf16_t*)(ws + WS_WEDN);
    constexpr int I_IN = 16 * 96, I_OUT = 16 * 32, I_KV = 16 * 64, I_FQ = 16 * 32, I_FOG = 16 * 32, I_FO = 16 * 32;
    constexpr int I_SMALL = I_IN + I_OUT + I_KV + I_FQ + I_FOG + I_FO;
    constexpr int I_EG = 16 * 16, I_ED = 8 * 32;
    constexpr int I_EXP = 2 * I_EG + I_ED;
    constexpr int NITEMS = I_SMALL + 2 * NEXP * I_EXP;
    for (int it = gw; it < NITEMS; it += NGW) {
        int r = it;
        if (r < I_IN) { const int kb = r / 96, nb = r % 96; const int n0 = nb * 32; tr_item(a.in[2] + n0, 3088, kb * 64, a.in[1], n0 < 512 ? GLA_QSCALE : 1.f, WIN + (size_t)n0 * 1024, 1024, scr, lane); continue; } r -= I_IN;
        if (r < I_OUT) { const int kb = r / 32, n0 = (r % 32) * 32; tr_item(a.in[6] + n0, 1024, kb * 64, a.in[5], 1.f, WOUT + (size_t)n0 * 1024, 1024, scr, lane); continue; } r -= I_OUT;
        if (r < I_KV) { const int kb = r / 64, n0 = (r % 64) * 32; tr_item(a.in[8] + n0, 2064, kb * 64, a.in[7], 1.f, WKVQ + (size_t)n0 * 1024, 1024, scr, lane); continue; } r -= I_KV;
        if (r < I_FQ) { const int kb = r / 32, n0 = (r % 32) * 32; tr_item(a.in[11] + n0, 2048, kb * 64, a.in[10], ATT_C2, WKVQ + (size_t)(2048 + n0) * 1024, 1024, scr, lane); continue; } r -= I_FQ;
        if (r < I_FOG) { const int kb = r / 32, n0 = (r % 32) * 32; tr_item(a.in[11] + 1024 + n0, 2048, kb * 64, a.in[10], 1.f, WKVQ + (size_t)(3072 + n0) * 1024, 1024, scr, lane); continue; } r -= I_FOG;
        if (r < I_FO) { const int kb = r / 32, n0 = (r % 32) * 32; tr_item(a.in[12] + n0, 1024, kb * 64, nullptr, 1.f, WFO + (size_t)n0 * 1024, 1024, scr, lane); continue; } r -= I_FO;
        const int le = r / I_EXP, l = le / NEXP; int q = r % I_EXP;
        const float* gain = a.in[13] + l * 1024;
        if (q < 2 * I_EG) { const int up = q >= I_EG; if (up) q -= I_EG; const int kb = q / 16, n0 = (q % 16) * 32;
            const float* W = (up ? a.in[19] : a.in[18]) + (size_t)le * 1024 * 512 + n0;
            bf16_t* dst = WEUP + ((size_t)le * 1024 + (n0 >> 7) * 256 + up * 128 + (n0 & 127)) * 1024;
            tr_item(W, 512, kb * 64, gain, 1.f, dst, 1024, scr, lane); continue; }
        q -= 2 * I_EG;
        { const int kb = q / 32, n0 = (q % 32) * 32; tr_item(a.in[20] + (size_t)le * 512 * 1024 + n0, 1024, kb * 64, nullptr, 1.f, WEDN + ((size_t)le * 1024 + n0) * 512, 512, scr, lane); }
    }
    bf16_t* SKH = (bf16_t*)(ws + WS_SKH); bf16_t* SKL = (bf16_t*)(ws + WS_SKL);
    const int gt = gw * 64 + lane, NGT = NGW * 64;
    for (int i = gt; i < 128 * 1024; i += NGT) {
        const int n = i >> 10, kk = i & 1023; float v = 0.f;
        if (n < 16) v = a.in[1][kk] * a.in[2][(size_t)kk * 3088 + 3072 + n];
        else if (n < 112) { const int l = (n - 16) / 48, m = (n - 16) % 48; const float g = a.in[13][l * 1024 + kk];
            if (m < 32) v = g * a.in[16][l * 32768 + kk * 32 + m]; else if (m < 36) v = g * a.in[14][l * 4096 + kk * 4 + (m - 32)]; }
        else v = a.in[7][kk] * a.in[8][(size_t)kk * 2064 + 2048 + (n - 112)];
        const unsigned hi = f2bf(v), lo = f2bf(v - bf2f(hi)); SKH[i] = (bf16_t)hi; SKL[i] = (bf16_t)lo;
    }
    if (blockIdx.x == 0) { if (wave == 0) ((int*)(ws + WS_CTL))[lane] = 0;
        for (int i = wave * 64 + lane; i < 3456; i += NTHREADS) ((unsigned*)(ws + WS_BAR))[i] = 0u; }
}

struct RowRegs { f32x4 v[4]; };
__device__ __forceinline__ RowRegs row_load(const float* p, int lane) { RowRegs r; const f32x4* q = (const f32x4*)p + lane;
#pragma unroll
    for (int j = 0; j < 4; ++j) r.v[j] = q[64 * j];
    return r; }
__device__ __forceinline__ float row_rs(const RowRegs& r) { float s = 0.f;
#pragma unroll
    for (int j = 0; j < 4; ++j) s += (r.v[j][0] * r.v[j][0] + r.v[j][1] * r.v[j][1]) + (r.v[j][2] * r.v[j][2] + r.v[j][3] * r.v[j][3]);
    return 1.0f / sqrtf(wave_sum(s) * (1.0f / 1024.0f) + RMS_EPS); }
__device__ __forceinline__ void row_store_bf16(bf16_t* p, const RowRegs& r, float rs, int lane) { u32x2* o = (u32x2*)p + lane;
#pragma unroll
    for (int j = 0; j < 4; ++j) { u32x2 w; w.x = pk2(r.v[j][0] * rs, r.v[j][1] * rs); w.y = pk2(r.v[j][2] * rs, r.v[j][3] * rs); o[64 * j] = w; } }
__device__ __forceinline__ float row_dot(const RowRegs& r, const float* w, int lane) { const f32x4* q = (const f32x4*)w + lane; float s = 0.f;
#pragma unroll
    for (int j = 0; j < 4; ++j) { const f32x4 x = q[64 * j]; s += (r.v[j][0] * x[0] + r.v[j][1] * x[1]) + (r.v[j][2] * x[2] + r.v[j][3] * x[3]); }
    return wave_sum(s); }
__device__ __forceinline__ void row_add_bf16(RowRegs& r, const bf16_t* p, float g, int lane) { const u32x2* q = (const u32x2*)p + lane;
#pragma unroll
    for (int j = 0; j < 4; ++j) { const u32x2 w = q[64 * j]; r.v[j][0] += g * bflo(w.x); r.v[j][1] += g * bfhi(w.x); r.v[j][2] += g * bflo(w.y); r.v[j][3] += g * bfhi(w.y); } }

__device__ __forceinline__ void combine_row(RowRegs& r, const unsigned char* ws, const MoeTab& tab, int t, int lane) {
    const i32x4 ti = ((const i32x4*)(ws + AB_TOKI))[t]; const f32x2 tg = ((const f32x2*)(ws + AB_TOKG))[t];
    const bf16_t* YS = (const bf16_t*)(ws + AB_YS);
    const int p0 = tab.tstart[ti.x] * BM + ti.z, p1 = tab.tstart[ti.y] * BM + ti.w;
    row_add_bf16(r, YS + (size_t)p0 * D, tg.x, lane); row_add_bf16(r, YS + (size_t)p1 * D, tg.y, lane);
}
__device__ __forceinline__ void p17_rows(const Args& a, LAS unsigned char* lds, int layer, int gw, int NGW, int lane, int wave) {
    const MoeTab tab = moe_tab(lds); moe_tab_build(tab, (const int*)(a.ws + WS_CTL) + layer * 32, wave);
    const f32x4* fn = (const f32x4*)a.in[21] + lane;
    for (int t = gw; t < T; t += NGW) {
        RowRegs r = row_load(a.out + (size_t)t * D, lane); combine_row(r, a.ws, tab, t, lane);
        const float rs = row_rs(r);
        f32x4* o = (f32x4*)(a.out + (size_t)t * D) + lane;
#pragma unroll
        for (int j = 0; j < 4; ++j) o[64 * j] = r.v[j] * rs * fn[64 * j];
    }
}

template <int NT, int MODE>
__device__ __forceinline__ void rowtile_pass(const Args& a, LAS unsigned char* lds, int layer, int wave) {
    const int lane = lane_now(), m = lane & 15, kq = lane >> 4, tidx = wave * 64 + lane;
    const int skr = MODE == 0 ? SKR_A : MODE == 1 ? (layer ? SKR_R1 : SKR_R0) : SKR_F;
    const bf16_t* wh = (const bf16_t*)(a.ws + WS_SKH) + (size_t)(skr + m) * 1024 + 8 * kq; const bf16_t* wl = (const bf16_t*)(a.ws + WS_SKL) + (size_t)(skr + m) * 1024 + 8 * kq;
    bf16_t* XN = (bf16_t*)(a.ws + AB_XN); float* RS = (float*)(a.ws + WS_RS);
    const float* src = MODE == 0 ? a.in[0] : a.out;
    MoeTab tab = moe_tab(lds);
    if (MODE == 2) moe_tab_build(tab, (const int*)(a.ws + WS_CTL) + layer * 32, wave);
    int* gcnt = (int*)(a.ws + WS_CTL) + layer * 32; int* LIST = (int*)(a.ws + AB_LIST); i32x4* TOKI = (i32x4*)(a.ws + AB_TOKI); f32x2* TOKG = (f32x2*)(a.ws + AB_TOKG);
    LAS int* be = (LAS int*)(lds); LAS int* rk = be + 256; LAS int* lcnt = rk + 256; LAS int* lbase = lcnt + 32; LAS float* bg = (LAS float*)(lbase + 32);
    LAS float* LG = (LAS float*)(lds + 8192) + wave * (16 * 52);
    for (int batch = blockIdx.x; batch < T / 128; batch += gridDim.x) {
        const int row = batch * 128 + wave * 16 + m;
        const float* xr = src + (size_t)row * D + 8 * kq;
        const bf16_t* y0 = nullptr; const bf16_t* y1 = nullptr; float g0 = 0.f, g1 = 0.f;
        if (MODE == 2) { const i32x4 ti = ((const i32x4*)(a.ws + AB_TOKI))[row]; const f32x2 tg = ((const f32x2*)(a.ws + AB_TOKG))[row]; const bf16_t* YS = (const bf16_t*)(a.ws + AB_YS);
            y0 = YS + (size_t)(tab.tstart[ti.x] * BM + ti.z) * D + 8 * kq; y1 = YS + (size_t)(tab.tstart[ti.y] * BM + ti.w) * D + 8 * kq; g0 = tg.x; g1 = tg.y; }
        if (MODE == 1 && tidx < 32) lcnt[tidx] = 0;
        f32x4 acc[NT];
#pragma unroll
        for (int t = 0; t < NT; ++t) acc[t] = (f32x4){0.f, 0.f, 0.f, 0.f};
        float ssq = 0.f;
#pragma unroll 2
        for (int s = 0; s < 32; ++s) {
            f32x4 xa = *(const f32x4*)(xr + 32 * s), xb = *(const f32x4*)(xr + 32 * s + 4);
            if (MODE == 2) { const u32x4 ya = *(const u32x4*)(y0 + 32 * s), yb = *(const u32x4*)(y1 + 32 * s);
                xa[0] += g0 * bflo(ya.x) + g1 * bflo(yb.x); xa[1] += g0 * bfhi(ya.x) + g1 * bfhi(yb.x); xa[2] += g0 * bflo(ya.y) + g1 * bflo(yb.y); xa[3] += g0 * bfhi(ya.y) + g1 * bfhi(yb.y);
                xb[0] += g0 * bflo(ya.z) + g1 * bflo(yb.z); xb[1] += g0 * bfhi(ya.z) + g1 * bfhi(yb.z); xb[2] += g0 * bflo(ya.w) + g1 * bflo(yb.w); xb[3] += g0 * bfhi(ya.w) + g1 * bfhi(yb.w);
                float* hw = a.out + (size_t)row * D + 8 * kq + 32 * s; *(f32x4*)hw = xa; *(f32x4*)(hw + 4) = xb; }
            ssq += (xa[0] * xa[0] + xa[1] * xa[1]) + (xa[2] * xa[2] + xa[3] * xa[3]) + (xb[0] * xb[0] + xb[1] * xb[1]) + (xb[2] * xb[2] + xb[3] * xb[3]);
            u32x4 hw4, lw4;
            hw4.x = pk2(xa[0], xa[1]); hw4.y = pk2(xa[2], xa[3]); hw4.z = pk2(xb[0], xb[1]); hw4.w = pk2(xb[2], xb[3]);
            lw4.x = pk2(xa[0] - bflo(hw4.x), xa[1] - bfhi(hw4.x)); lw4.y = pk2(xa[2] - bflo(hw4.y), xa[3] - bfhi(hw4.y)); lw4.z = pk2(xb[0] - bflo(hw4.z), xb[1] - bfhi(hw4.z)); lw4.w = pk2(xb[2] - bflo(hw4.w), xb[3] - bfhi(hw4.w));
            *(u32x4*)(XN + (size_t)row * D + 8 * kq + 32 * s) = hw4;
            const bf16x8 xh = __builtin_bit_cast(bf16x8, hw4), xl = __builtin_bit_cast(bf16x8, lw4);
#pragma unroll
            for (int t = 0; t < NT; ++t) { const bf16x8 bh = *(const bf16x8*)(wh + t * 16384 + 32 * s), bl = *(const bf16x8*)(wl + t * 16384 + 32 * s);
                acc[t] = __builtin_amdgcn_mfma_f32_16x16x32_bf16(bh, xh, acc[t], 0, 0, 0); acc[t] = __builtin_amdgcn_mfma_f32_16x16x32_bf16(bl, xh, acc[t], 0, 0, 0); acc[t] = __builtin_amdgcn_mfma_f32_16x16x32_bf16(bh, xl, acc[t], 0, 0, 0); }
        }
        ssq += __shfl_xor(ssq, 16); ssq += __shfl_xor(ssq, 32);
        const float rs = 1.0f / sqrtf(ssq * (1.0f / 1024.0f) + RMS_EPS);
        if (kq == 0) RS[row] = rs;
        if (MODE == 0) *(f32x4*)((float*)(a.ws + AB_AA) + (size_t)row * 16 + 4 * kq) = acc[0] * rs;
        if (MODE == 2) { const f32x4 b4 = *(const f32x4*)(a.in[9] + 4 * kq); f32x4 o;
#pragma unroll
            for (int j = 0; j < 4; ++j) o[j] = log_sigmoid(acc[0][j] * rs + b4[j]);
            *(f32x4*)((float*)(a.ws + AB_LF) + (size_t)row * 16 + 4 * kq) = o; }
        if (MODE == 1) {
            const float* bc = a.in[15] + layer * 4; const float* bfine = a.in[17] + layer * 32;
#pragma unroll
            for (int t = 0; t < NT; ++t) *(LAS f32x4*)(LG + m * 52 + 16 * t + 4 * kq) = acc[t] * rs;
            if (kq == 0) {
                const LAS float* lg = LG + m * 52;
                const float c0 = lg[32] + bc[0], c1 = lg[33] + bc[1], c2 = lg[34] + bc[2], c3 = lg[35] + bc[3];
                int gi = 0; float cm = c0; if (c1 > cm) { cm = c1; gi = 1; } if (c2 > cm) { cm = c2; gi = 2; } if (c3 > cm) { cm = c3; gi = 3; }
                const float pc = 1.f / (__expf(c0 - cm) + __expf(c1 - cm) + __expf(c2 - cm) + __expf(c3 - cm));
                const f32x4 fa = *(const LAS f32x4*)(lg + gi * 8), fb = *(const LAS f32x4*)(lg + gi * 8 + 4); const f32x4 ba4 = *(const f32x4*)(bfine + gi * 8), bb4 = *(const f32x4*)(bfine + gi * 8 + 4);
                const float f[8] = {fa[0] + ba4[0], fa[1] + ba4[1], fa[2] + ba4[2], fa[3] + ba4[3], fb[0] + bb4[0], fb[1] + bb4[1], fb[2] + bb4[2], fb[3] + bb4[3]};
                int j0 = 0; float m0 = f[0];
#pragma unroll
                for (int j = 1; j < 8; ++j) if (f[j] > m0) { m0 = f[j]; j0 = j; }
                int j1 = -1; float m1 = -INFINITY;
#pragma unroll
                for (int j = 0; j < 8; ++j) if (j != j0 && f[j] > m1) { m1 = f[j]; j1 = j; }
                const float e1 = __expf(m1 - m0), inv = 1.f / (1.f + e1); const int lr = wave * 16 + m;
                be[lr * 2] = gi * 8 + j0; be[lr * 2 + 1] = gi * 8 + j1; bg[lr * 2] = pc * inv; bg[lr * 2 + 1] = pc * e1 * inv;
            }
            __syncthreads();
            if (tidx < 256) rk[tidx] = atomicAdd((int*)&lcnt[be[tidx]], 1);
            __syncthreads();
            if (tidx < 32) lbase[tidx] = lcnt[tidx] ? atomicAdd(&gcnt[tidx], lcnt[tidx]) : 0;
            __syncthreads();
            if (tidx < 256) { const int e = be[tidx], idx = lbase[e] + rk[tidx]; LIST[e * T + idx] = batch * 128 + (tidx >> 1); rk[tidx] = idx; }
            __syncthreads();
            if (tidx < 128) { const int lr = tidx; TOKI[batch * 128 + lr] = (i32x4){be[lr * 2], be[lr * 2 + 1], rk[lr * 2], rk[lr * 2 + 1]}; TOKG[batch * 128 + lr] = (f32x2){bg[lr * 2], bg[lr * 2 + 1]}; }
            __syncthreads();
        }
    }
}

__device__ __forceinline__ void gla_alpha_naive(const Args& a, int wave) {
    const float* AA = (const float*)(a.ws + AB_AA); float* AL = (float*)(a.ws + AB_ALPHA); const float* w2 = a.in[3]; const float* ba = a.in[4];
    for (size_t i = (size_t)blockIdx.x * NTHREADS + TIDX; i < (size_t)T * 512; i += (size_t)gridDim.x * NTHREADS) {
        const int t = (int)(i >> 9), hd = (int)(i & 511); float z = ba[hd];
#pragma unroll
        for (int r = 0; r < 16; ++r) z += AA[(size_t)t * 16 + r] * w2[r * 512 + hd];
        AL[i] = __expf(log_sigmoid(z) * (1.f / 16.f));
    }
}
__device__ __forceinline__ void gla_scan_naive(const Args& a, int gw, int NGW, int lane) {
    const bf16_t* __restrict__ Q = (const bf16_t*)(a.ws + AB_Q); const bf16_t* __restrict__ K = (const bf16_t*)(a.ws + AB_K); bf16_t* V = (bf16_t*)(a.ws + AB_V);
    const float* __restrict__ AL = (const float*)(a.ws + AB_ALPHA); float* SSQ = (float*)(a.ws + AB_SSQ);
    for (int item = gw; item < 256; item += NGW) {
        const int b = item >> 4, h = (item >> 2) & 3, sl = item & 3, e = h * 256 + sl * 64 + lane;
        float St[128];
#pragma unroll
        for (int d = 0; d < 128; ++d) St[d] = 0.f;
        for (int t = 0; t < SEQ; ++t) {
            const size_t row = (size_t)b * SEQ + t;
            const float v = bf2f(V[row * D + e]);
            const u32x4* qp = (const u32x4*)(Q + row * 512 + h * 128); const u32x4* kp = (const u32x4*)(K + row * 512 + h * 128); const f32x4* ap = (const f32x4*)(AL + row * 512 + h * 128);
            float o = 0.f;
#pragma unroll
            for (int c = 0; c < 16; ++c) { const u32x4 qw = qp[c], kw = kp[c]; const f32x4 a0 = ap[2 * c], a1 = ap[2 * c + 1];
                const float qf[8] = {bflo(qw.x), bfhi(qw.x), bflo(qw.y), bfhi(qw.y), bflo(qw.z), bfhi(qw.z), bflo(qw.w), bfhi(qw.w)};
                const float kf[8] = {bflo(kw.x), bfhi(kw.x), bflo(kw.y), bfhi(kw.y), bflo(kw.z), bfhi(kw.z), bflo(kw.w), bfhi(kw.w)};
                const float af[8] = {a0[0], a0[1], a0[2], a0[3], a1[0], a1[1], a1[2], a1[3]};
#pragma unroll
                for (int j = 0; j < 8; ++j) { const int d = c * 8 + j; St[d] = af[j] * St[d] + kf[j] * v; o += qf[j] * St[d]; } }
            V[row * D + e] = (bf16_t)f2bf(o);
            const float ss = wave_sum(o * o);
            if (lane < 2) SSQ[row * 32 + h * 8 + sl * 2 + lane] = lane ? 0.f : ss;
        }
    }
}
__device__ __forceinline__ void gla_post(const Args& a, int wave) {
    bf16_t* V = (bf16_t*)(a.ws + AB_XN); const bf16_t* R = (const bf16_t*)(a.ws + AB_R); const float* SSQ = (const float*)(a.ws + AB_SSQ);
    for (size_t i = (size_t)blockIdx.x * NTHREADS + TIDX; i < (size_t)T * 128; i += (size_t)gridDim.x * NTHREADS) {
        const size_t t = i >> 7; const int c8 = (int)(i & 127) * 8, h = c8 >> 8;
        const f32x4 sq = *(const f32x4*)(SSQ + t * 32 + h * 8), sq2 = *(const f32x4*)(SSQ + t * 32 + h * 8 + 4);
        const float rstd = 1.0f / sqrtf((((sq[0] + sq[1]) + (sq[2] + sq[3])) + ((sq2[0] + sq2[1]) + (sq2[2] + sq2[3]))) * (1.f / 256.f) + RMS_EPS);
        const u32x4 ow = *(const u32x4*)(V + t * D + c8), rw = *(const u32x4*)(R + t * D + c8);
        const unsigned oo[4] = {ow.x, ow.y, ow.z, ow.w}, rr[4] = {rw.x, rw.y, rw.z, rw.w}; unsigned res[4];
#pragma unroll
        for (int j = 0; j < 4; ++j) { const float r0 = bflo(rr[j]), r1 = bfhi(rr[j]); res[j] = pk2(bflo(oo[j]) * rstd * r0 * sigmoidf_(r0), bfhi(oo[j]) * rstd * r1 * sigmoidf_(r1)); }
        *(u32x4*)(V + t * D + c8) = (u32x4){res[0], res[1], res[2], res[3]};
    }
}

namespace gla {
typedef short v4i16 __attribute__((ext_vector_type(4)));
typedef float f32x16 __attribute__((ext_vector_type(16)));
constexpr int QP = 136, VP = 72;
constexpr int OFF_Q = 0, OFF_K = 64 * QP * 2, OFF_V = 2 * 64 * QP * 2, OFF_P = OFF_V + 64 * VP * 2, STAGE = OFF_P + 64 * VP * 2;
constexpr int OFF_ST = 2 * STAGE, SZ_ST = 64 * QP * 2, OFF_EL = OFF_ST + 2 * SZ_ST;
static_assert(OFF_EL + 1024 <= LDS_BYTES, "GLA LDS map");
__device__ __forceinline__ int crow(int r, int hi) { return (r & 3) + 8 * (r >> 2) + 4 * hi; }
__device__ __forceinline__ bf16x8 row_frag(const LAS unsigned char* base, int pitchB, int row, int s, int hi) { return *(const LAS bf16x8*)(base + row * pitchB + (16 * s + 8 * hi) * 2); }
__device__ __forceinline__ bf16x8 tr_frag(const LAS unsigned char* base, int pitchB, int s, int col0, int lane) {
    const int hi = lane >> 5, q4 = (lane >> 2) & 3, p4 = lane & 3, cb = (col0 + 16 * ((lane >> 4) & 1) + 4 * p4) * 2;
    const LAS unsigned char* p0 = base + (16 * s + 8 * hi + q4) * pitchB + cb;
    const v4i16 lo = __builtin_amdgcn_ds_read_tr16_b64_v4i16((LAS v4i16*)p0);
    const v4i16 hh = __builtin_amdgcn_ds_read_tr16_b64_v4i16((LAS v4i16*)(p0 + 4 * pitchB));
    return (bf16x8){lo[0], lo[1], lo[2], lo[3], hh[0], hh[1], hh[2], hh[3]};
}
__device__ __forceinline__ void prep(const Args& a, LAS unsigned char* lds, int wave) {
    const int lane = lane_now(), tid = wave * 64 + lane, g = wave, dp = lane, r32 = lane & 31, hi = lane >> 5;
    bf16_t* Qb = (bf16_t*)(a.ws + AB_Q); bf16_t* Kb = (bf16_t*)(a.ws + AB_K); bf16_t* PM = (bf16_t*)(a.ws + AB_PM); float* EL = (float*)(a.ws + AB_EL);
    const float* AA = (const float*)(a.ws + AB_AA); const float* w2 = a.in[3]; const float* ba = a.in[4];
    LAS float* As = (LAS float*)lds; LAS float* GT = (LAS float*)(lds + 4096); LAS unsigned char* Qs = lds + 8192; LAS unsigned char* Ks = lds + 8192 + 64 * QP * 2;
    for (int item = blockIdx.x; item < 2048; item += gridDim.x) {
        const int bh = item >> 5, c = item & 31, h = bh & 3; const size_t row0 = (size_t)(bh >> 2) * SEQ + c * 64;
        *(LAS f32x2*)(As + tid * 2) = *(const f32x2*)(AA + row0 * 16 + tid * 2);
        f32x2 w[16];
#pragma unroll
        for (int r = 0; r < 16; ++r) w[r] = *(const f32x2*)(w2 + r * 512 + h * 128 + 2 * dp);
        const f32x2 bb = *(const f32x2*)(ba + h * 128 + 2 * dp);
        __syncthreads();
        float c0[8], c1[8]; float cs0 = 0.f, cs1 = 0.f;
#pragma unroll
        for (int ii = 0; ii < 8; ++ii) { const int i = 8 * g + ii; float z0 = bb.x, z1 = bb.y;
#pragma unroll
            for (int r4 = 0; r4 < 4; ++r4) { const f32x4 av = *(const LAS f32x4*)(As + i * 16 + r4 * 4);
#pragma unroll
                for (int j = 0; j < 4; ++j) { z0 += av[j] * w[r4 * 4 + j].x; z1 += av[j] * w[r4 * 4 + j].y; } }
            cs0 += log_sigmoid(z0) * (1.f / 16.f); cs1 += log_sigmoid(z1) * (1.f / 16.f); c0[ii] = cs0; c1[ii] = cs1; }
        *(LAS f32x2*)(GT + g * 128 + 2 * dp) = (f32x2){cs0, cs1};
        __syncthreads();
        float off0 = 0.f, off1 = 0.f, last0 = 0.f, last1 = 0.f;
#pragma unroll
        for (int gg = 0; gg < 8; ++gg) { const f32x2 t = *(const LAS f32x2*)(GT + gg * 128 + 2 * dp); if (gg < g) { off0 += t.x; off1 += t.y; } last0 += t.x; last1 += t.y; }
        if (g == 0) *(f32x2*)(EL + (size_t)item * 128 + 2 * dp) = (f32x2){__expf(last0), __expf(last1)};
#pragma unroll
        for (int ii = 0; ii < 8; ++ii) { const int i = 8 * g + ii; const float m0 = off0 + c0[ii], m1 = off1 + c1[ii];
            unsigned* qp = (unsigned*)(Qb + (row0 + i) * 512 + h * 128 + 2 * dp); unsigned* kp = (unsigned*)(Kb + (row0 + i) * 512 + h * 128 + 2 * dp);
            const unsigned qw = *qp, kw = *kp;
            const unsigned qt = pk2(bflo(qw) * __expf(m0), bfhi(qw) * __expf(m1));
            const unsigned kt = pk2(bflo(kw) * __expf(-m0), bfhi(kw) * __expf(-m1));
            const unsigned kh = pk2(bflo(kw) * __expf(last0 - m0), bfhi(kw) * __expf(last1 - m1));
            *qp = qt; *kp = kh;
            *(LAS unsigned*)(Qs + i * QP * 2 + 4 * dp) = qt; *(LAS unsigned*)(Ks + i * QP * 2 + 4 * dp) = kt; }
        __syncthreads();
        if (wave < 4) {
            const int ti = wave >> 1, tj = wave & 1; f32x16 acc = {};
#pragma unroll
            for (int s = 0; s < 8; ++s) acc = __builtin_amdgcn_mfma_f32_32x32x16_bf16(row_frag(Ks, QP * 2, 32 * tj + r32, s, hi), row_frag(Qs, QP * 2, 32 * ti + r32, s, hi), acc, 0, 0, 0);
            const int i = 32 * ti + r32;
#pragma unroll
            for (int g4 = 0; g4 < 4; ++g4) { const int j0 = 32 * tj + 8 * g4 + 4 * hi; float v[4];
#pragma unroll
                for (int x = 0; x < 4; ++x) v[x] = (j0 + x <= i) ? acc[4 * g4 + x] : 0.f;
                *(u32x2*)(PM + (size_t)item * 4096 + i * 64 + j0) = (u32x2){pk2(v[0], v[1]), pk2(v[2], v[3])}; }
        }
        __syncthreads();
    }
}
__device__ __forceinline__ void scan(const Args& a, LAS unsigned char* lds, int wave) {
    const int lane = lane_now(), tid = wave * 64 + lane, r32 = lane & 31, hi = lane >> 5;
    const bf16_t* Qb = (const bf16_t*)(a.ws + AB_Q); const bf16_t* Kb = (const bf16_t*)(a.ws + AB_K); const bf16_t* Vb = (const bf16_t*)(a.ws + AB_V); bf16_t* Ob = (bf16_t*)(a.ws + AB_XN);
    const bf16_t* PM = (const bf16_t*)(a.ws + AB_PM); const float* EL = (const float*)(a.ws + AB_EL); float* SSQ = (float*)(a.ws + AB_SSQ);
    const int te = wave & 1, td = wave >> 1, ti = (wave >> 1) & 1;
    for (int item = blockIdx.x; item < 256; item += gridDim.x) {
        const int b = item >> 4, h = (item >> 2) & 3, sl = item & 3, bh = b * 4 + h; const size_t row0 = (size_t)b * SEQ;
        const int qrow0 = tid >> 4, qch = tid & 15, vrow = tid >> 3, vch = tid & 7;
        const bf16_t* gq = Qb + (row0 + qrow0) * 512 + h * 128 + qch * 8; const bf16_t* gk = Kb + (row0 + qrow0) * 512 + h * 128 + qch * 8;
        const bf16_t* gv = Vb + (row0 + vrow) * D + h * 256 + sl * 64 + vch * 8; const bf16_t* gp = PM + (size_t)bh * 32 * 4096 + vrow * 64 + vch * 8;
        const float* ge = EL + (size_t)bh * 32 * 128 + (tid & 31) * 4;
        const int lq = qrow0 * QP * 2 + qch * 16, lv = vrow * VP * 2 + vch * 16;
        u32x4 rq0, rq1, rk0, rk1, rv, rp; f32x4 re;
#define GLA_LOAD(c) do { rq0 = *(const u32x4*)(gq + (size_t)(c) * 64 * 512); rq1 = *(const u32x4*)(gq + (size_t)(c) * 64 * 512 + 32 * 512); rk0 = *(const u32x4*)(gk + (size_t)(c) * 64 * 512); rk1 = *(const u32x4*)(gk + (size_t)(c) * 64 * 512 + 32 * 512); \
        rv = *(const u32x4*)(gv + (size_t)(c) * 64 * D); rp = *(const u32x4*)(gp + (size_t)(c) * 4096); re = *(const f32x4*)(ge + (c) * 128); } while (0)
#define GLA_WRITE(bf) do { LAS unsigned char* sb = lds + (bf) * STAGE; *(LAS u32x4*)(sb + OFF_Q + lq) = rq0; *(LAS u32x4*)(sb + OFF_Q + lq + 32 * QP * 2) = rq1; *(LAS u32x4*)(sb + OFF_K + lq) = rk0; *(LAS u32x4*)(sb + OFF_K + lq + 32 * QP * 2) = rk1; \
        *(LAS u32x4*)(sb + OFF_V + lv) = rv; *(LAS u32x4*)(sb + OFF_P + lv) = rp; if (tid < 32) *(LAS f32x4*)(lds + OFF_EL + (bf) * 512 + tid * 16) = re; } while (0)
        f32x16 Sacc = {};
        for (int i = tid; i < SZ_ST / 16; i += NTHREADS) *(LAS u32x4*)(lds + OFF_ST + i * 16) = (u32x4){0u, 0u, 0u, 0u};
        GLA_LOAD(0); GLA_WRITE(0); GLA_LOAD(1);
        __syncthreads();
        for (int c = 0; c < 32; ++c) {
            const int bf = c & 1; const LAS unsigned char* sb = lds + bf * STAGE; const LAS unsigned char* ST = lds + OFF_ST + bf * SZ_ST;
            bf16x8 vfr[4], kfr[4];
#pragma unroll
            for (int s = 0; s < 4; ++s) { vfr[s] = tr_frag(sb + OFF_V, VP * 2, s, 32 * te, lane); kfr[s] = tr_frag(sb + OFF_K, QP * 2, s, 32 * td, lane); }
            const float elv = *(const LAS float*)(lds + OFF_EL + bf * 512 + (32 * td + r32) * 4);
            if (wave < 4) {
                f32x16 oacc = {};
#pragma unroll
                for (int s = 0; s < 8; ++s) oacc = __builtin_amdgcn_mfma_f32_32x32x16_bf16(row_frag(ST, QP * 2, 32 * te + r32, s, hi), row_frag(sb + OFF_Q, QP * 2, 32 * ti + r32, s, hi), oacc, 0, 0, 0);
#pragma unroll
                for (int s = 0; s < 4; ++s) oacc = __builtin_amdgcn_mfma_f32_32x32x16_bf16(vfr[s], row_frag(sb + OFF_P, VP * 2, 32 * ti + r32, s, hi), oacc, 0, 0, 0);
                const size_t orow = row0 + c * 64 + 32 * ti + r32; float ss = 0.f;
#pragma unroll
                for (int g4 = 0; g4 < 4; ++g4) { const int e0 = 32 * te + 8 * g4 + 4 * hi;
                    *(u32x2*)(Ob + orow * D + h * 256 + sl * 64 + e0) = (u32x2){pk2(oacc[4 * g4], oacc[4 * g4 + 1]), pk2(oacc[4 * g4 + 2], oacc[4 * g4 + 3])};
#pragma unroll
                    for (int x = 0; x < 4; ++x) ss += oacc[4 * g4 + x] * oacc[4 * g4 + x]; }
                ss += __shfl_xor(ss, 32);
                if (hi == 0) SSQ[orow * 32 + h * 8 + sl * 2 + te] = ss;
            }
#pragma unroll
            for (int r = 0; r < 16; ++r) Sacc[r] *= elv;
#pragma unroll
            for (int s = 0; s < 4; ++s) Sacc = __builtin_amdgcn_mfma_f32_32x32x16_bf16(vfr[s], kfr[s], Sacc, 0, 0, 0);
            { LAS unsigned char* STn = lds + OFF_ST + (bf ^ 1) * SZ_ST;
#pragma unroll
              for (int r = 0; r < 16; ++r) *(LAS unsigned short*)(STn + (32 * te + crow(r, hi)) * QP * 2 + (32 * td + r32) * 2) = (unsigned short)f2bf(Sacc[r]); }
            if (c + 1 < 32) GLA_WRITE(bf ^ 1);
            if (c + 2 < 32) GLA_LOAD(c + 2);
            __syncthreads();
        }
#undef GLA_LOAD
#undef GLA_WRITE
    }
}
}

__device__ __forceinline__ void fox_cumsum(const Args& a, int gw, int NGW, int lane) {
    const float* LF = (const float*)(a.ws + AB_LF); float* C = (float*)(a.ws + AB_C);
    for (int item = gw; item < 256; item += NGW) {
        const int b = item >> 4, h = item & 15; float loc[32]; float s = 0.f;
#pragma unroll
        for (int i = 0; i < 32; ++i) { s += LF[((size_t)b * SEQ + lane * 32 + i) * 16 + h]; loc[i] = s; }
        float incl = s;
#pragma unroll
        for (int o = 1; o < 64; o <<= 1) { const float n = __shfl_up(incl, o); if (lane >= o) incl += n; }
        const float excl = incl - s;
#pragma unroll
        for (int i = 0; i < 32; ++i) C[(size_t)item * SEQ + lane * 32 + i] = loc[i] + excl;
    }
}
__device__ __forceinline__ void fox_attn_naive(const Args& a, int gw, int NGW, int lane) {
    bf16_t* Q = (bf16_t*)(a.ws + AB_FQ); const bf16_t* __restrict__ K = (const bf16_t*)(a.ws + AB_FK); const bf16_t* __restrict__ V = (const bf16_t*)(a.ws + AB_FV);
    const bf16_t* __restrict__ OG = (const bf16_t*)(a.ws + AB_FOG); const float* __restrict__ C = (const float*)(a.ws + AB_C);
    for (int item = gw; item < 8192; item += NGW) {
        const int bh = item >> 5, tb = item & 31, b = bh >> 4, h = bh & 15, t = tb * 64 + lane;
        const size_t row = (size_t)b * SEQ + t;
        float q[64], o[64];
#pragma unroll
        for (int c = 0; c < 8; ++c) { const u32x4 w = *(const u32x4*)(Q + row * D + h * 64 + c * 8); q[c * 8 + 0] = bflo(w.x); q[c * 8 + 1] = bfhi(w.x); q[c * 8 + 2] = bflo(w.y); q[c * 8 + 3] = bfhi(w.y); q[c * 8 + 4] = bflo(w.z); q[c * 8 + 5] = bfhi(w.z); q[c * 8 + 6] = bflo(w.w); q[c * 8 + 7] = bfhi(w.w); }
#pragma unroll
        for (int d = 0; d < 64; ++d) o[d] = 0.f;
        float m = -INFINITY, l = 0.f; const float cref = C[(size_t)bh * SEQ + tb * 64 + 63];
        const int smax = tb * 64 + 63;
        for (int s = 0; s <= smax; ++s) {
            const size_t krow = (size_t)b * SEQ + s; float x = 0.f;
#pragma unroll
            for (int c = 0; c < 8; ++c) { const u32x4 w = *(const u32x4*)(K + krow * D + h * 64 + c * 8);
                x += q[c * 8 + 0] * bflo(w.x) + q[c * 8 + 1] * bfhi(w.x) + q[c * 8 + 2] * bflo(w.y) + q[c * 8 + 3] * bfhi(w.y) + q[c * 8 + 4] * bflo(w.z) + q[c * 8 + 5] * bfhi(w.z) + q[c * 8 + 6] * bflo(w.w) + q[c * 8 + 7] * bfhi(w.w); }
            x += (cref - C[(size_t)bh * SEQ + s]) * LOG2E;
            if (s > t) x = -INFINITY;
            const float mn = fmaxf(m, x); const float sc = (mn == -INFINITY) ? 1.f : exp2f(m - mn), p = (mn == -INFINITY) ? 0.f : exp2f(x - mn);
            m = mn; l = l * sc + p;
#pragma unroll
            for (int c = 0; c < 8; ++c) { const u32x4 w = *(const u32x4*)(V + krow * D + h * 64 + c * 8);
                const float vv[8] = {bflo(w.x), bfhi(w.x), bflo(w.y), bfhi(w.y), bflo(w.z), bfhi(w.z), bflo(w.w), bfhi(w.w)};
#pragma unroll
                for (int j = 0; j < 8; ++j) o[c * 8 + j] = o[c * 8 + j] * sc + p * vv[j]; }
        }
        const float il = 1.f / l;
#pragma unroll
        for (int c = 0; c < 8; ++c) { const u32x4 g = *(const u32x4*)(OG + row * D + h * 64 + c * 8); const unsigned gg[4] = {g.x, g.y, g.z, g.w}; unsigned res[4];
#pragma unroll
            for (int j = 0; j < 4; ++j) res[j] = pk2(o[c * 8 + 2 * j] * il * sigmoidf_(bflo(gg[j])), o[c * 8 + 2 * j + 1] * il * sigmoidf_(bfhi(gg[j])));
            *(u32x4*)(Q + row * D + h * 64 + c * 8) = (u32x4){res[0], res[1], res[2], res[3]}; }
    }
}

#include <hip/hip_bf16.h>
#include <cmath>
namespace attn_body {
using bf16=__hip_bfloat16;
using bf16x8=__attribute__((ext_vector_type(8)))short;
using s16x4=__attribute__((ext_vector_type(4)))short;
using f32x16=__attribute__((ext_vector_type(16)))float;
using u32x4=__attribute__((ext_vector_type(4)))unsigned;
constexpr int BATCH=16,NHEAD=16,SEQ=2048,D=64,DM=NHEAD*D;
constexpr int NW=8,QBLK=32,QB=QBLK*NW,KVBLK=64,NQB=SEQ/QB;
constexpr int ATTN_PITCH=DM, ATTN_UNIT_ROWS=QB;
__device__ __forceinline__ int crow(int r,int hi){return (r&3)+8*(r>>2)+4*hi;}
#define SBAR() __builtin_amdgcn_sched_barrier(0)
__device__ __forceinline__ void cmask(f32x16&p0,f32x16&p1,int jb,int qrel,int hi){
  const float NEG=-INFINITY; int kb=64*jb+4*hi;
  #pragma unroll
  for(int r=0;r<16;++r){int kv=kb+(r&3)+8*(r>>2); if(kv>qrel)p0[r]=NEG; if(kv+32>qrel)p1[r]=NEG;}
}

constexpr int NSLOT=3, SLOTB=8192;
constexpr int LDS_CL=90112;
typedef float f32x4a __attribute__((ext_vector_type(4)));
constexpr int LDS_K=0, LDS_V=NSLOT*SLOTB, LDS_WS=2*NSLOT*SLOTB, LDS_OST=LDS_WS+NW*64*4, LDS_BYTES=LDS_OST+NW*4096;
constexpr float C2=0.125f*1.4426950408889634f;
__device__ __forceinline__ void glds16(const void*sbase,unsigned voff,unsigned lds_dst){unsigned keep;
  asm volatile("s_mov_b32 %0, m0\n\ts_mov_b32 m0, %3\n\ts_nop 0\n\tglobal_load_lds_dwordx4 %1, %2\n\ts_mov_b32 m0, %0":"=&s"(keep):"v"(voff),"s"(sbase),"s"(lds_dst):"memory");}
__device__ __forceinline__ float max3f(float a,float b,float c){float r;asm("v_max3_f32 %0, %1, %2, %3":"=v"(r):"v"(a),"v"(b),"v"(c));return r;}
__device__ __forceinline__ float max2f(float a,float b){float r;asm("v_max_f32_e32 %0, %1, %2":"=v"(r):"v"(a),"v"(b));return r;}
__device__ __forceinline__ float fadd_s(float a,float b){float r;asm("v_add_f32_e32 %0, %1, %2":"=v"(r):"v"(a),"v"(b));return r;}
__device__ __forceinline__ float fsub_s(float a,float b){float r;asm("v_sub_f32_e32 %0, %1, %2":"=v"(r):"v"(a),"v"(b));return r;}
typedef float f32x2_t __attribute__((ext_vector_type(2))); typedef __bf16 bf16x2_t __attribute__((ext_vector_type(2)));
__device__ __forceinline__ unsigned cvtpk_s(float lo,float hi){f32x2_t v={lo,hi};bf16x2_t b=__builtin_convertvector(v,bf16x2_t);return __builtin_bit_cast(unsigned,b);}
#define WAIT_BAR(N) asm volatile("s_waitcnt vmcnt(" #N ") lgkmcnt(0)\n\ts_barrier":::"memory")

__device__ __forceinline__ void qkt(f32x16&p0,f32x16&p1,const char*Kslot,const bf16x8*qr,int r32,int hi){
  const char*kb=Kslot+hi*1024+r32*16;
  #pragma unroll
  for(int d0=0;d0<4;++d0){
    const bf16x8 b0=*reinterpret_cast<const bf16x8*>(kb+d0*2048);
    const bf16x8 b1=*reinterpret_cast<const bf16x8*>(kb+d0*2048+512);
    p0=__builtin_amdgcn_mfma_f32_32x32x16_bf16(b0,qr[d0],p0,0,0,0);p1=__builtin_amdgcn_mfma_f32_32x32x16_bf16(b1,qr[d0],p1,0,0,0);}
}
typedef __attribute__((address_space(3))) const char* lds_cptr;
typedef short v4i16_t __attribute__((ext_vector_type(4)));
__device__ __forceinline__ void kload8(bf16x8*kf,lds_cptr kp){
  kf[0]=*(const __attribute__((address_space(3))) bf16x8*)(kp);      kf[1]=*(const __attribute__((address_space(3))) bf16x8*)(kp+512);
  kf[2]=*(const __attribute__((address_space(3))) bf16x8*)(kp+2048); kf[3]=*(const __attribute__((address_space(3))) bf16x8*)(kp+2560);
  kf[4]=*(const __attribute__((address_space(3))) bf16x8*)(kp+4096); kf[5]=*(const __attribute__((address_space(3))) bf16x8*)(kp+4608);
  kf[6]=*(const __attribute__((address_space(3))) bf16x8*)(kp+6144); kf[7]=*(const __attribute__((address_space(3))) bf16x8*)(kp+6656);
}
__device__ __forceinline__ void kload2(bf16x8*kf,lds_cptr kp,int j){ kf[2*j]=*(const __attribute__((address_space(3))) bf16x8*)(kp+j*2048); kf[2*j+1]=*(const __attribute__((address_space(3))) bf16x8*)(kp+j*2048+512); }
__device__ __forceinline__ s16x4 vtr(lds_cptr p){ return __builtin_bit_cast(s16x4,__builtin_amdgcn_ds_read_tr16_b64_v4i16((__attribute__((address_space(3))) v4i16_t*)p)); }
__device__ __forceinline__ float rowmax(const f32x16&p0,const f32x16&p1){
  float a=max3f(p0[0],p0[1],p1[0]),b=max3f(p0[2],p0[3],p1[1]);a=max3f(a,p1[2],p1[3]);
  #pragma unroll
  for(int r=4;r<16;r+=4){a=max3f(a,p0[r],p0[r+1]);b=max3f(b,p0[r+2],p0[r+3]);a=max3f(a,p1[r],p1[r+1]);b=max3f(b,p1[r+2],p1[r+3]);}
  const float m=max2f(a,b);
  auto rr=__builtin_amdgcn_permlane32_swap(__float_as_uint(m),__float_as_uint(m),false,false);
  return max2f(__uint_as_float(rr[0]),__uint_as_float(rr[1]));
}
__device__ __forceinline__ void pv(f32x16*o,int vb,bf16x8 pa0,bf16x8 pa1,bf16x8 pa2,bf16x8 pa3){
  #pragma unroll
  for(int d0=0;d0<2;++d0){s16x4 lo[4],hi[4];
    #pragma unroll
    for(int ks=0;ks<4;++ks){
      asm volatile("ds_read_b64_tr_b16 %0,%1 offset:%c2":"=&v"(lo[ks]):"v"(vb),"i"(d0*4096+ks*1024):"memory");
      asm volatile("ds_read_b64_tr_b16 %0,%1 offset:%c2":"=&v"(hi[ks]):"v"(vb),"i"(d0*4096+ks*1024+512):"memory");}
    asm volatile("s_waitcnt lgkmcnt(0)":::"memory");SBAR();
    #define PK(k) (bf16x8){lo[k][0],lo[k][1],lo[k][2],lo[k][3],hi[k][0],hi[k][1],hi[k][2],hi[k][3]}
    o[d0]=__builtin_amdgcn_mfma_f32_32x32x16_bf16(pa0,PK(0),o[d0],0,0,0);
    o[d0]=__builtin_amdgcn_mfma_f32_32x32x16_bf16(pa1,PK(1),o[d0],0,0,0);
    o[d0]=__builtin_amdgcn_mfma_f32_32x32x16_bf16(pa2,PK(2),o[d0],0,0,0);
    o[d0]=__builtin_amdgcn_mfma_f32_32x32x16_bf16(pa3,PK(3),o[d0],0,0,0);
    #undef PK
  }
}

#ifndef ATTN_STORE16
#define ATTN_STORE16(p,v) (*(u32x4*)(p)=(v))
#endif
template<int THRL> __device__ __forceinline__ void attn_unit(int b,int h,int qb,const bf16*Q,const bf16*__restrict__ K,const bf16*__restrict__ V,const bf16*__restrict__ OG,bf16*O,char*shm,int wave){
  const int lane=lane_now(),r32=lane&31,hi=lane>>5; const int wid=wave;
  const long rowbase=(long)b*SEQ; const int q0=qb*QB;
  const bf16*Qw=Q+(rowbase+q0+wid*QBLK)*DM+h*D;
  const bf16*Kh=K+rowbase*DM+h*D,*Vh=V+rowbase*DM+h*D;
  const unsigned lds0=(unsigned)(uintptr_t)shm;
  float*wsf=(float*)(shm+LDS_WS)+wid*64;
  const unsigned koff=(unsigned)(lane*DM+wid*8)*2u;
  const unsigned voff=(unsigned)((16*(wid&3)+(lane>>2))*DM+(wid>>2)*32+(lane&3)*8)*2u;
  const unsigned kdst=lds0+LDS_K+wid*1024, vdst=lds0+LDS_V+wid*1024;
  #define DMA_K(t,slot) glds16(Kh+(long)(t)*KVBLK*DM,koff,(unsigned)__builtin_amdgcn_readfirstlane(kdst+(slot)))
  #define DMA_V(t,slot) glds16(Vh+(long)(t)*KVBLK*DM,voff,(unsigned)__builtin_amdgcn_readfirstlane(vdst+(slot)))
  const int vb0=(int)(lds0+LDS_V)+((lane>>4)&1)*32+(lane&3)*8+(4*hi+((lane&15)>>2))*64;
  const char*Kbase=shm+LDS_K; bf16x8 kf[8];
  const lds_cptr shm3=(lds_cptr)shm; const lds_cptr kp0=shm3+LDS_K+hi*1024+r32*16; const lds_cptr vp0=shm3+LDS_V+((lane>>4)&1)*32+(lane&3)*8+(4*hi+((lane&15)>>2))*64;
  const int NT=(q0+QB)/KVBLK;
  DMA_K(0,0);DMA_V(0,0);DMA_K(1,SLOTB);
  bf16x8 qr[4]; int rq_=r32; asm volatile("":"+v"(rq_));
  #pragma unroll
  for(int d0=0;d0<4;++d0)qr[d0]=*reinterpret_cast<const bf16x8*>(&Qw[(long)rq_*DM+d0*16+hi*8]);
  float mhat=0.f,l_reg=0.f;f32x16 o[2];o[0]=f32x16{};o[1]=f32x16{};
  #define BIASLD(P0,P1,tt) do{ const __attribute__((address_space(3))) f32x4a*c_=(const __attribute__((address_space(3))) f32x4a*)(shm3+LDS_CL+((tt)*64+4*hi)*4); \
    _Pragma("unroll") for(int g_=0;g_<4;++g_){ const f32x4a a_=c_[2*g_],b_=c_[2*g_+8]; _Pragma("unroll") for(int j_=0;j_<4;++j_){P0[4*g_+j_]=a_[j_];P1[4*g_+j_]=b_[j_];} } }while(0)
  const int qrel=wid*QBLK+r32;
  #define CMASK(P0,P1,t) do{int jb_=(t)-(NT-4); if(jb_>=0)cmask(P0,P1,jb_,qrel,hi);}while(0)
  bool resc=false;
  #define START(P0,P1) do{ const float rm=rowmax(P0,P1); resc=false; \
    { const float dl=rm; mhat=fadd_s(mhat,dl); \
      _Pragma("unroll") for(int r=0;r<16;++r){P0[r]=fsub_s(P0[r],dl);P1[r]=fsub_s(P1[r],dl);} } \
    _Pragma("unroll") for(int r=0;r<16;++r)P0[r]=__builtin_amdgcn_exp2f(P0[r]); }while(0)
  #define RESC() do{ if(resc){ asm volatile("s_waitcnt lgkmcnt(0)":::"memory"); \
      _Pragma("unroll") for(int d_=0;d_<2;++d_) _Pragma("unroll") for(int r=0;r<16;++r)o[d_][r]*=wsf[crow(r,hi)]; } }while(0)
  f32x16 pA0,pA1,pB0,pB1;
  int sl_prev=0,sl_cur=0,sl_next=SLOTB;
  #define ROT() do{sl_prev=sl_cur;sl_cur=sl_next;sl_next=(sl_next==(NSLOT-1)*SLOTB)?0:sl_next+SLOTB;}while(0)
  DMA_K(2,2*SLOTB);
  WAIT_BAR(3);
  BIASLD(pA0,pA1,0); _Pragma("unroll") for(int r=0;r<16;++r){pA0[r]=-pA0[r];pA1[r]=-pA1[r];}
  qkt(pA0,pA1,Kbase,qr,r32,hi);asm volatile("s_nop 15\n\ts_nop 7":"+v"(pA0),"+v"(pA1));CMASK(pA0,pA1,0);
  START(pA0,pA1);
  _Pragma("unroll") for(int r=0;r<16;++r)pA1[r]=__builtin_amdgcn_exp2f(pA1[r]);
  BIASLD(pB0,pB1,1);
  WAIT_BAR(0);
  DMA_K(3,0);DMA_V(1,SLOTB);
  ROT();
  kload8(kf,kp0+sl_cur);
  WAIT_BAR(2);
  s16x4 vlo[8],vhi[8]; u32x4 pw0,pw1,pw2,pw3;
  #define PKW(P,B) cvtpk_s(P[B],P[B+1])
  #define PAF(k) __builtin_bit_cast(bf16x8,pw##k)
  #define VFR(i) (bf16x8){vlo[i][0],vlo[i][1],vlo[i][2],vlo[i][3],vhi[i][0],vhi[i][1],vhi[i][2],vhi[i][3]}
  #define PIN(x) asm volatile("":"+v"(x))
  #define MX3(a,b,c) __builtin_fmaxf(__builtin_fmaxf((a),(b)),(c))
  #define GAPA(MF,A0,A1,A2,A3,W0,W1,PW) do{ MF; sacc+=A0; sacc+=A1; sacc+=A2; sacc+=A3; PIN(sacc); W0; W1; PIN(PW); SBAR(); }while(0)
  #define EX(v) __builtin_amdgcn_exp2f(v)
  #define GAPB(MF,X,B) do{ MF; X[B]=EX(X[B]); X[B+1]=EX(X[B+1]); X[B+2]=EX(X[B+2]); X[B+3]=EX(X[B+3]); PIN(X); SBAR(); }while(0)
  #define VRD(i) do{ vlo[i]=vtr(vp_+(((i)>>2)*4096+((i)&3)*1024)); vhi[i]=vtr(vp_+(((i)>>2)*4096+((i)&3)*1024+512)); }while(0)
  #define KRD(G,j) do{ if(G){ kload2(kf,kp0+sl_next,j); SBAR(); } }while(0)
  #define STEP(C0,C1,P0,P1,t,GK,GV,GL) do{ SBAR(); \
    { const float nm_=-mhat; _Pragma("unroll") for(int r=0;r<16;++r){C0[r]=nm_-C0[r];C1[r]=nm_-C1[r];} } \
    const lds_cptr vp_=vp0+sl_prev; \
    VRD(0); SBAR(); float sacc=(P0[0]+P0[1]); \
    GAPA(C0=__builtin_amdgcn_mfma_f32_32x32x16_bf16(kf[0],qr[0],C0,0,0,0), P0[2],P0[3],P0[4],P0[5],     pw0[0]=PKW(P0,0), pw0[1]=PKW(P0,2), pw0); \
    VRD(4); SBAR(); GAPA(C1=__builtin_amdgcn_mfma_f32_32x32x16_bf16(kf[1],qr[0],C1,0,0,0), P0[6],P0[7],P0[8],P0[9],     pw0[2]=PKW(P0,4), pw0[3]=PKW(P0,6), pw0); \
    VRD(1); SBAR(); GAPA(C0=__builtin_amdgcn_mfma_f32_32x32x16_bf16(kf[2],qr[1],C0,0,0,0),   P0[10],P0[11],P0[12],P0[13], pw1[0]=PKW(P0,8), pw1[1]=PKW(P0,10), pw1); \
    VRD(5); SBAR(); GAPA(C1=__builtin_amdgcn_mfma_f32_32x32x16_bf16(kf[3],qr[1],C1,0,0,0),   P0[14],P0[15],P1[0],P1[1],   pw1[2]=PKW(P0,12),pw1[3]=PKW(P0,14), pw1); \
    VRD(2); SBAR(); GAPA(C0=__builtin_amdgcn_mfma_f32_32x32x16_bf16(kf[4],qr[2],C0,0,0,0),   P1[2],P1[3],P1[4],P1[5],     pw2[0]=PKW(P1,0), pw2[1]=PKW(P1,2), pw2); \
    VRD(6); SBAR(); GAPA(C1=__builtin_amdgcn_mfma_f32_32x32x16_bf16(kf[5],qr[2],C1,0,0,0),   P1[6],P1[7],P1[8],P1[9],     pw2[2]=PKW(P1,4), pw2[3]=PKW(P1,6), pw2); \
    VRD(3); SBAR(); GAPA(C0=__builtin_amdgcn_mfma_f32_32x32x16_bf16(kf[6],qr[3],C0,0,0,0),   P1[10],P1[11],P1[12],P1[13], pw3[0]=PKW(P1,8), pw3[1]=PKW(P1,10), pw3); \
    VRD(7); SBAR(); GAPA(C1=__builtin_amdgcn_mfma_f32_32x32x16_bf16(kf[7],qr[3],C1,0,0,0),   P1[14],P1[15],0.f,0.f,       pw3[2]=PKW(P1,12),pw3[3]=PKW(P1,14), pw3); \
    l_reg+=sacc; \
    if(GK){DMA_K((t)+3,sl_cur);} if(GV){DMA_V((t)+1,sl_next);} \
    CMASK(C0,C1,t); \
    { float a=MX3(C0[0],C0[1],C1[0]),b=MX3(C0[2],C0[3],C1[1]); a=MX3(a,C1[2],C1[3]); \
      _Pragma("unroll") for(int r=4;r<16;r+=4){a=MX3(a,C0[r],C0[r+1]);b=MX3(b,C0[r+2],C0[r+3]);a=MX3(a,C1[r],C1[r+1]);b=MX3(b,C1[r+2],C1[r+3]);} \
      float rm=__builtin_fmaxf(a,b); { auto rr=__builtin_amdgcn_permlane32_swap(__float_as_uint(rm),__float_as_uint(rm),false,false); rm=__builtin_fmaxf(__uint_as_float(rr[0]),__uint_as_float(rr[1])); } \
      resc=false; \
      if(__builtin_expect(__any(rm>(float)THRL),0)){ const float dl=__builtin_fmaxf(rm,0.f); mhat+=dl; \
        _Pragma("unroll") for(int r=0;r<16;++r){C0[r]-=dl;C1[r]-=dl;} \
        const float f=__builtin_amdgcn_exp2f(-dl); l_reg*=f; if(hi==0)wsf[r32]=f; resc=true; } } \
    SBAR(); \
    GAPB(o[0]=__builtin_amdgcn_mfma_f32_32x32x16_bf16(PAF(0),VFR(0),o[0],0,0,0), C0,0); \
    GAPB(o[1]=__builtin_amdgcn_mfma_f32_32x32x16_bf16(PAF(0),VFR(4),o[1],0,0,0), C0,4); \
    KRD(GL,0); GAPB(o[0]=__builtin_amdgcn_mfma_f32_32x32x16_bf16(PAF(1),VFR(1),o[0],0,0,0), C0,8); \
    KRD(GL,1); GAPB(o[1]=__builtin_amdgcn_mfma_f32_32x32x16_bf16(PAF(1),VFR(5),o[1],0,0,0), C0,12); \
    KRD(GL,2); GAPB(o[0]=__builtin_amdgcn_mfma_f32_32x32x16_bf16(PAF(2),VFR(2),o[0],0,0,0), C1,0); \
    KRD(GL,3); GAPB(o[1]=__builtin_amdgcn_mfma_f32_32x32x16_bf16(PAF(2),VFR(6),o[1],0,0,0), C1,4); \
    GAPB(o[0]=__builtin_amdgcn_mfma_f32_32x32x16_bf16(PAF(3),VFR(3),o[0],0,0,0), C1,8); \
    GAPB(o[1]=__builtin_amdgcn_mfma_f32_32x32x16_bf16(PAF(3),VFR(7),o[1],0,0,0), C1,12); \
    }while(0)
  int t=1;
  #undef CMASK
  #define CMASK(P0,P1,t) do{}while(0)
  for(;t+5<NT;t+=2){
    STEP(pB0,pB1,pA0,pA1,t,true,true,true);     BIASLD(pA0,pA1,t+1); WAIT_BAR(2); RESC(); ROT();
    STEP(pA0,pA1,pB0,pB1,t+1,true,true,true);   BIASLD(pB0,pB1,t+2); WAIT_BAR(2); RESC(); ROT();
  }
  #undef CMASK
  #define CMASK(P0,P1,t) do{int jb_=(t)-(NT-4); if(jb_>=0)cmask(P0,P1,jb_,qrel,hi);}while(0)
  #define ENDW(tt) do{ if((tt)+3<NT){WAIT_BAR(2);} else if((tt)+2<NT){WAIT_BAR(1);} else {WAIT_BAR(0);} }while(0)
  for(;t+1<NT;t+=2){
    STEP(pB0,pB1,pA0,pA1,t,(t+3<NT),(t+1<NT),(t+1<NT));       BIASLD(pA0,pA1,t+1); ENDW(t);   RESC(); ROT();
    STEP(pA0,pA1,pB0,pB1,t+1,(t+4<NT),(t+2<NT),(t+2<NT));     BIASLD(pB0,pB1,t+2); ENDW(t+1); RESC(); ROT();
  }
  STEP(pB0,pB1,pA0,pA1,NT-1,false,false,false); RESC();
  { float sacc=pB0[0]+pB0[1]; _Pragma("unroll") for(int r=2;r<16;++r)sacc+=pB0[r]; _Pragma("unroll") for(int r=0;r<16;++r)sacc+=pB1[r]; l_reg+=sacc;
    pw0=(u32x4){PKW(pB0,0),PKW(pB0,2),PKW(pB0,4),PKW(pB0,6)};pw1=(u32x4){PKW(pB0,8),PKW(pB0,10),PKW(pB0,12),PKW(pB0,14)};pw2=(u32x4){PKW(pB1,0),PKW(pB1,2),PKW(pB1,4),PKW(pB1,6)};pw3=(u32x4){PKW(pB1,8),PKW(pB1,10),PKW(pB1,12),PKW(pB1,14)};
    SBAR(); pv(o,vb0+sl_cur,PAF(0),PAF(1),PAF(2),PAF(3)); }
  #undef PKW
  #undef PAF
  #undef VFR
  #undef PIN
  #undef MX3
  #undef GAPA
  #undef GAPB
  #undef EX
  #undef VRD
  #undef KRD
  #undef STEP
  #undef ENDW
  {auto rr=__builtin_amdgcn_permlane32_swap(__float_as_uint(l_reg),__float_as_uint(l_reg),false,false);l_reg=__uint_as_float(rr[0])+__uint_as_float(rr[1]);}
  if(hi==0)wsf[32+r32]=l_reg;asm volatile("s_waitcnt lgkmcnt(0)":::"memory");
  float rli[16];
  #pragma unroll
  for(int r=0;r<16;++r)rli[r]=__builtin_amdgcn_rcpf(wsf[32+crow(r,hi)]);
  bf16*Ow=O+(rowbase+q0+wid*QBLK)*DM+h*D;
  { bf16*stg=(bf16*)(shm+LDS_OST)+wid*2048;
    #pragma unroll
    for(int r=0;r<16;++r){const int orow=crow(r,hi);
      #pragma unroll
      for(int d0=0;d0<2;++d0)stg[orow*64+d0*32+r32]=__float2bfloat16(o[d0][r]*rli[r]);}
    asm volatile("s_waitcnt lgkmcnt(0)":::"memory");
    const bf16*Gw=OG+(rowbase+q0+wid*QBLK)*DM+h*D;
    int ln=lane; asm volatile("":"+v"(ln));
    #pragma unroll
    for(int i=0;i<4;++i){const int row=i*8+(ln>>3),ch=ln&7; u32x4 v=*(const u32x4*)(stg+row*64+ch*8); const u32x4 g=*(const u32x4*)(Gw+(long)row*DM+ch*8);
      #pragma unroll
      for(int j=0;j<4;++j){ const float g0=__uint_as_float(g[j]<<16),g1=__uint_as_float(g[j]&0xffff0000u),v0=__uint_as_float(v[j]<<16),v1=__uint_as_float(v[j]&0xffff0000u);
        v[j]=cvtpk_s(v0*__builtin_amdgcn_rcpf(1.f+__builtin_amdgcn_exp2f(-1.4426950408889634f*g0)),v1*__builtin_amdgcn_rcpf(1.f+__builtin_amdgcn_exp2f(-1.4426950408889634f*g1))); }
      ATTN_STORE16(Ow+(long)row*DM+ch*8,v);} }
  asm volatile("s_waitcnt lgkmcnt(0)\n\ts_barrier":::"memory");
  #undef DMA_K
  #undef DMA_V
  #undef CMASK
  #undef START
  #undef RESC
  #undef ROT
  #undef BIASLD
}
constexpr int ATTN_LDS_BYTES=LDS_BYTES;
template<int THRL=8> __device__ __forceinline__ void attn_phase(char*lds,const bf16*Q,const bf16*K,const bf16*V,const bf16*OG,bf16*O,const float*Ccum,int wave){
  for(int bh=blockIdx.x;bh<BATCH*NHEAD;bh+=gridDim.x){
    { const int tx=TIDX;
      const f32x4a c=*(const f32x4a*)(Ccum+(size_t)bh*SEQ+tx*4)*1.4426950408889634f;
      *(__attribute__((address_space(3))) f32x4a*)((__attribute__((address_space(3))) char*)lds+LDS_CL+tx*16)=c;
      asm volatile("s_waitcnt lgkmcnt(0)\n\ts_barrier":::"memory"); }
    #pragma unroll 1
    for(int qb=NQB-1;qb>=0;--qb) attn_unit<THRL>(bh/NHEAD,bh%NHEAD,qb,Q,K,V,OG,O,lds,wave);
  }
}
#undef SBAR
#undef WAIT_BAR
}

#define XB_TMO      128
#define XB_XCNT(j)  (256  + 64 * (j))
#define XB_XSUB(j)  (1280 + 64 * (j))
#define XB_XGEN(j)  (2304 + 64 * (j))
#define XB_TOP      3328
#define XB_TOPGEN   3392
#define XCD_BAR_WORDS 3456
#define XB_SPIN_CAP (1u << 18)

__device__ __forceinline__ unsigned xb_ld(unsigned* p)              { return __hip_atomic_load(p, __ATOMIC_RELAXED, __HIP_MEMORY_SCOPE_AGENT); }
__device__ __forceinline__ unsigned xb_add(unsigned* p, unsigned v) { return __hip_atomic_fetch_add(p, v, __ATOMIC_RELAXED, __HIP_MEMORY_SCOPE_AGENT); }
__device__ __forceinline__ unsigned xb_xcc_id() { return (unsigned)__builtin_amdgcn_s_getreg((3 << 11) | 20) & 0xFu; }
#define XB_SPIN(cond, bar) do { unsigned _sp = 0; while (cond) { __builtin_amdgcn_s_sleep(1); \
    if ((++_sp & 255u) == 0u) { if (xb_ld(&(bar)[XB_TMO])) break; if (_sp > XB_SPIN_CAP) { atomicAdd(&(bar)[XB_TMO], 1u); break; } } } } while (0)

struct XcdBarrier {
    unsigned* bar; unsigned x;
    volatile LAS unsigned* st;
};

__device__ __forceinline__ XcdBarrier xcd_barrier_post(unsigned* bar, volatile LAS unsigned* st) {
    XcdBarrier b; b.bar = bar; b.x = xb_xcc_id(); b.st = st;
    if (threadIdx.x == 0) (void)xb_add(&bar[XB_XCNT(b.x)], 1u);
    return b;
}
__device__ __forceinline__ void xcd_barrier_complete(unsigned* bar, unsigned x, unsigned& nloc, unsigned& nx) {
    const unsigned G = gridDim.x * gridDim.y * gridDim.z;
    unsigned sum, cnt, mine, sp = 0u;
    for (;;) {
        sum = 0u; cnt = 0u; mine = 0u;
#pragma unroll
        for (unsigned j = 0; j < 16; ++j) { const unsigned c = xb_ld(&bar[XB_XCNT(j)]); sum += c; cnt += (c > 0u) ? 1u : 0u; mine = (j == x) ? c : mine; }
        if (sum == G) break;
        __builtin_amdgcn_s_sleep(1);
        if ((++sp & 255u) == 0u) { if (xb_ld(&bar[XB_TMO])) break; if (sp > XB_SPIN_CAP) { atomicAdd(&bar[XB_TMO], 1u); break; } }
    }
    nloc = mine > 0u ? mine : 1u; nx = cnt > 0u ? cnt : 1u;
}

__device__ __forceinline__ void xcd_barrier(const XcdBarrier& b) {
    asm volatile("s_waitcnt vmcnt(0)" ::: "memory");
    __syncthreads();
    if (threadIdx.x == 0) {
        unsigned* bar = b.bar;
        __builtin_amdgcn_s_waitcnt(0);
        unsigned nloc = b.st[0], nx = b.st[1];
        if (nloc == 0u) { xcd_barrier_complete(bar, b.x, nloc, nx); b.st[0] = nloc; b.st[1] = nx; }
        const unsigned old = xb_add(&bar[XB_XSUB(b.x)], 1u);
        const unsigned gen = old / nloc;
        if (old + 1u == (gen + 1u) * nloc) {
            __builtin_amdgcn_fence(__ATOMIC_RELEASE, "agent");
            asm volatile("s_waitcnt vmcnt(0)" ::: "memory");
            const unsigned og = xb_add(&bar[XB_TOP], 1u);
            const unsigned tg = og / nx;
            if (og + 1u == (tg + 1u) * nx) xb_add(&bar[XB_TOPGEN], 1u);
            else XB_SPIN(xb_ld(&bar[XB_TOPGEN]) == tg, bar);
            __builtin_amdgcn_fence(__ATOMIC_ACQUIRE, "agent");
            xb_add(&bar[XB_XGEN(b.x)], 1u);
            asm volatile("s_waitcnt vmcnt(0)" ::: "memory");
        } else {
            XB_SPIN(xb_ld(&bar[XB_XGEN(b.x)]) == gen, bar);
            __builtin_amdgcn_fence(__ATOMIC_ACQUIRE, "agent");
            asm volatile("s_waitcnt vmcnt(0)" ::: "memory");
        }
    }
    __syncthreads();
}


constexpr int NPHASES = 18;
__global__ void __launch_bounds__(NTHREADS, 2) fwd(Args a) {
    extern __shared__ __attribute__((aligned(16))) unsigned char lds_raw[];
    LAS unsigned char* lds = (LAS unsigned char*)lds_raw;
    cg::grid_group grid = cg::this_grid();
    const int wave = __builtin_amdgcn_readfirstlane(threadIdx.x >> 6);
#define lane lane_now()
    const int G = gridDim.x, gw = blockIdx.x * NWAVES + wave, NGW = G * NWAVES;
    unsigned char* ws = a.ws;
    if (threadIdx.x < 4) ((LAS unsigned*)(lds + LDS_BYTES - 16))[threadIdx.x] = 0u;
    __syncthreads();
    XcdBarrier bar; bar.bar = nullptr; bar.x = 0; bar.st = nullptr;
#ifdef ONLY_PHASE
#define IN(k) ((k) == ONLY_PHASE)
#else
#define IN(k) true
#endif
#define SEAM(k) do { if ((k) == 0) { grid.sync(); bar = xcd_barrier_post((unsigned*)(ws + WS_BAR), (volatile LAS unsigned*)(lds + LDS_BYTES - 16)); } else xcd_barrier(bar); } while (0)
#define RUN(k, ...) if (IN(k)) { __VA_ARGS__ } if (PROBE_DUP == (k)) { if ((k) == 0) grid.sync(); else xcd_barrier(bar); __VA_ARGS__ } SEAM(k);
#define RUN_LAST(k, ...) if (IN(k)) { __VA_ARGS__ }
    RUN(0, p0_weights(a, lds, gw, NGW, lane, wave);)
    if (PROBE_DUP == 100) { for (int i = 0; i < 20; ++i) xcd_barrier(bar); }
    RUN(1, rowtile_pass<1, 0>(a, lds, 0, wave);)
    RUN(2,
        StaticOrder S; S.init(T, 3072, G, blockIdx.x);
        EpiSplitBf16<0> E{ws, (const float*)(ws + WS_RS)};
        gemm_phase<EpiSplitBf16<0>, StaticOrder, IdMap, true>(lds, (const bf16_t*)(ws + AB_XN), (const bf16_t*)(ws + WS_WIN), 1024, S, E, IdMap{}, wave);)
    RUN(3, gla::prep(a, lds, wave);)
    RUN(4, gla::scan(a, lds, wave);)
    RUN(5, gla_post(a, wave);)
    RUN(6,
        StaticOrder S; S.init(T, 1024, G, blockIdx.x); EpiResF32 E{a.in[0], a.out};
        gemm_phase<EpiResF32, StaticOrder, IdMap, true>(lds, (const bf16_t*)(ws + AB_XN), (const bf16_t*)(ws + WS_WOUT), 1024, S, E, IdMap{}, wave);)
#define MOE_PHASES(layer, pb) \
    RUN(pb, rowtile_pass<3, 1>(a, lds, layer, wave);) \
    RUN(pb + 1, \
        const MoeTab tab = moe_tab(lds); moe_tab_build(tab, (const int*)(ws + WS_CTL) + layer * 32, wave); \
        MoeOrder S; S.so.init(tab.tstart[32] * BM, 1024, G, blockIdx.x); S.tab = tab; \
        MoeGather AM{tab, (const int*)(ws + AB_LIST)}; EpiSwiGLU E{(bf16_t*)(ws + AB_HB), AM, (const float*)(ws + WS_RS)}; \
        gemm_phase<EpiSwiGLU, MoeOrder, MoeGather, true>(lds, (const bf16_t*)(ws + AB_XN), (const bf16_t*)(ws + WS_WEUP) + (size_t)layer * 32 * 1024 * 1024, 1024, S, E, AM, wave); \
        __syncthreads();) \
    RUN(pb + 2, \
        const MoeTab tab = moe_tab(lds); moe_tab_build(tab, (const int*)(ws + WS_CTL) + layer * 32, wave); \
        MoeOrder S; S.so.init(tab.tstart[32] * BM, 1024, G, blockIdx.x); S.tab = tab; \
        EpiMoeDown E{(bf16_t*)(ws + AB_YS)}; \
        gemm_phase<EpiMoeDown, MoeOrder, IdMap, true>(lds, (const bf16_t*)(ws + AB_HB), (const bf16_t*)(ws + WS_WEDN) + (size_t)layer * 32 * 1024 * 512, 512, S, E, IdMap{}, wave); \
        __syncthreads();)
    MOE_PHASES(0, 7)
    RUN(10, rowtile_pass<1, 2>(a, lds, 0, wave); __syncthreads();)
    RUN(11,
        fox_cumsum(a, gw, NGW, lane);
        StaticOrder S; S.init(T, 4096, G, blockIdx.x);
        EpiSplitBf16<1> E{ws, (const float*)(ws + WS_RS)};
        gemm_phase<EpiSplitBf16<1>, StaticOrder, IdMap, true>(lds, (const bf16_t*)(ws + AB_XN), (const bf16_t*)(ws + WS_WKVQ), 1024, S, E, IdMap{}, wave);)
    RUN(12, attn_body::attn_phase<8>((char*)lds_raw, (const attn_body::bf16*)(ws + AB_FQ), (const attn_body::bf16*)(ws + AB_FK), (const attn_body::bf16*)(ws + AB_FV), (const attn_body::bf16*)(ws + AB_FOG), (attn_body::bf16*)(ws + AB_XN), (const float*)(ws + AB_C), wave);)
    RUN(13,
        StaticOrder S; S.init(T, 1024, G, blockIdx.x); EpiResF32 E{a.out, a.out};
        gemm_phase<EpiResF32, StaticOrder, IdMap, true>(lds, (const bf16_t*)(ws + AB_XN), (const bf16_t*)(ws + WS_WFO), 1024, S, E, IdMap{}, wave);)
    MOE_PHASES(1, 14)
    RUN_LAST(17, p17_rows(a, lds, 1, gw, NGW, lane, wave);)
#undef RUN
#undef RUN_LAST
#undef IN
#undef SEAM
#undef lane
}

extern "C" void kernel_launch(void* const* d_in, const int* in_sizes, int n_in, void* d_out, int out_size, void* d_ws, size_t ws_size, hipStream_t stream) {
    static int grid = 0;
    if (grid == 0) {
        if (n_in != 22 || out_size != T * D || ws_size < WS_END) { fprintf(stderr, "kernel_launch: unexpected shapes (n_in %d, out %d, ws %zu < %zu)\n", n_in, out_size, ws_size, (size_t)WS_END); grid = -1; return; }
        int dev = 0, cus = 0, per_cu = 0;
        hipGetDevice(&dev); hipDeviceGetAttribute(&cus, hipDeviceAttributeMultiprocessorCount, dev);
        hipFuncSetAttribute((const void*)fwd, hipFuncAttributeMaxDynamicSharedMemorySize, LDS_BYTES);
        hipOccupancyMaxActiveBlocksPerMultiprocessor(&per_cu, (const void*)fwd, NTHREADS, LDS_BYTES);
        if (per_cu < 1) { fprintf(stderr, "kernel_launch: occupancy query says %d blocks per CU\n", per_cu); grid = -1; return; }
        grid = cus;
        fprintf(stderr, "kernel_launch: grid %d (per_cu %d), ws %zu\n", grid, per_cu, ws_size);
    }
    if (grid < 0) return;
    Args a{};
    for (int i = 0; i < 22; ++i) a.in[i] = (const float*)d_in[i];
    a.out = (float*)d_out; a.ws = (unsigned char*)d_ws;
    {
    void* args[] = {&a};
    hipError_t e = hipLaunchCooperativeKernel((const void*)fwd, dim3(grid), dim3(NTHREADS), args, LDS_BYTES, stream);
    if (e != hipSuccess) fprintf(stderr, "cooperative launch failed: %s\n", hipGetErrorString(e));
    }
}
```
